# Optimizing an MI355X kernel written in HIP

```python
import math
import jax, jax.numpy as jnp
from jax import lax
import numpy as np

D_MODEL = 4096
BATCH = 1
SEQ = 8192
DEPTH = 1
DEC_BATCH = 128
DEC_SEQ = 4
PAST_LEN = 8192
PAGE_SIZE = 128

HEAD_DIM = 128
ATTN_HEADS = (D_MODEL // 2) // HEAD_DIM
ATTN_KV_HEADS = ATTN_HEADS // 4
ATTN_GROUP = ATTN_HEADS // ATTN_KV_HEADS
ATTN_WIDTH = ATTN_HEADS * HEAD_DIM
KV_WIDTH = ATTN_KV_HEADS * HEAD_DIM
WINDOW = 128
ATTN_BLOCK = 128
REL_BUCKETS = 32
REL_MAX_DIST = 128
GDN_HEADS = (D_MODEL - ATTN_WIDTH) // HEAD_DIM
GDN_DK = HEAD_DIM
GDN_DV = HEAD_DIM
GDN_KEY_WIDTH = GDN_HEADS * GDN_DK
GDN_WIDTH = GDN_HEADS * GDN_DV
GDN_CONV = 4
GDN_CONV_CH = 2 * GDN_KEY_WIDTH + GDN_WIDTH
GDN_CHUNK = 64
MIX_WIDTH = ATTN_WIDTH + GDN_WIDTH
FF_DIM = -(-8 * D_MODEL // (3 * 256)) * 256
PROJ_SIZES = (ATTN_WIDTH, KV_WIDTH, KV_WIDTH, GDN_CONV_CH, GDN_WIDTH, GDN_HEADS, GDN_HEADS)
PROJ_WIDTH = ATTN_WIDTH + 2 * KV_WIDTH + GDN_CONV_CH + GDN_WIDTH + 2 * GDN_HEADS
NORM_EPS = 1e-6
NEG_INF = -1e30

kernel_name = 'hybrid_swa_sink_gated_deltanet_step'


def rms_norm(x, w):
    xf = x.astype(jnp.float32)
    y = xf * lax.rsqrt(jnp.mean(xf * xf, axis=-1, keepdims=True) + NORM_EPS)
    return (y * w.astype(jnp.float32)).astype(x.dtype)


def l2_norm(x):
    xf = x.astype(jnp.float32)
    return xf * lax.rsqrt(jnp.sum(xf * xf, axis=-1, keepdims=True) + NORM_EPS)


def rel_bucket(d):
    n = jnp.maximum(d, 0)
    max_exact = REL_BUCKETS // 2
    nf = jnp.maximum(n, 1).astype(jnp.float32)
    large = max_exact + (jnp.log(nf / max_exact) / math.log(REL_MAX_DIST / max_exact)
                         * (REL_BUCKETS - max_exact)).astype(jnp.int32)
    large = jnp.minimum(large, REL_BUCKETS - 1)
    return jnp.where(n < max_exact, n, large)


def swa_attend(q, k, v, q_pos, k_pos, k_valid, sinks, rel_bias):
    tq, tk = q_pos.shape[0], k_pos.shape[0]
    d = q_pos[:, None] - k_pos[None, :]
    allowed = (d >= 0) & (d <= WINDOW)
    bias = rel_bias.astype(jnp.float32)[rel_bucket(d)]
    bias = bias.reshape(tq, tk, ATTN_KV_HEADS, ATTN_GROUP).transpose(2, 3, 0, 1)
    s = jnp.einsum('...qhgd,...khd->...hgqk', q, k).astype(jnp.float32) * (HEAD_DIM ** -0.5) + bias
    mask = allowed & k_valid[..., None, None, None, :]
    s = jnp.where(mask, s, NEG_INF)
    sink = sinks.astype(jnp.float32).reshape(ATTN_KV_HEADS, ATTN_GROUP)[:, :, None, None]
    m = jnp.maximum(jnp.max(s, axis=-1, keepdims=True), sink)
    p = jnp.exp(s - m)
    denom = jnp.sum(p, axis=-1, keepdims=True) + jnp.exp(sink - m)
    return jnp.einsum('...hgqk,...khd->...qhgd', (p / denom).astype(v.dtype), v)


def swa_prompt(q, k, v, sinks, rel_bias):
    b, t = q.shape[:2]
    c = ATTN_BLOCK
    nb = t // c
    qb = q.reshape(b, nb, c, ATTN_KV_HEADS, ATTN_GROUP, HEAD_DIM)
    kb = k.reshape(b, nb, c, ATTN_KV_HEADS, HEAD_DIM)
    vb = v.reshape(b, nb, c, ATTN_KV_HEADS, HEAD_DIM)
    padw = ((0, 0), (1, 0), (0, 0), (0, 0), (0, 0))
    kk = jnp.concatenate([jnp.pad(kb, padw)[:, :-1], kb], axis=2)
    vv = jnp.concatenate([jnp.pad(vb, padw)[:, :-1], vb], axis=2)
    q_pos = c + jnp.arange(c)
    k_pos = jnp.arange(2 * c)
    k_valid = (jnp.arange(nb)[:, None] > 0) | (k_pos[None, :] >= c)
    o = swa_attend(qb, kk, vv, q_pos, k_pos, k_valid, sinks, rel_bias)
    return o.reshape(b, t, ATTN_WIDTH)


def swa_sample(q, k, v, win_k, win_v, sinks, rel_bias):
    b, t = q.shape[:2]
    l = win_k.shape[1]
    kk = jnp.concatenate([win_k, k], axis=1)
    vv = jnp.concatenate([win_v, v], axis=1)
    q_pos = l + jnp.arange(t)
    k_pos = jnp.arange(l + t)
    k_valid = jnp.ones((l + t,), dtype=bool)
    o = swa_attend(q.reshape(b, t, ATTN_KV_HEADS, ATTN_GROUP, HEAD_DIM), kk, vv,
                   q_pos, k_pos, k_valid, sinks, rel_bias)
    return o.reshape(b, t, ATTN_WIDTH), kk[:, -l:], vv[:, -l:]


def causal_conv(x, conv_state, w):
    t = x.shape[1]
    xp = jnp.concatenate([conv_state.astype(x.dtype), x], axis=1)
    y = xp[:, 0:t] * w[0]
    for i in range(1, GDN_CONV):
        y = y + xp[:, i:i + t] * w[i]
    return jax.nn.silu(y), xp[:, -(GDN_CONV - 1):]


def gated_delta_chunked(q, k, v, g, beta, s0):
    f32 = jnp.float32
    q, k, v, g, beta = (a.astype(f32) for a in (q, k, v, g, beta))
    b, t, h, dk = q.shape
    dv = v.shape[-1]
    c = min(GDN_CHUNK, t)
    pad = (-t) % c
    if pad:
        p4 = ((0, 0), (0, pad), (0, 0), (0, 0))
        p3 = ((0, 0), (0, pad), (0, 0))
        q, k, v = jnp.pad(q, p4), jnp.pad(k, p4), jnp.pad(v, p4)
        g, beta = jnp.pad(g, p3), jnp.pad(beta, p3)
    n = (t + pad) // c

    def chunks(a):
        a = a.reshape((b, n, c) + a.shape[2:])
        return jnp.moveaxis(a, (1, 2), (0, 3))

    q, k, v, g, beta = chunks(q * dk ** -0.5), chunks(k), chunks(v), chunks(g), chunks(beta)
    gc = jnp.cumsum(g, axis=-1)
    idx = jnp.arange(c)
    causal = idx[:, None] >= idx[None, :]
    strict = idx[:, None] > idx[None, :]
    decay = jnp.exp(jnp.where(causal, gc[..., :, None] - gc[..., None, :], -jnp.inf))
    kb = k * beta[..., None]
    a_mat = jnp.where(strict, jnp.einsum('...id,...jd->...ij', kb, k) * decay, 0.0)
    eye = jnp.eye(c, dtype=f32)
    t_mat = lax.linalg.triangular_solve(a_mat + eye, jnp.broadcast_to(eye, a_mat.shape),
                                        left_side=True, lower=True)
    u = t_mat @ (v * beta[..., None])
    w = t_mat @ (kb * jnp.exp(gc)[..., None])
    qk = jnp.einsum('...id,...jd->...ij', q, k) * decay

    def step(s, inp):
        qc, kc, uc, wc, gcc, qkc = inp
        v_new = uc - wc @ s
        o = (qc * jnp.exp(gcc)[..., None]) @ s + qkc @ v_new
        g_last = gcc[..., -1:]
        s = s * jnp.exp(g_last)[..., None] + jnp.einsum(
            'bhck,bhcv->bhkv', kc * jnp.exp(g_last - gcc)[..., None], v_new)
        return s, o

    s, o = lax.scan(step, s0.astype(f32), (q, k, u, w, gc, qk))
    o = jnp.moveaxis(o, (0, 3), (1, 2)).reshape(b, n * c, h, dv)[:, :t]
    return o, s


def decoder_layer(x, params, win_k, win_v, conv_state, gdn_state, rel_bias):
    (w_in, sinks, conv_w, a_log, dt_bias, gnorm_w, w_out,
     n_pre_mix, n_post_mix, n_pre_ffn, n_post_ffn, w_gate, w_up, w_down) = params
    b, t, _ = x.shape
    h = rms_norm(x, n_pre_mix)
    proj = h @ w_in
    pts, acc = [], 0
    for sz in PROJ_SIZES[:-1]:
        acc += sz
        pts.append(acc)
    q_a, k_a, v_a, qkv_g, z_g, a_g, b_g = jnp.split(proj, pts, axis=-1)

    q_a = q_a.reshape(b, t, ATTN_HEADS, HEAD_DIM)
    k_a = k_a.reshape(b, t, ATTN_KV_HEADS, HEAD_DIM)
    v_a = v_a.reshape(b, t, ATTN_KV_HEADS, HEAD_DIM)
    if win_k is None:
        attn = swa_prompt(q_a, k_a, v_a, sinks, rel_bias)
        lw = min(WINDOW, t)
        new_k, new_v = k_a[:, t - lw:], v_a[:, t - lw:]
    else:
        attn, new_k, new_v = swa_sample(q_a, k_a, v_a, win_k, win_v, sinks, rel_bias)

    if conv_state is None:
        conv_state = jnp.zeros((b, GDN_CONV - 1, GDN_CONV_CH), x.dtype)
    if gdn_state is None:
        gdn_state = jnp.zeros((b, GDN_HEADS, GDN_DK, GDN_DV), jnp.float32)
    cq, new_conv = causal_conv(qkv_g, conv_state, conv_w)
    q_g, k_g, v_g = jnp.split(cq, [GDN_KEY_WIDTH, 2 * GDN_KEY_WIDTH], axis=-1)
    q_g = l2_norm(q_g.reshape(b, t, GDN_HEADS, GDN_DK))
    k_g = l2_norm(k_g.reshape(b, t, GDN_HEADS, GDN_DK))
    v_g = v_g.reshape(b, t, GDN_HEADS, GDN_DV)
    g = -jnp.exp(a_log.astype(jnp.float32)) * jax.nn.softplus(
        a_g.astype(jnp.float32) + dt_bias.astype(jnp.float32))
    beta = jax.nn.sigmoid(b_g.astype(jnp.float32))
    o_g, new_s = gated_delta_chunked(q_g, k_g, v_g, g, beta, gdn_state)
    o_g = rms_norm(o_g, gnorm_w) * jax.nn.silu(z_g.reshape(b, t, GDN_HEADS, GDN_DV).astype(jnp.float32))
    o_g = o_g.reshape(b, t, GDN_WIDTH).astype(x.dtype)

    mix = jnp.concatenate([attn.astype(x.dtype), o_g], axis=-1) @ w_out
    x = x + rms_norm(mix, n_post_mix)
    h2 = rms_norm(x, n_pre_ffn)
    ffn = (jax.nn.silu(h2 @ w_gate) * (h2 @ w_up)) @ w_down
    x = x + rms_norm(ffn, n_post_ffn)
    return x, new_k, new_v, new_conv, new_s.astype(x.dtype)


def setup_inputs(seed: int = 0) -> dict:
    key = jax.random.key(seed)
    ks = jax.random.split(key, 24)
    f32 = jnp.float32
    win_len = min(WINDOW, PAST_LEN)
    nrm = lambda kk, shape, s: jax.random.normal(kk, shape, f32) * s
    dt = jnp.exp(jax.random.uniform(ks[10], (DEPTH, GDN_HEADS), f32)
                 * (math.log(0.1) - math.log(0.001)) + math.log(0.001))
    return {
        'x_prompt': nrm(ks[0], (BATCH, SEQ, D_MODEL), 1.0),
        'x_sample': nrm(ks[1], (DEC_BATCH, DEC_SEQ, D_MODEL), 1.0),
        'cache_win_k': nrm(ks[2], (DEPTH, DEC_BATCH, win_len, ATTN_KV_HEADS, HEAD_DIM), 1.0),
        'cache_win_v': nrm(ks[3], (DEPTH, DEC_BATCH, win_len, ATTN_KV_HEADS, HEAD_DIM), 1.0),
        'state_conv': nrm(ks[4], (DEPTH, DEC_BATCH, GDN_CONV - 1, GDN_CONV_CH), 1.0),
        'state_gdn': nrm(ks[5], (DEPTH, DEC_BATCH, GDN_HEADS, GDN_DK, GDN_DV), GDN_DK ** -0.5),
        'rel_bias': nrm(ks[6], (REL_BUCKETS, ATTN_HEADS), 0.5),
        'w_in': nrm(ks[7], (DEPTH, D_MODEL, PROJ_WIDTH), D_MODEL ** -0.5),
        'attn_sinks': nrm(ks[8], (DEPTH, ATTN_HEADS), 1.0),
        'gdn_conv_w': nrm(ks[9], (DEPTH, GDN_CONV, GDN_CONV_CH), GDN_CONV ** -0.5),
        'gdn_a_log': jnp.log(jax.random.uniform(ks[11], (DEPTH, GDN_HEADS), f32, 1.0, 16.0)),
        'gdn_dt_bias': dt + jnp.log(-jnp.expm1(-dt)),
        'gdn_norm_w': 1.0 + nrm(ks[12], (DEPTH, GDN_DV), 0.1),
        'w_out': nrm(ks[13], (DEPTH, MIX_WIDTH, D_MODEL), MIX_WIDTH ** -0.5),
        'norm_pre_mix': 1.0 + nrm(ks[14], (DEPTH, D_MODEL), 0.1),
        'norm_post_mix': 1.0 + nrm(ks[15], (DEPTH, D_MODEL), 0.1),
        'norm_pre_ffn': 1.0 + nrm(ks[16], (DEPTH, D_MODEL), 0.1),
        'norm_post_ffn': 1.0 + nrm(ks[17], (DEPTH, D_MODEL), 0.1),
        'w_gate': nrm(ks[18], (DEPTH, D_MODEL, FF_DIM), D_MODEL ** -0.5),
        'w_up': nrm(ks[19], (DEPTH, D_MODEL, FF_DIM), D_MODEL ** -0.5),
        'w_down': nrm(ks[20], (DEPTH, FF_DIM, D_MODEL), FF_DIM ** -0.5),
    }


def reference(x_prompt, x_sample, cache_win_k, cache_win_v, state_conv, state_gdn, rel_bias,
              w_in, attn_sinks, gdn_conv_w, gdn_a_log, gdn_dt_bias, gdn_norm_w, w_out,
              norm_pre_mix, norm_post_mix, norm_pre_ffn, norm_post_ffn, w_gate, w_up, w_down):
    yp, ys = x_prompt, x_sample
    pk, pv, pc, ps = [], [], [], []
    sk, sv, sc, ss = [], [], [], []
    for l in range(DEPTH):
        params = (w_in[l], attn_sinks[l], gdn_conv_w[l], gdn_a_log[l], gdn_dt_bias[l], gdn_norm_w[l],
                  w_out[l], norm_pre_mix[l], norm_post_mix[l], norm_pre_ffn[l], norm_post_ffn[l],
                  w_gate[l], w_up[l], w_down[l])
        yp, k1, v1, c1, s1 = decoder_layer(yp, params, None, None, None, None, rel_bias)
        ys, k2, v2, c2, s2 = decoder_layer(ys, params, cache_win_k[l], cache_win_v[l],
                                           state_conv[l], state_gdn[l], rel_bias)
        pk.append(k1); pv.append(v1); pc.append(c1); ps.append(s1)
        sk.append(k2); sv.append(v2); sc.append(c2); ss.append(s2)
    return (yp, ys, jnp.stack(pk), jnp.stack(pv), jnp.stack(pc), jnp.stack(ps),
            jnp.stack(sk), jnp.stack(sv), jnp.stack(sc), jnp.stack(ss))
```

```cpp
#include <hip/hip_runtime.h>
#include <cstdio>
#include <cstdint>
namespace pg8 {
#define PG8_LAS __attribute__((address_space(3)))
typedef unsigned short bf16_t;
typedef short bf16x8 __attribute__((ext_vector_type(8)));
typedef float f32x4 __attribute__((ext_vector_type(4)));
typedef unsigned u32x4 __attribute__((ext_vector_type(4)));
constexpr int BM = 256, BK = 64, HALF = 128, HTB = HALF * BK * 2  , STAGE_BYTES = 8 * HTB, NXCD = 8, WGM = 8;

__host__ __device__ __forceinline__ int lds_byte(int r, int c) { const int st = (r >> 4) * 2 + (c >> 5), rr = r & 15, cc = c & 31, ob = rr * 64 + cc * 2; return st * 1024 + (ob ^ (((ob >> 9) & 1) << 5)); }
__host__ __device__ __forceinline__ void stage_rc(int b, int& R, int& C) { const int st = b / 1024, sb = b % 1024, swz = sb ^ (((sb >> 9) & 1) << 5); R = (st >> 1) * 16 + swz / 64; C = (st & 1) * 32 + (swz % 64) / 2; }
__host__ __device__ __forceinline__ int perm32(int rho) { const int n = rho >> 4, i = rho & 15; return 8 * (i >> 2) + 4 * n + (i & 3); }

struct Unit { int pm, pn, k0, nk; };
struct Gemm { const bf16_t* A; const bf16_t* Bt; int M, N, K; };

struct StaticOrder {
    int nM, nN, nwg, G, c, ntf;
    __host__ __device__ void init(int M, int N, int K, int G_, int c_) { nM = M / BM; nN = N / BM; nwg = nM * nN; G = G_; c = c_; ntf = K / BK; }
    __host__ __device__ bool next(int i, Unit& u) const {
        const long L = (long)i * G + c; if (L >= nwg) return false;
        int wgid = (int)L; { const int q = nwg / NXCD, r = nwg % NXCD, xcd = wgid % NXCD, off = wgid / NXCD; wgid = (xcd < r ? xcd * (q + 1) : r * (q + 1) + (xcd - r) * q) + off; }
        const int nig = WGM * nN, gid = wgid / nig, fm = gid * WGM, gsz = (nM - fm) < WGM ? (nM - fm) : WGM;
        u.pm = fm + ((wgid % nig) % gsz); u.pn = (wgid % nig) / gsz; u.k0 = 0; u.nk = ntf; return true;
    }
    __device__ __forceinline__ void a_ready(const Unit&) const {}
    __device__ __forceinline__ void done(const Unit&) const {}
};
struct SplitTailOrder {
    StaticOrder base; int mp, ntail_items;
    __host__ __device__ void init(int Mprompt, int Msample, int N, int K, int G_, int c_) { base.init(Mprompt, N, K, G_, c_); mp = Mprompt / BM; ntail_items = (Msample / BM) * (N / BM) * 8; }
    __host__ __device__ bool next(int i, Unit& u) const {
        Unit t; t.pm = 0; t.pn = 0; t.k0 = 0; t.nk = base.ntf; const bool full = base.next(i, t);
        const int nb = (base.nwg - base.c + base.G - 1) / base.G;
        const int item = (i - nb) * base.G + base.c; const bool tail = !full && i >= nb && item < ntail_items;
        const int tt = item >> 3, sp = item & 7, per = (base.ntf / 16) * 2, rem = (base.ntf - 8 * per) / 2;
        u.pm = full ? t.pm : mp + tt / base.nN; u.pn = full ? t.pn : tt % base.nN; u.nk = full ? t.nk : per + (sp < rem ? 2 : 0); u.k0 = full ? 0 : sp * per + 2 * (sp < rem ? sp : rem);
        return full || tail;
    }
    __device__ __forceinline__ void a_ready(const Unit&) const {}
    __device__ __forceinline__ void done(const Unit&) const {}
};
__device__ __forceinline__ unsigned cvt_pk_bf16(float lo, float hi) { unsigned r; asm volatile("v_cvt_pk_bf16_f32 %0, %1, %2" : "=v"(r) : "v"(lo), "v"(hi)); return r; }
typedef float f32x2 __attribute__((ext_vector_type(2)));
__device__ __forceinline__ float silu_f(float x) { return x * __builtin_amdgcn_rcpf(1.0f + __expf(-x)); }
struct EpiProj {
    static constexpr bool PERM = true, AFTER_DRAIN = false;
    bf16_t* P; float* AB; int ldp;
    __device__ __forceinline__ void operator()(const f32x4 (&acc)[2][2][4][2], const Unit& u, int wr, int wc, int fr, int fq) const {
        const int row0 = u.pm * BM + wr * 64 + fr;
        if (u.pn < 44) {
            const int col0 = u.pn * BM + wc * 32 + 8 * fq;
#pragma unroll
            for (int ai = 0; ai < 2; ++ai)
#pragma unroll
                for (int m = 0; m < 4; ++m) { bf16_t* rowp = P + (size_t)(row0 + ai * HALF + m * 16) * ldp + col0;
#pragma unroll
                    for (int bj = 0; bj < 2; ++bj) { const f32x4 v0 = acc[ai][bj][m][0], v1 = acc[ai][bj][m][1];
                        u32x4 w; w.x = cvt_pk_bf16(v0[0], v0[1]); w.y = cvt_pk_bf16(v0[2], v0[3]); w.z = cvt_pk_bf16(v1[0], v1[1]); w.w = cvt_pk_bf16(v1[2], v1[3]);
                        *(u32x4*)(rowp + bj * HALF) = w; } }
        } else if (wc == 0) {
#pragma unroll
            for (int ai = 0; ai < 2; ++ai)
#pragma unroll
                for (int m = 0; m < 4; ++m) { float* rp = AB + (size_t)(row0 + ai * HALF + m * 16) * 32 + 8 * fq;
                    *(f32x4*)(rp) = acc[ai][0][m][0]; *(f32x4*)(rp + 4) = acc[ai][0][m][1]; }
        }
    }
};
struct EpiBfSlab {
    static constexpr bool PERM = true, AFTER_DRAIN = false;
    bf16_t* C; int ldc; float* slab; int mp, ntf; size_t slab_stride;
    __device__ __forceinline__ void operator()(const f32x4 (&acc)[2][2][4][2], const Unit& u, int wr, int wc, int fr, int fq) const {
        const int col0 = u.pn * BM + wc * 32 + 8 * fq, row0 = u.pm * BM + wr * 64 + fr;
        if (u.nk == ntf) {
#pragma unroll
            for (int ai = 0; ai < 2; ++ai)
#pragma unroll
                for (int m = 0; m < 4; ++m) { bf16_t* rowp = C + (size_t)(row0 + ai * HALF + m * 16) * ldc + col0;
#pragma unroll
                    for (int bj = 0; bj < 2; ++bj) { const f32x4 v0 = acc[ai][bj][m][0], v1 = acc[ai][bj][m][1];
                        u32x4 w; w.x = cvt_pk_bf16(v0[0], v0[1]); w.y = cvt_pk_bf16(v0[2], v0[3]); w.z = cvt_pk_bf16(v1[0], v1[1]); w.w = cvt_pk_bf16(v1[2], v1[3]);
                        *(u32x4*)(rowp + bj * HALF) = w; } }
        } else {
            const int per = (ntf / 16) * 2, rem = (ntf - 8 * per) / 2; const int sp = u.k0 < rem * (per + 2) ? u.k0 / (per + 2) : rem + (u.k0 - rem * (per + 2)) / per;
            float* Cb = slab + (size_t)sp * slab_stride; const int r0 = row0 - mp * BM;
#pragma unroll
            for (int ai = 0; ai < 2; ++ai)
#pragma unroll
                for (int m = 0; m < 4; ++m) { float* rowp = Cb + (size_t)(r0 + ai * HALF + m * 16) * ldc + col0;
#pragma unroll
                    for (int bj = 0; bj < 2; ++bj) { *(f32x4*)(rowp + bj * HALF) = acc[ai][bj][m][0]; *(f32x4*)(rowp + bj * HALF + 4) = acc[ai][bj][m][1]; } }
        }
    }
};
struct EpiSwiGLU {
    static constexpr bool PERM = true, AFTER_DRAIN = false;
    bf16_t* O; int ldc;
    __device__ __forceinline__ void operator()(const f32x4 (&acc)[2][2][4][2], const Unit& u, int wr, int wc, int fr, int fq) const {
        const int row0 = u.pm * BM + wr * 64 + fr, col0 = u.pn * HALF + wc * 32 + 8 * fq;
#pragma unroll
        for (int ai = 0; ai < 2; ++ai)
#pragma unroll
            for (int m = 0; m < 4; ++m) { bf16_t* rowp = O + (size_t)(row0 + ai * HALF + m * 16) * ldc + col0;
                const f32x4 g0 = acc[ai][0][m][0], g1 = acc[ai][0][m][1], u0 = acc[ai][1][m][0], u1 = acc[ai][1][m][1];
                u32x4 w; w.x = cvt_pk_bf16(silu_f(g0[0]) * u0[0], silu_f(g0[1]) * u0[1]); w.y = cvt_pk_bf16(silu_f(g0[2]) * u0[2], silu_f(g0[3]) * u0[3]);
                w.z = cvt_pk_bf16(silu_f(g1[0]) * u1[0], silu_f(g1[1]) * u1[1]); w.w = cvt_pk_bf16(silu_f(g1[2]) * u1[2], silu_f(g1[3]) * u1[3]);
                *(u32x4*)rowp = w; }
    }
};
template <class Epi, class Sched, bool ALIGN_EPI = false, bool SP2 = false>
__device__ __forceinline__ void gemm_phase(PG8_LAS unsigned char* lds, const Gemm g, const Sched& S, const Epi& E) {
    const int tid = threadIdx.x, wid = __builtin_amdgcn_readfirstlane(tid >> 6), lane = tid & 63, wr = wid >> 2, wc = wid & 3, fr = lane & 15, fq = lane >> 4;
    const int K = g.K;
    unsigned voffA[2], voffB[2];
#pragma unroll
    for (int i = 0; i < 2; ++i) { int R, C; stage_rc(tid * 16 + i * 8192, R, C); const int Rb = Epi::PERM ? ((R & ~31) + perm32(R & 31)) : R;
        voffA[i] = (unsigned)(R * K + C) * 2u; voffB[i] = (unsigned)(Rb * K + C) * 2u; }
    const size_t kstep = (size_t)(BK * 2);
    const size_t hstep = (size_t)HALF * K * 2;
    const size_t tstep = 2 * hstep;
    const unsigned ldsw = (unsigned)wid * 1024u;
    const int aoff = lds_byte(wr * 64 + fr, fq * 8), boff = lds_byte(wc * 32 + fr, fq * 8);
#define PG8_SA(b, h) (((b) * 2 + (h)) * HTB)
#define PG8_SB(b, h) ((4 + (b) * 2 + (h)) * HTB)
#define PG8_STAGE(bufoff, gbase, voff) do { _Pragma("unroll") for (int _i = 0; _i < 2; ++_i) \
        __builtin_amdgcn_global_load_lds((const unsigned*)((const char*)(gbase) + (voff)[_i]), (PG8_LAS unsigned*)(lds + (bufoff) + ldsw + _i * 8192), 16, 0, 0); } while (0)
#define PG8_LDA(dst, b, h) do { _Pragma("unroll") for (int m = 0; m < 4; ++m) _Pragma("unroll") for (int k = 0; k < 2; ++k) dst[m][k] = *(const PG8_LAS bf16x8*)(lds + PG8_SA(b, h) + aoff + m * 2048 + k * 1024); } while (0)
#define PG8_LDB(dst, b, h) do { _Pragma("unroll") for (int n = 0; n < 2; ++n) _Pragma("unroll") for (int k = 0; k < 2; ++k) dst[n][k] = *(const PG8_LAS bf16x8*)(lds + PG8_SB(b, h) + boff + n * 2048 + k * 1024); } while (0)
#define PG8_MMA(ai, bj, At, Bt) do { __builtin_amdgcn_s_setprio(1); _Pragma("unroll") for (int m = 0; m < 4; ++m) _Pragma("unroll") for (int n = 0; n < 2; ++n) _Pragma("unroll") for (int k = 0; k < 2; ++k) \
        acc[ai][bj][m][n] = __builtin_amdgcn_mfma_f32_16x16x32_bf16(Bt[n][k], At[m][k], acc[ai][bj][m][n], 0, 0, 0); __builtin_amdgcn_s_setprio(0); } while (0)
#define PG8_WAIT_V(n) asm volatile("s_waitcnt vmcnt(" #n ")" ::: "memory")
#define PG8_WAIT_L(n) asm volatile("s_waitcnt lgkmcnt(" #n ")" ::: "memory")
#define PG8_BAR __builtin_amdgcn_s_barrier()
#define PG8_SCHED __builtin_amdgcn_sched_barrier(0)
    Unit cur, nxt; int ui = 0;
    if (!S.next(0, cur)) return;
    f32x4 acc[2][2][4][2];
#pragma unroll
    for (int a = 0; a < 2; ++a)
#pragma unroll
        for (int b = 0; b < 2; ++b)
#pragma unroll
            for (int m = 0; m < 4; ++m)
#pragma unroll
                for (int n = 0; n < 2; ++n) acc[a][b][m][n] = (f32x4){0.f, 0.f, 0.f, 0.f};
    bf16x8 At[4][2], B0[2][2], B1[2][2];
    const char* cA = (const char*)g.A + (size_t)cur.pm * tstep + (size_t)cur.k0 * (BK * 2); const char* cB = (const char*)g.Bt + (size_t)cur.pn * tstep + (size_t)cur.k0 * (BK * 2);
    S.a_ready(cur);
    if constexpr (SP2) {
        PG8_STAGE(PG8_SB(0, 0), cB, voffB); PG8_STAGE(PG8_SB(0, 1), cB + hstep, voffB); PG8_STAGE(PG8_SA(0, 0), cA, voffA); PG8_STAGE(PG8_SA(0, 1), cA + hstep, voffA);
        if (wr == 1) PG8_BAR;
        PG8_WAIT_V(2); PG8_BAR;
        PG8_STAGE(PG8_SB(1, 0), cB + kstep, voffB); PG8_STAGE(PG8_SA(1, 0), cA + kstep, voffA); PG8_STAGE(PG8_SB(1, 1), cB + hstep + kstep, voffB);
        PG8_WAIT_V(6); PG8_BAR;
    } else {
        PG8_STAGE(PG8_SB(0, 0), cB, voffB); PG8_STAGE(PG8_SA(0, 0), cA, voffA); PG8_STAGE(PG8_SB(0, 1), cB + hstep, voffB); PG8_STAGE(PG8_SA(0, 1), cA + hstep, voffA);
        if (wr == 1) PG8_BAR;
        PG8_WAIT_V(4); PG8_BAR;
        PG8_STAGE(PG8_SB(1, 0), cB + kstep, voffB); PG8_STAGE(PG8_SA(1, 0), cA + kstep, voffA); PG8_STAGE(PG8_SB(1, 1), cB + hstep + kstep, voffB);
        PG8_WAIT_V(6); PG8_BAR;
    }
    for (;;) {
        const bool has_next = S.next(ui + 1, nxt);
        const char* nA = has_next ? (const char*)g.A + (size_t)nxt.pm * tstep + (size_t)nxt.k0 * (BK * 2) : cA; const char* nB = has_next ? (const char*)g.Bt + (size_t)nxt.pn * tstep + (size_t)nxt.k0 * (BK * 2) : cB;
        const int nt = cur.nk;
        for (int t = 0; t < nt; t += 2) {
            const bool last = (t == nt - 2);
            const char* a1 = cA + (size_t)(t + 1) * kstep;
            const char* a2 = last ? nA : cA + (size_t)(t + 2) * kstep; const char* b2 = last ? nB : cB + (size_t)(t + 2) * kstep;
            const char* a3 = a2 + kstep; const char* b3 = b2 + kstep;
            if (last && has_next) S.a_ready(nxt);
            if constexpr (SP2) {
            PG8_LDB(B0, 0, 0); PG8_LDB(B1, 0, 1); PG8_SCHED; PG8_LDA(At, 0, 0); PG8_STAGE(PG8_SA(1, 1), a1 + hstep, voffA);
            PG8_WAIT_V(8); PG8_WAIT_L(0); PG8_BAR; PG8_MMA(0, 0, At, B0); PG8_MMA(0, 1, At, B1); PG8_BAR; PG8_SCHED;
            PG8_LDA(At, 0, 1); PG8_STAGE(PG8_SB(0, 0), b2, voffB); PG8_STAGE(PG8_SB(0, 1), b2 + hstep, voffB); PG8_STAGE(PG8_SA(0, 0), a2, voffA);
            PG8_WAIT_V(8); PG8_WAIT_L(0); PG8_BAR; PG8_MMA(1, 0, At, B0); PG8_MMA(1, 1, At, B1); PG8_BAR; PG8_SCHED;
            PG8_LDB(B0, 1, 0); PG8_LDB(B1, 1, 1); PG8_SCHED; PG8_LDA(At, 1, 0); PG8_STAGE(PG8_SA(0, 1), a2 + hstep, voffA);
            PG8_WAIT_V(8); PG8_WAIT_L(0); PG8_BAR; PG8_MMA(0, 0, At, B0); PG8_MMA(0, 1, At, B1); PG8_BAR; PG8_SCHED;
            PG8_LDA(At, 1, 1); PG8_STAGE(PG8_SB(1, 0), b3, voffB); PG8_STAGE(PG8_SB(1, 1), b3 + hstep, voffB); PG8_STAGE(PG8_SA(1, 0), a3, voffA);
            PG8_WAIT_V(8); PG8_WAIT_L(0); PG8_BAR; PG8_MMA(1, 0, At, B0); PG8_MMA(1, 1, At, B1); PG8_BAR; PG8_SCHED;
            } else {
            PG8_LDB(B0, 0, 0); PG8_SCHED; PG8_LDA(At, 0, 0); PG8_STAGE(PG8_SA(1, 1), a1 + hstep, voffA);
            PG8_WAIT_L(8); PG8_BAR; PG8_WAIT_L(0); PG8_MMA(0, 0, At, B0); PG8_BAR; PG8_SCHED;
            PG8_LDB(B1, 0, 1); PG8_STAGE(PG8_SB(0, 0), b2, voffB);
            PG8_BAR; PG8_WAIT_L(0); PG8_MMA(0, 1, At, B1); PG8_BAR;
            PG8_LDA(At, 0, 1); PG8_STAGE(PG8_SA(0, 0), a2, voffA);
            PG8_BAR; PG8_WAIT_L(0); PG8_MMA(1, 0, At, B0); PG8_BAR; PG8_SCHED;
            PG8_STAGE(PG8_SB(0, 1), b2 + hstep, voffB);
            PG8_WAIT_V(6); PG8_BAR; PG8_MMA(1, 1, At, B1); PG8_BAR;
            PG8_LDB(B0, 1, 0); PG8_SCHED; PG8_LDA(At, 1, 0); PG8_STAGE(PG8_SA(0, 1), a2 + hstep, voffA);
            PG8_WAIT_L(8); PG8_BAR; PG8_WAIT_L(0); PG8_MMA(0, 0, At, B0); PG8_BAR; PG8_SCHED;
            PG8_LDB(B1, 1, 1); PG8_STAGE(PG8_SB(1, 0), b3, voffB);
            PG8_BAR; PG8_WAIT_L(0); PG8_MMA(0, 1, At, B1); PG8_BAR;
            PG8_LDA(At, 1, 1); PG8_STAGE(PG8_SA(1, 0), a3, voffA);
            PG8_BAR; PG8_WAIT_L(0); PG8_MMA(1, 0, At, B0); PG8_BAR; PG8_SCHED;
            PG8_STAGE(PG8_SB(1, 1), b3 + hstep, voffB);
            PG8_WAIT_V(6); PG8_BAR; PG8_MMA(1, 1, At, B1); PG8_BAR;
            }
        }
        if constexpr (ALIGN_EPI) { if (wr == 0) PG8_BAR; }
        if constexpr (!Epi::AFTER_DRAIN) { E(acc, cur, wr, wc, fr, fq); S.done(cur); }
        if (!has_next) break;
#pragma unroll
        for (int a = 0; a < 2; ++a)
#pragma unroll
            for (int b = 0; b < 2; ++b)
#pragma unroll
                for (int m = 0; m < 4; ++m)
#pragma unroll
                    for (int n = 0; n < 2; ++n) acc[a][b][m][n] = (f32x4){0.f, 0.f, 0.f, 0.f};
        cur = nxt; cA = nA; cB = nB; ++ui;
        if constexpr (ALIGN_EPI) { if (wr == 1) PG8_BAR; }
    }
    PG8_WAIT_V(0);
    if constexpr (!ALIGN_EPI) { if (wr == 0) PG8_BAR; }
    PG8_BAR;
    if constexpr (Epi::AFTER_DRAIN) { E.fused(acc, cur, wr, wc, fr, fq, lds, wid, lane); S.done(cur); }
#undef PG8_SA
#undef PG8_SB
#undef PG8_STAGE
#undef PG8_LDA
#undef PG8_LDB
#undef PG8_MMA
#undef PG8_WAIT_V
#undef PG8_WAIT_L
#undef PG8_BAR
#undef PG8_SCHED
}
}
constexpr int NWAVES = 8;
constexpr int DM = 4096, TP = 8192, NSB = 128, NST = 4, MROWS = TP + NSB * NST;
constexpr int PROJ_W = 11296, PROJ_PAD = 11520, PW = 11264;
constexpr int C_QA = 0, C_KA = 2048, C_VA = 2560, C_QKVG = 3072, C_ZG = 9216;
constexpr int FF = 11008, NGU = 2 * FF;
constexpr float NORM_EPS = 1e-6f;
constexpr size_t O_YP = 0, O_YS = 33554432, O_PWK = 35651584, O_PWV = 35717120, O_PCONV = 35782656, O_PGDN = 35801088,
                 O_SWK = 36063232, O_SWV = 44451840, O_SCONV = 52840448, O_SGDN = 55199744, O_TOTAL = 88754176;
constexpr size_t WS_CTL = 0, CTL_ZERO_BYTES = 1u << 20;
constexpr size_t WS_WIN = CTL_ZERO_BYTES;
constexpr size_t WS_WOUT = WS_WIN + (size_t)PROJ_PAD * DM * 2;
constexpr size_t WS_WGU = WS_WOUT + (size_t)DM * DM * 2;
constexpr size_t WS_WDN = WS_WGU + (size_t)NGU * DM * 2;
constexpr size_t WS_H = WS_WDN + (size_t)DM * FF * 2;
constexpr size_t WS_MIX = WS_H + (size_t)MROWS * DM * 2;
constexpr size_t WS_FFNO = WS_H;
constexpr size_t WS_P = WS_MIX + (size_t)MROWS * DM * 2;
constexpr size_t WS_MIXO = WS_P;
constexpr size_t WS_ACT = WS_P;
constexpr size_t WS_AB = WS_P + (size_t)MROWS * PW * 2;
constexpr size_t WS_QN = WS_AB + (size_t)MROWS * 32 * 4;
constexpr size_t WS_KN = WS_QN + (size_t)NSB * NST * 2048 * 4;
constexpr size_t WS_VN = WS_KN + (size_t)NSB * NST * 2048 * 4;
constexpr size_t WS_GB = WS_VN + (size_t)NSB * NST * 2048 * 4;
constexpr size_t WS_ORAW = WS_GB + (size_t)MROWS * 32 * 4;
constexpr int NUNIT = 16 * 128;
constexpr size_t WS_WF = WS_ORAW + (size_t)MROWS * 2048 * 4;
constexpr size_t WS_KDF = WS_WF + (size_t)NUNIT * 16384;
constexpr size_t WS_QEF = WS_KDF + (size_t)NUNIT * 16384;
constexpr size_t WS_QKF = WS_QEF + (size_t)NUNIT * 16384;
constexpr size_t WS_UF = WS_QKF + (size_t)NUNIT * 8192;
constexpr size_t WS_EGL = WS_UF + (size_t)NUNIT * 32768;
constexpr size_t WS_VBG = WS_EGL + (size_t)NUNIT * 4;
constexpr size_t WS_END = WS_VBG + (size_t)NUNIT * 32768;
static_assert((size_t)MROWS * DM * 4 <= 2 * (size_t)MROWS * DM * 2 && (size_t)MROWS * FF * 2 <= (size_t)MROWS * PW * 2, "overlays");
constexpr int CW_TMO = 0, CW_CODE = 1, CW_BAR = 4096;
constexpr int RING_OFF = 0, RING_BYTES = 139264;
constexpr int LDSCTL_OFF = RING_BYTES, MISC_OFF = LDSCTL_OFF + 320;
constexpr int LDS_BYTES = 147456;
#define GAS __attribute__((address_space(1)))
#define LAS __attribute__((address_space(3)))
typedef unsigned short bf16;
typedef unsigned v4u __attribute__((ext_vector_type(4)));
typedef unsigned v2u __attribute__((ext_vector_type(2)));
typedef float f32x4 __attribute__((ext_vector_type(4)));
typedef short bf16x8 __attribute__((ext_vector_type(8)));
typedef GAS unsigned gu32;
#define RLX_AGENT __ATOMIC_RELAXED, __HIP_MEMORY_SCOPE_AGENT
#define LDS_WAIT() asm volatile("s_waitcnt lgkmcnt(0)" ::: "memory")
#define VM_WAIT() asm volatile("s_waitcnt vmcnt(0)" ::: "memory")
#define LDS_BAR() do { asm volatile("s_waitcnt lgkmcnt(0)" ::: "memory"); __builtin_amdgcn_s_barrier(); asm volatile("" ::: "memory"); } while (0)
__device__ __forceinline__ unsigned f2bf(float f) { unsigned u = __builtin_bit_cast(unsigned, f); return (u + 0x7fffu + ((u >> 16) & 1u)) >> 16; }
__device__ __forceinline__ unsigned pk2(float lo, float hi) { return f2bf(lo) | (f2bf(hi) << 16); }
__device__ __forceinline__ float bf2f(unsigned short b) { return __builtin_bit_cast(float, ((unsigned)b) << 16); }
__device__ __forceinline__ float bflo(unsigned w) { return __builtin_bit_cast(float, w << 16); }
__device__ __forceinline__ float bfhi(unsigned w) { return __builtin_bit_cast(float, w & 0xffff0000u); }
__device__ __forceinline__ float wave_sum(float v) {
#pragma unroll
    for (int o = 1; o < 64; o <<= 1) v += __shfl_xor(v, o);
    return v;
}
__device__ __forceinline__ float wave_max(float v) {
#pragma unroll
    for (int o = 1; o < 64; o <<= 1) v = fmaxf(v, __shfl_xor(v, o));
    return v;
}
__device__ __forceinline__ float sigmoid_f(float x) { return 1.0f / (1.0f + __expf(-x)); }
__device__ __forceinline__ float silu_f(float x) { return x / (1.0f + __expf(-x)); }
__device__ __forceinline__ float softplus_f(float x) { return fmaxf(x, 0.f) + log1pf(__expf(-fabsf(x))); }
#define XB_TMO      128
#define XB_XCNT(j)  (256  + 64 * (j))
#define XB_XSUB(j)  (1280 + 64 * (j))
#define XB_XGEN(j)  (2304 + 64 * (j))
#define XB_TOP      3328
#define XB_TOPGEN   3392
#define XCD_BAR_WORDS 3456
#define XB_SPIN_CAP (1u << 18)

__device__ __forceinline__ unsigned xb_ld(unsigned* p)              { return __hip_atomic_load(p, __ATOMIC_RELAXED, __HIP_MEMORY_SCOPE_AGENT); }
__device__ __forceinline__ unsigned xb_add(unsigned* p, unsigned v) { return __hip_atomic_fetch_add(p, v, __ATOMIC_RELAXED, __HIP_MEMORY_SCOPE_AGENT); }
__device__ __forceinline__ unsigned xb_xcc_id() { return (unsigned)__builtin_amdgcn_s_getreg((3 << 11) | 20) & 0xFu; }
#define XB_SPIN(cond, bar) do { unsigned _sp = 0; while (cond) { __builtin_amdgcn_s_sleep(1); \
    if ((++_sp & 255u) == 0u) { if (xb_ld(&(bar)[XB_TMO])) break; if (_sp > XB_SPIN_CAP) { atomicAdd(&(bar)[XB_TMO], 1u); break; } } } } while (0)

struct XcdBarrier {
    unsigned* bar; unsigned x;
    volatile LAS unsigned* st;
};

__device__ __forceinline__ XcdBarrier xcd_barrier_post(unsigned* bar, volatile LAS unsigned* st) {
    XcdBarrier b; b.bar = bar; b.x = xb_xcc_id(); b.st = st;
    if (threadIdx.x == 0) (void)xb_add(&bar[XB_XCNT(b.x)], 1u);
    return b;
}
__device__ __forceinline__ void xcd_barrier_complete(unsigned* bar, unsigned x, unsigned& nloc, unsigned& nx) {
    const unsigned G = gridDim.x * gridDim.y * gridDim.z;
    unsigned sum, cnt, mine, sp = 0u;
    for (;;) {
        sum = 0u; cnt = 0u; mine = 0u;
#pragma unroll
        for (unsigned j = 0; j < 16; ++j) { const unsigned c = xb_ld(&bar[XB_XCNT(j)]); sum += c; cnt += (c > 0u) ? 1u : 0u; mine = (j == x) ? c : mine; }
        if (sum == G) break;
        __builtin_amdgcn_s_sleep(1);
        if ((++sp & 255u) == 0u) { if (xb_ld(&bar[XB_TMO])) break; if (sp > XB_SPIN_CAP) { atomicAdd(&bar[XB_TMO], 1u); break; } }
    }
    nloc = mine > 0u ? mine : 1u; nx = cnt > 0u ? cnt : 1u;
}

__device__ __forceinline__ void xcd_barrier(const XcdBarrier& b) {
    asm volatile("s_waitcnt vmcnt(0)" ::: "memory");
    __syncthreads();
    if (threadIdx.x == 0) {
        unsigned* bar = b.bar;
        __builtin_amdgcn_s_waitcnt(0);
        unsigned nloc = b.st[0], nx = b.st[1];
        if (nloc == 0u) { xcd_barrier_complete(bar, b.x, nloc, nx); b.st[0] = nloc; b.st[1] = nx; }
        const unsigned old = xb_add(&bar[XB_XSUB(b.x)], 1u);
        const unsigned gen = old / nloc;
        if (old + 1u == (gen + 1u) * nloc) {
            __builtin_amdgcn_fence(__ATOMIC_RELEASE, "agent");
            asm volatile("s_waitcnt vmcnt(0)" ::: "memory");
            const unsigned og = xb_add(&bar[XB_TOP], 1u);
            const unsigned tg = og / nx;
            if (og + 1u == (tg + 1u) * nx) xb_add(&bar[XB_TOPGEN], 1u);
            else XB_SPIN(xb_ld(&bar[XB_TOPGEN]) == tg, bar);
            __builtin_amdgcn_fence(__ATOMIC_ACQUIRE, "agent");
            xb_add(&bar[XB_XGEN(b.x)], 1u);
            asm volatile("s_waitcnt vmcnt(0)" ::: "memory");
        } else {
            XB_SPIN(xb_ld(&bar[XB_XGEN(b.x)]) == gen, bar);
            __builtin_amdgcn_fence(__ATOMIC_ACQUIRE, "agent");
            asm volatile("s_waitcnt vmcnt(0)" ::: "memory");
        }
    }
    __syncthreads();
}
struct Params {
    const float* in[21]; float* out; unsigned char* ws; int ph_lo, ph_hi, li, pad;
};
struct Frame {
    LAS unsigned char* lds;
    volatile LAS unsigned* MISC;
    gu32* ctl;
    int tid, lane, wave, vcu, G;
};
__device__ __forceinline__ void p0_transpose_item(const float* W, int K, int N, bf16* WT, int k0, int n0, int dst_row0, LAS float* scr, int lane) {
#pragma unroll 8
    for (int i = 0; i < 32; ++i) { const int kk = 2 * i + (lane >> 5); scr[kk * 33 + (lane & 31)] = W[(size_t)(k0 + kk) * N + n0 + (lane & 31)]; }
    LDS_WAIT(); asm volatile("" ::: "memory");
    const int c = lane & 7;
#pragma unroll
    for (int j = 0; j < 4; ++j) { const int n = (lane >> 3) + 8 * j; const LAS float* s = scr + (8 * c) * 33 + n;
        v4u o; o.x = pk2(s[0 * 33], s[1 * 33]); o.y = pk2(s[2 * 33], s[3 * 33]); o.z = pk2(s[4 * 33], s[5 * 33]); o.w = pk2(s[6 * 33], s[7 * 33]);
        *(GAS v4u*)(WT + (size_t)(dst_row0 + n) * K + k0 + 8 * c) = o; }
    LDS_WAIT(); asm volatile("" ::: "memory");
}
__device__ __forceinline__ const float* x_row(const Params& p, int m) { return m < TP ? p.in[0] + (size_t)m * DM : p.in[1] + (size_t)(m - TP) * DM; }
__device__ __forceinline__ void rms_row_to_bf16(const float* xrow, const float* w, bf16* orow, int lane) {
    const GAS f32x4* xr = (const GAS f32x4*)xrow + lane; const GAS f32x4* wr = (const GAS f32x4*)w + lane;
    f32x4 v[16]; float s = 0.f;
#pragma unroll
    for (int j = 0; j < 16; ++j) { v[j] = xr[64 * j]; s += (v[j].x * v[j].x + v[j].y * v[j].y) + (v[j].z * v[j].z + v[j].w * v[j].w); }
    const float r = rsqrtf(wave_sum(s) * (1.f / DM) + NORM_EPS);
    GAS v2u* o8 = (GAS v2u*)orow + lane;
#pragma unroll
    for (int j = 0; j < 16; ++j) { const f32x4 ww = wr[64 * j]; v2u o; o.x = pk2(v[j].x * r * ww.x, v[j].y * r * ww.y); o.y = pk2(v[j].z * r * ww.z, v[j].w * r * ww.w); o8[64 * j] = o; }
}
__device__ __forceinline__ void p0_prologue(Frame& F, const Params& p) {
    LAS float* scr = (LAS float*)(F.lds + RING_OFF + F.wave * 16384);
    const int gw = F.vcu * NWAVES + F.wave, NGW = F.G * NWAVES;
    unsigned char* ws = p.ws;
    bf16* Win_t = (bf16*)(ws + WS_WIN); bf16* Wout_t = (bf16*)(ws + WS_WOUT); bf16* Wgu_t = (bf16*)(ws + WS_WGU);
    constexpr int I_IN = (DM / 64) * (PROJ_W / 32), I_OUT = (DM / 64) * (DM / 32), I_G = (DM / 64) * (FF / 32);
    constexpr int NITEMS = I_IN + I_OUT + I_G;
    for (int it = gw; it < NITEMS; it += NGW) {
        int r = it;
        if (r < I_IN) { const int nb = r % (PROJ_W / 32), kb = r / (PROJ_W / 32); p0_transpose_item(p.in[7], DM, PROJ_W, Win_t, 64 * kb, 32 * nb, 32 * nb, scr, F.lane); continue; } r -= I_IN;
        if (r < I_OUT) { const int nb = r % (DM / 32), kb = r / (DM / 32); p0_transpose_item(p.in[13], DM, DM, Wout_t, 64 * kb, 32 * nb, 32 * nb, scr, F.lane); continue; } r -= I_OUT;
        { const int nb = r % (FF / 32), kb = r / (FF / 32), n0 = 32 * nb; p0_transpose_item(p.in[18], DM, FF, Wgu_t, 64 * kb, n0, 256 * (n0 >> 7) + (n0 & 127), scr, F.lane); }
    }
    { GAS v4u* z = (GAS v4u*)(Win_t + (size_t)PROJ_W * DM); const size_t n16 = (size_t)(PROJ_PAD - PROJ_W) * DM * 2 / 16;
      for (size_t i = (size_t)gw * 64 + F.lane; i < n16; i += (size_t)NGW * 64) z[i] = (v4u){0u, 0u, 0u, 0u}; }
    bf16* H = (bf16*)(ws + WS_H);
    for (int m = gw; m < MROWS; m += NGW) rms_row_to_bf16(x_row(p, m), p.in[14], H + (size_t)m * DM, F.lane);
}
__device__ __forceinline__ void w_down_convert(const Frame& F, const Params& p, int wi, int nw) {
    LAS float* scr = (LAS float*)(F.lds + RING_OFF + F.wave * 16384);
    bf16* Wdn_t = (bf16*)(p.ws + WS_WDN);
    constexpr int I_D = (FF / 64) * (DM / 32);
    for (int r = wi * NWAVES + F.wave; r < I_D; r += nw * NWAVES) { const int nb = r % (DM / 32), kb = r / (DM / 32); p0_transpose_item(p.in[20], FF, DM, Wdn_t, 64 * kb, 32 * nb, 32 * nb, scr, F.lane); }
}
__device__ __forceinline__ void w_up_convert(const Frame& F, const Params& p, int wi, int nw) {
    LAS float* scr = (LAS float*)(F.lds + RING_OFF + F.wave * 16384);
    bf16* Wgu_t = (bf16*)(p.ws + WS_WGU);
    constexpr int I_G = (DM / 64) * (FF / 32);
    for (int r = wi * NWAVES + F.wave; r < I_G; r += nw * NWAVES) { const int nb = r % (FF / 32), kb = r / (FF / 32), n0 = 32 * nb; p0_transpose_item(p.in[19], DM, FF, Wgu_t, 64 * kb, n0, 256 * (n0 >> 7) + 128 + (n0 & 127), scr, F.lane); }
}
__device__ __forceinline__ int rel_bucket_dev(int n) {
    if (n < 16) return n;
    int large = 16 + (int)(logf((float)n * 0.0625f) / 2.0794415416798357f * 16.0f);
    return large < 31 ? large : 31;
}
__device__ __forceinline__ void ph_copy_states(const Frame& F, const bf16* P, const float* ck, const float* cv, float* out) {
    const size_t gid = (size_t)F.vcu * 512 + F.tid, gs = (size_t)F.G * 512;
    for (size_t i = gid; i < 65536; i += gs) { const size_t j = i >> 9, c = i & 511; out[O_PWK + i] = bf2f(P[(TP - 128 + j) * PW + C_KA + c]); out[O_PWV + i] = bf2f(P[(TP - 128 + j) * PW + C_VA + c]); }
    for (size_t i = gid; i < 18432; i += gs) { const size_t r = i / 6144, c = i % 6144; out[O_PCONV + i] = bf2f(P[(TP - 3 + r) * PW + C_QKVG + c]); }
    for (size_t i = gid; i < 8388608; i += gs) { const size_t b = i >> 16, j = ((i >> 9) & 127) + 4, c = i & 511;
        float k, v;
        if (j < 128) { k = ck[(b * 128 + j) * 512 + c]; v = cv[(b * 128 + j) * 512 + c]; }
        else { const size_t r = TP + 4 * b + (j - 128); k = bf2f(P[r * PW + C_KA + c]); v = bf2f(P[r * PW + C_VA + c]); }
        out[O_SWK + i] = k; out[O_SWV + i] = v; }
    for (size_t i = gid; i < 2359296; i += gs) { const size_t b = i / 18432, r = (i % 18432) / 6144, c = i % 6144; out[O_SCONV + i] = bf2f(P[(TP + 4 * b + r + 1) * PW + C_QKVG + c]); }
}
__device__ __forceinline__ void ph_gated_norm(const Frame& F, const float* ORAW, const bf16* P, const float* gw, bf16* MIX, int row_lo, int row_hi) {
    const int lane = F.lane;
    for (int g = row_lo * 16 + F.vcu * NWAVES + F.wave; g < row_hi * 16; g += F.G * NWAVES) {
        const int row = g >> 4, h = g & 15;
        const float o0 = ORAW[(size_t)row * 2048 + h * 128 + 2 * lane], o1 = ORAW[(size_t)row * 2048 + h * 128 + 2 * lane + 1];
        const float r = rsqrtf(wave_sum(o0 * o0 + o1 * o1) * (1.f / 128.f) + NORM_EPS);
        const unsigned z = *(const unsigned*)(P + (size_t)row * PW + C_ZG + h * 128 + 2 * lane);
        const float y0 = o0 * r * gw[2 * lane] * silu_f(bflo(z)), y1 = o1 * r * gw[2 * lane + 1] * silu_f(bfhi(z));
        *(unsigned*)(MIX + (size_t)row * DM + 2048 + h * 128 + 2 * lane) = pk2(y0, y1);
    }
}
__device__ __forceinline__ f32x4 gemm_row_ld(const bf16* C, const float* slab, int row, int idx4) {
    if (row < TP) { const v2u w = ((const v2u*)(C + (size_t)row * DM))[idx4]; return (f32x4){bflo(w.x), bfhi(w.x), bflo(w.y), bfhi(w.y)}; }
    const f32x4* s = (const f32x4*)(slab + (size_t)(row - TP) * DM) + idx4; constexpr size_t st = (size_t)NSB * NST * DM / 4;
    return ((s[0] + s[st]) + (s[2 * st] + s[3 * st])) + ((s[4 * st] + s[5 * st]) + (s[6 * st] + s[7 * st]));
}
__device__ __forceinline__ void ph_postmix(const Frame& F, const Params& p, const bf16* MIXO, const float* SLAB, float* out, bf16* H) {
    const int lane = F.lane; const float* w_post = p.in[15]; const float* w_pre = p.in[16];
    for (int row = F.vcu * NWAVES + F.wave; row < MROWS; row += F.G * NWAVES) {
        const float* xrow = x_row(p, row);
        const f32x4* xr = (const f32x4*)xrow + lane;
        f32x4 v[16]; float s = 0.f;
#pragma unroll
        for (int j = 0; j < 16; ++j) { v[j] = gemm_row_ld(MIXO, SLAB, row, lane + 64 * j); s += (v[j].x * v[j].x + v[j].y * v[j].y) + (v[j].z * v[j].z + v[j].w * v[j].w); }
        const float r = rsqrtf(wave_sum(s) * (1.f / DM) + NORM_EPS); float s2 = 0.f;
        f32x4* orow = (f32x4*)(out + (size_t)row * DM) + lane;
#pragma unroll
        for (int j = 0; j < 16; ++j) { const f32x4 w = ((const f32x4*)w_post)[lane + 64 * j], x = xr[64 * j];
            v[j].x = x.x + v[j].x * r * w.x; v[j].y = x.y + v[j].y * r * w.y; v[j].z = x.z + v[j].z * r * w.z; v[j].w = x.w + v[j].w * r * w.w;
            orow[64 * j] = v[j]; s2 += (v[j].x * v[j].x + v[j].y * v[j].y) + (v[j].z * v[j].z + v[j].w * v[j].w); }
        const float r2 = rsqrtf(wave_sum(s2) * (1.f / DM) + NORM_EPS);
        v2u* hrow = (v2u*)(H + (size_t)row * DM) + lane;
#pragma unroll
        for (int j = 0; j < 16; ++j) { const f32x4 w = ((const f32x4*)w_pre)[lane + 64 * j]; v2u o; o.x = pk2(v[j].x * r2 * w.x, v[j].y * r2 * w.y); o.y = pk2(v[j].z * r2 * w.z, v[j].w * r2 * w.w); hrow[64 * j] = o; }
    }
}
__device__ __forceinline__ void ph_final(const Frame& F, const bf16* FFNO, const float* SLAB, const float* w_post, float* out) {
    const int lane = F.lane;
    for (int row = F.vcu * NWAVES + F.wave; row < MROWS; row += F.G * NWAVES) {
        f32x4* orow = (f32x4*)(out + (size_t)row * DM) + lane;
        f32x4 v[16]; float s = 0.f;
#pragma unroll
        for (int j = 0; j < 16; ++j) { v[j] = gemm_row_ld(FFNO, SLAB, row, lane + 64 * j); s += (v[j].x * v[j].x + v[j].y * v[j].y) + (v[j].z * v[j].z + v[j].w * v[j].w); }
        const float r = rsqrtf(wave_sum(s) * (1.f / DM) + NORM_EPS);
#pragma unroll
        for (int j = 0; j < 16; ++j) { const f32x4 w = ((const f32x4*)w_post)[lane + 64 * j], x = orow[64 * j];
            orow[64 * j] = (f32x4){x.x + v[j].x * r * w.x, x.y + v[j].y * r * w.y, x.z + v[j].z * r * w.z, x.w + v[j].w * r * w.w}; }
    }
}
__device__ __forceinline__ unsigned off_b(unsigned row, unsigned ch) { return 256u * row + 16u * (ch ^ (((row & 3) << 2) | ((row >> 2) & 3))); }
__device__ __forceinline__ unsigned row_read_addr_16(unsigned lane, unsigned rb, unsigned s) { return off_b((lane & 15) + 16 * rb, 4 * s + (lane >> 4)); }
__device__ __forceinline__ unsigned tr_read_addr_16(unsigned lane, unsigned c, unsigned ks, unsigned t) {
    const unsigned g = lane >> 4, q = (lane & 15) >> 2, p = lane & 3;
    return off_b(32 * ks + 8 * g + 4 * t + q, 2 * c + (p >> 1)) + 8 * (p & 1);
}
typedef short s16x4 __attribute__((ext_vector_type(4)));
__device__ __forceinline__ unsigned lds_addr(const LAS unsigned char* p) { return (unsigned)(__UINTPTR_TYPE__)p; }
__device__ __forceinline__ s16x4 tr_read_wait(unsigned a) { s16x4 r; asm volatile("ds_read_b64_tr_b16 %0, %1\n\ts_waitcnt lgkmcnt(0)" : "=&v"(r) : "v"(a) : "memory"); return r; }
__device__ __forceinline__ bf16x8 tr_frag(unsigned base, unsigned lane, unsigned c, unsigned ks) {
    const s16x4 lo = tr_read_wait(base + tr_read_addr_16(lane, c, ks, 0)), hi = tr_read_wait(base + tr_read_addr_16(lane, c, ks, 1));
    return (bf16x8){lo[0], lo[1], lo[2], lo[3], hi[0], hi[1], hi[2], hi[3]};
}
__device__ __forceinline__ v4u pack8(const float* y) { v4u o; o.x = pk2(y[0], y[1]); o.y = pk2(y[2], y[3]); o.z = pk2(y[4], y[5]); o.w = pk2(y[6], y[7]); return o; }
struct ScanBufs { bf16* wF; bf16* kdF; bf16* qeF; bf16* qkF; float* uF; float* egl; unsigned char* vbg; };
constexpr int PREP_B = 4;
constexpr int PA_SLOT = 17408;
constexpr int PA_IMG = PREP_B * PA_SLOT;
constexpr int PA_MSC = PA_IMG + 65536;
__device__ __forceinline__ void gdn_prep_a(const Frame& F, int un, int slot, const bf16* P, const float* AB, const float* conv_w, const float* a_log, const float* dt_bias, const ScanBufs sb) {
    constexpr int KIMG = PA_IMG, QIMG = PA_IMG + 16384, QEIMG = PA_IMG + 32768, KDIMG = PA_IMG + 49152, QKB = QIMG;
    LAS unsigned char* L = F.lds + RING_OFF;
    LAS float* gcs = (LAS float*)(L + PA_MSC); LAS float* bts = gcs + 64; LAS float* Af = (LAS float*)(L + slot * PA_SLOT);
    int zv = 0; asm volatile("" : "+v"(zv));
    const int tid = F.tid + zv, lane = tid & 63, wave = F.wave, quad = lane >> 4, l15 = lane & 15;
    const int h = un >> 7, n = un & 127, row0 = 64 * n;
    const int part = tid >> 7, tok0 = ((tid >> 4) & 7) * 8, cl = tid & 15, ch = part * 2048 + h * 128 + cl * 8;
    v4u xw[11]; f32x4 w0[4], w1[4];
    unsigned char* vbg = sb.vbg + (size_t)un * 32768;
    if (tid < 384) {
#pragma unroll
        for (int k = 0; k < 11; ++k) { const int r = row0 + tok0 - 3 + k, rc = r < 0 ? 0 : r; xw[k] = *(const v4u*)(P + (size_t)rc * PW + C_QKVG + ch); if (r < 0) xw[k] = (v4u){0u, 0u, 0u, 0u}; }
#pragma unroll
        for (int i = 0; i < 4; ++i) { const float* wp = conv_w + (size_t)i * 6144 + ch; w0[i] = *(const f32x4*)wp; w1[i] = *(const f32x4*)(wp + 4); }
    } else if (wave == 6) {
        const float a = AB[(size_t)(row0 + lane) * 32 + h], bb = AB[(size_t)(row0 + lane) * 32 + 16 + h];
        float g = -__expf(a_log[h]) * softplus_f(a + dt_bias[h]);
#pragma unroll
        for (int o = 1; o < 64; o <<= 1) { const float t = __shfl_up(g, o); if (lane >= o) g += t; }
        gcs[lane] = g; bts[lane] = sigmoid_f(bb);
    }
    LDS_BAR();
    const float glast = gcs[63];
    if (tid < 384) {
#pragma unroll
        for (int t = 0; t < 8; ++t) {
            const int tok = tok0 + t; float y[8];
#pragma unroll
            for (int e = 0; e < 8; ++e) y[e] = 0.f;
#pragma unroll
            for (int i = 0; i < 4; ++i) { const v4u w = xw[t + i];
                y[0] += bflo(w.x) * w0[i].x; y[1] += bfhi(w.x) * w0[i].y; y[2] += bflo(w.y) * w0[i].z; y[3] += bfhi(w.y) * w0[i].w;
                y[4] += bflo(w.z) * w1[i].x; y[5] += bfhi(w.z) * w1[i].y; y[6] += bflo(w.w) * w1[i].z; y[7] += bfhi(w.w) * w1[i].w; }
            float ss = 0.f;
#pragma unroll
            for (int e = 0; e < 8; ++e) { y[e] = silu_f(y[e]); ss += y[e] * y[e]; }
            const float gc = gcs[tok], be = bts[tok], egc = __expf(gc), ekd = __expf(glast - gc);
            const unsigned o = off_b(tok, cl); float t8[8];
            if (part < 2) {
#pragma unroll
                for (int sh = 1; sh < 16; sh <<= 1) ss += __shfl_xor(ss, sh);
                const float rn = rsqrtf(ss + NORM_EPS) * (part == 0 ? 0.08838834764831845f : 1.0f);
#pragma unroll
                for (int e = 0; e < 8; ++e) y[e] *= rn;
            }
            if (part == 0) {
                *(LAS v4u*)(L + QIMG + o) = pack8(y);
#pragma unroll
                for (int e = 0; e < 8; ++e) t8[e] = y[e] * egc;
                *(LAS v4u*)(L + QEIMG + o) = pack8(t8);
            } else if (part == 1) {
                *(LAS v4u*)(L + KIMG + o) = pack8(y);
#pragma unroll
                for (int e = 0; e < 8; ++e) t8[e] = y[e] * (be * egc);
                *(v4u*)(vbg + 16384 + o) = pack8(t8);
#pragma unroll
                for (int e = 0; e < 8; ++e) t8[e] = y[e] * ekd;
                *(LAS v4u*)(L + KDIMG + o) = pack8(t8);
            } else {
#pragma unroll
                for (int e = 0; e < 8; ++e) t8[e] = y[e] * be;
                *(v4u*)(vbg + o) = pack8(t8);
            }
        }
    }
    LDS_BAR();
    f32x4 accj[3];
#pragma unroll
    for (int r = 0; r < 3; ++r) {
        const int job = wave + 8 * r; accj[r] = (f32x4){0.f, 0.f, 0.f, 0.f};
        if (job < 20) {
            const int idx = job < 10 ? job : job - 10, ti = idx >= 6 ? 3 : idx >= 3 ? 2 : idx >= 1 ? 1 : 0, tj = idx - ti * (ti + 1) / 2;
            const int aimg = job < 10 ? KIMG : QIMG;
#pragma unroll
            for (int s = 0; s < 4; ++s) { const bf16x8 a = *(const LAS bf16x8*)(L + aimg + row_read_addr_16(lane, ti, s)), b = *(const LAS bf16x8*)(L + KIMG + row_read_addr_16(lane, tj, s));
                accj[r] = __builtin_amdgcn_mfma_f32_16x16x32_bf16(a, b, accj[r], 0, 0, 0); }
        }
    }
    LDS_BAR();
#pragma unroll
    for (int r = 0; r < 3; ++r) {
        const int job = wave + 8 * r;
        if (job < 20) {
            const int idx = job < 10 ? job : job - 10, ti = idx >= 6 ? 3 : idx >= 3 ? 2 : idx >= 1 ? 1 : 0, tj = idx - ti * (ti + 1) / 2;
            const int j = 16 * tj + l15; const float gj = gcs[j];
#pragma unroll
            for (int e = 0; e < 4; ++e) { const int i = 16 * ti + 4 * quad + e; const float dec = __expf(fminf(gcs[i] - gj, 0.f));
                if (job < 10) Af[i * 68 + j] = (i > j) ? bts[i] * accj[r][e] * dec : 0.f;
                else ((LAS bf16*)(L + QKB))[i * 72 + j] = (bf16)f2bf(accj[r][e] * dec); }
        }
    }
    LDS_BAR();
    {
        const unsigned base = lds_addr(L);
#pragma unroll 1
        for (int job = wave; job < 40; job += 8) {
            if (job < 16) { const int ti = job >> 2, s = job & 3;
                *(v4u*)(sb.qeF + ((size_t)(un * 16 + job) * 64 + lane) * 8) = *(const LAS v4u*)(L + QEIMG + row_read_addr_16(lane, ti, s)); }
            else if (job < 32) { const int f = job - 16, di = f >> 1, s2 = f & 1;
                const bf16x8 fr = tr_frag(base + KDIMG, lane, di, s2);
                *(bf16x8*)(sb.kdF + ((size_t)(un * 16 + f) * 64 + lane) * 8) = fr; }
            else { const int f = job - 32, ti = f >> 1, s2 = f & 1, i = 16 * ti + l15, j0 = 32 * s2 + 8 * quad;
                v4u w = *(const LAS v4u*)(L + QKB + i * 144 + j0 * 2);
                w.x = (j0 + 0 <= i ? w.x & 0xffffu : 0u) | (j0 + 1 <= i ? w.x & 0xffff0000u : 0u); w.y = (j0 + 2 <= i ? w.y & 0xffffu : 0u) | (j0 + 3 <= i ? w.y & 0xffff0000u : 0u);
                w.z = (j0 + 4 <= i ? w.z & 0xffffu : 0u) | (j0 + 5 <= i ? w.z & 0xffff0000u : 0u); w.w = (j0 + 6 <= i ? w.w & 0xffffu : 0u) | (j0 + 7 <= i ? w.w & 0xffff0000u : 0u);
                *(v4u*)(sb.qkF + ((size_t)(un * 8 + f) * 64 + lane) * 8) = w; }
        }
    }
    if (tid == 0) sb.egl[un] = __expf(glast);
    LDS_BAR();
}
__device__ __forceinline__ void gdn_prep_c(const Frame& F, int un, int slot, const ScanBufs sb) {
    constexpr int VBIMG = PA_IMG, KGIMG = PA_IMG + 16384, WT = PA_IMG + 32768;
    LAS unsigned char* L = F.lds + RING_OFF;
    int zv = 0; asm volatile("" : "+v"(zv));
    const int tid = F.tid + zv, lane = tid & 63, wave = F.wave, quad = lane >> 4, l15 = lane & 15;
    const unsigned char* vbg = sb.vbg + (size_t)un * 32768;
#pragma unroll
    for (int it = 0; it < 4; ++it) { const int o = (tid + 512 * it) * 16; *(LAS v4u*)(L + VBIMG + o) = *(const v4u*)(vbg + o); }
    LDS_BAR();
    {
        const int ti = wave & 3, which = wave >> 2; const unsigned base = lds_addr(L) + (which ? KGIMG : VBIMG);
        bf16x8 ta[2];
#pragma unroll
        for (int s2 = 0; s2 < 2; ++s2) ta[s2] = *(const LAS bf16x8*)(L + slot * PA_SLOT + (16 * ti + l15) * 144 + (32 * s2 + 8 * quad) * 2);
#pragma unroll 2
        for (int ct = 0; ct < 8; ++ct) {
            f32x4 acc = (f32x4){0.f, 0.f, 0.f, 0.f};
            { const unsigned a0 = base + tr_read_addr_16(lane, ct, 0, 0), a1 = base + tr_read_addr_16(lane, ct, 0, 1), a2 = base + tr_read_addr_16(lane, ct, 1, 0), a3 = base + tr_read_addr_16(lane, ct, 1, 1);
              s16x4 t0, t1, t2, t3;
              asm volatile("ds_read_b64_tr_b16 %0, %4\n\tds_read_b64_tr_b16 %1, %5\n\tds_read_b64_tr_b16 %2, %6\n\tds_read_b64_tr_b16 %3, %7\n\ts_waitcnt lgkmcnt(0)"
                           : "=&v"(t0), "=&v"(t1), "=&v"(t2), "=&v"(t3) : "v"(a0), "v"(a1), "v"(a2), "v"(a3) : "memory");
              acc = __builtin_amdgcn_mfma_f32_16x16x32_bf16(ta[0], (bf16x8){t0[0], t0[1], t0[2], t0[3], t1[0], t1[1], t1[2], t1[3]}, acc, 0, 0, 0);
              acc = __builtin_amdgcn_mfma_f32_16x16x32_bf16(ta[1], (bf16x8){t2[0], t2[1], t2[2], t2[3], t3[0], t3[1], t3[2], t3[3]}, acc, 0, 0, 0); }
            if (which == 0) *(f32x4*)(sb.uF + ((size_t)((un * 4 + ti) * 8 + ct) * 64 + lane) * 4) = acc;
            else {
#pragma unroll
                for (int e = 0; e < 4; ++e) ((LAS bf16*)(L + WT))[(16 * ti + 4 * quad + e) * 136 + 16 * ct + l15] = (bf16)f2bf(acc[e]); }
        }
    }
    LDS_BAR();
#pragma unroll
    for (int it = 0; it < 2; ++it) { const int idx = tid + 512 * it, fr = idx >> 6, ln = idx & 63, ti = fr >> 2, s = fr & 3;
        *(v4u*)(sb.wF + ((size_t)(un * 16 + fr) * 64 + ln) * 8) = *(const LAS v4u*)(L + WT + (16 * ti + (ln & 15)) * 272 + (32 * s + 8 * (ln >> 4)) * 2); }
    LDS_BAR();
}
__device__ __forceinline__ void gdn_prep_invert_blocked(const Frame& F, int nslots) {
    LAS unsigned char* L = F.lds + RING_OFF;
    int zv = 0; asm volatile("" : "+v"(zv));
    const int tid = F.tid + zv, lane = tid & 63, wave = F.wave, q = lane >> 4, l15 = lane & 15;
    if (wave < nslots) {
        const LAS float* Af = (const LAS float*)(L + wave * PA_SLOT); LAS float* Tf = (LAS float*)(L + PA_IMG + wave * 16384);
        float t[16];
#pragma unroll
        for (int i = 0; i < 16; ++i) {
            const LAS float* rp = Af + (16 * q + i) * 68 + 16 * q; f32x4 ar[4];
#pragma unroll
            for (int jb = 0; jb < 4; ++jb) if (4 * jb < i) ar[jb] = *(const LAS f32x4*)(rp + 4 * jb);
            float acc = (l15 == i) ? 1.f : 0.f;
#pragma unroll
            for (int j = 0; j < i; ++j) acc -= ar[j >> 2][j & 3] * t[j];
            t[i] = acc;
        }
#pragma unroll
        for (int i = 0; i < 16; ++i) Tf[(16 * q + i) * 64 + 16 * q + l15] = t[i];
    }
    LDS_BAR();
#pragma unroll
    for (int d = 1; d < 4; ++d) {
        const int per = 4 - d, total = nslots * per;
#pragma unroll 1
        for (int job = wave; job < total; job += NWAVES) {
            const int slot = job / per, b = job - slot * per, a = b + d;
            const LAS float* Af = (const LAS float*)(L + slot * PA_SLOT); LAS float* Tf = (LAS float*)(L + PA_IMG + slot * 16384);
            f32x4 acc = (f32x4){0.f, 0.f, 0.f, 0.f};
#pragma unroll 1
            for (int c = b; c < a; ++c)
#pragma unroll
                for (int s4 = 0; s4 < 4; ++s4) acc = __builtin_amdgcn_mfma_f32_16x16x4f32(Af[(16 * a + l15) * 68 + 16 * c + 4 * s4 + q], Tf[(16 * c + 4 * s4 + q) * 64 + 16 * b + l15], acc, 0, 0, 0);
            f32x4 res = (f32x4){0.f, 0.f, 0.f, 0.f};
#pragma unroll
            for (int s4 = 0; s4 < 4; ++s4) res = __builtin_amdgcn_mfma_f32_16x16x4f32(-Tf[(16 * a + l15) * 64 + 16 * a + 4 * q + s4], acc[s4], res, 0, 0, 0);
#pragma unroll
            for (int r = 0; r < 4; ++r) Tf[(16 * a + 4 * q + r) * 64 + 16 * b + l15] = res[r];
        }
        LDS_BAR();
    }
    for (int idx = tid; idx < nslots * 4096; idx += NWAVES * 64) { const int slot = idx >> 12, e = idx & 4095, i = e >> 6, c = e & 63;
        const float v = ((c >> 4) <= (i >> 4)) ? ((const LAS float*)(L + PA_IMG + slot * 16384))[e] : 0.f;
        ((LAS bf16*)(L + slot * PA_SLOT))[i * 72 + c] = (bf16)f2bf(v); }
    LDS_BAR();
}
__device__ __forceinline__ void gdn_prep_all(const Frame& F, const bf16* P, const float* AB, const float* conv_w, const float* a_log, const float* dt_bias, const ScanBufs sb) {
#pragma unroll 1
    for (int u0 = F.vcu; u0 < NUNIT; u0 += F.G * PREP_B) {
#pragma unroll 1
        for (int s = 0; s < PREP_B; ++s) { const int un = u0 + s * F.G; if (un < NUNIT) gdn_prep_a(F, un, s, P, AB, conv_w, a_log, dt_bias, sb); }
        { int ns = 0;
#pragma unroll
          for (int k = 0; k < PREP_B; ++k) ns += (u0 + k * F.G < NUNIT) ? 1 : 0;
          gdn_prep_invert_blocked(F, ns); }
#pragma unroll 1
        for (int s = 0; s < PREP_B; ++s) { const int un = u0 + s * F.G; if (un < NUNIT) gdn_prep_c(F, un, s, sb); }
    }
}
constexpr int SCAN_D = 4;
__device__ __forceinline__ void gdn_scan_unit(const Frame& F, int h, int sl, const ScanBufs sb, float* ORAW, float* Sout) {
    constexpr int SB_PITCH = 272, VN_PITCH = 144, SB_OFF = 0, VN_OFF = 16 * SB_PITCH;
    LAS unsigned char* L = F.lds + RING_OFF;
    const int lane = F.lane, wave = F.wave, quad = lane >> 4, l15 = lane & 15;
    for (int i = F.tid; i < (16 * SB_PITCH) / 4; i += NWAVES * 64) ((LAS unsigned*)(L + SB_OFF))[i] = 0u;
    __syncthreads();
    const LAS unsigned char* sfp = L + SB_OFF + l15 * SB_PITCH + quad * 16;
    const LAS unsigned char* vfp = L + VN_OFF + l15 * VN_PITCH + quad * 16;
    if (wave < 4) {
        const int ti = wave;
        f32x4 S0 = (f32x4){0.f, 0.f, 0.f, 0.f}, S1 = S0;
        bf16x8 wf[SCAN_D][4], kdf[SCAN_D][2][2]; f32x4 uf[SCAN_D]; float gl[SCAN_D];
#define LOAD_C(un_, W, KD, U, G) do { \
        _Pragma("unroll") for (int s = 0; s < 4; ++s) W[s] = *(const bf16x8*)(sb.wF + ((size_t)((un_) * 16 + ti * 4 + s) * 64 + lane) * 8); \
        _Pragma("unroll") for (int d = 0; d < 2; ++d) _Pragma("unroll") for (int s2 = 0; s2 < 2; ++s2) KD[d][s2] = *(const bf16x8*)(sb.kdF + ((size_t)((un_) * 16 + (2 * ti + d) * 2 + s2) * 64 + lane) * 8); \
        U = *(const f32x4*)(sb.uF + ((size_t)(((un_) * 4 + ti) * 8 + sl) * 64 + lane) * 4); G = sb.egl[un_]; } while (0)
#pragma unroll
        for (int k = 0; k < SCAN_D; ++k) LOAD_C(h * 128 + k, wf[k], kdf[k], uf[k], gl[k]);
#pragma unroll 1
        for (int n0 = 0; n0 < 128; n0 += SCAN_D) {
#pragma unroll
            for (int k = 0; k < SCAN_D; ++k) {
                f32x4 acc = (f32x4){0.f, 0.f, 0.f, 0.f};
#pragma unroll
                for (int s = 0; s < 4; ++s) { const bf16x8 sf = *(const LAS bf16x8*)(sfp + s * 64); acc = __builtin_amdgcn_mfma_f32_16x16x32_bf16(wf[k][s], sf, acc, 0, 0, 0); }
                const f32x4 vn = uf[k] - acc;
                { v2u w; w.x = pk2(vn[0], vn[1]); w.y = pk2(vn[2], vn[3]); *(LAS v2u*)(L + VN_OFF + l15 * VN_PITCH + (16 * ti + 4 * quad) * 2) = w; }
                LDS_BAR();
                S0 = S0 * gl[k]; S1 = S1 * gl[k];
#pragma unroll
                for (int s2 = 0; s2 < 2; ++s2) { const bf16x8 vf = *(const LAS bf16x8*)(vfp + s2 * 64);
                    S0 = __builtin_amdgcn_mfma_f32_16x16x32_bf16(kdf[k][0][s2], vf, S0, 0, 0, 0); S1 = __builtin_amdgcn_mfma_f32_16x16x32_bf16(kdf[k][1][s2], vf, S1, 0, 0, 0); }
                { v2u w; w.x = pk2(S0[0], S0[1]); w.y = pk2(S0[2], S0[3]); *(LAS v2u*)(L + SB_OFF + l15 * SB_PITCH + (16 * (2 * ti) + 4 * quad) * 2) = w;
                  w.x = pk2(S1[0], S1[1]); w.y = pk2(S1[2], S1[3]); *(LAS v2u*)(L + SB_OFF + l15 * SB_PITCH + (16 * (2 * ti + 1) + 4 * quad) * 2) = w; }
                { const int nn = n0 + k + SCAN_D < 128 ? n0 + k + SCAN_D : 127; LOAD_C(h * 128 + nn, wf[k], kdf[k], uf[k], gl[k]); }
                LDS_BAR();
            }
        }
#undef LOAD_C
#pragma unroll
        for (int e = 0; e < 4; ++e) { Sout[((size_t)h * 128 + 16 * (2 * ti) + 4 * quad + e) * 128 + 16 * sl + l15] = S0[e]; Sout[((size_t)h * 128 + 16 * (2 * ti + 1) + 4 * quad + e) * 128 + 16 * sl + l15] = S1[e]; }
    } else {
        const int ti = wave - 4;
        bf16x8 qef[SCAN_D][4], qkf[SCAN_D][2];
#define LOAD_O(un_, QE, QK) do { \
        _Pragma("unroll") for (int s = 0; s < 4; ++s) QE[s] = *(const bf16x8*)(sb.qeF + ((size_t)((un_) * 16 + ti * 4 + s) * 64 + lane) * 8); \
        _Pragma("unroll") for (int s2 = 0; s2 < 2; ++s2) QK[s2] = *(const bf16x8*)(sb.qkF + ((size_t)((un_) * 8 + ti * 2 + s2) * 64 + lane) * 8); } while (0)
#pragma unroll
        for (int k = 0; k < SCAN_D; ++k) LOAD_O(h * 128 + k, qef[k], qkf[k]);
#pragma unroll 1
        for (int n0 = 0; n0 < 128; n0 += SCAN_D) {
#pragma unroll
            for (int k = 0; k < SCAN_D; ++k) {
                const int n = n0 + k;
                f32x4 acc = (f32x4){0.f, 0.f, 0.f, 0.f};
#pragma unroll
                for (int s = 0; s < 4; ++s) { const bf16x8 sf = *(const LAS bf16x8*)(sfp + s * 64); acc = __builtin_amdgcn_mfma_f32_16x16x32_bf16(qef[k][s], sf, acc, 0, 0, 0); }
                LDS_BAR();
#pragma unroll
                for (int s2 = 0; s2 < 2; ++s2) { const bf16x8 vf = *(const LAS bf16x8*)(vfp + s2 * 64); acc = __builtin_amdgcn_mfma_f32_16x16x32_bf16(qkf[k][s2], vf, acc, 0, 0, 0); }
#pragma unroll
                for (int e = 0; e < 4; ++e) ORAW[(size_t)(64 * n + 16 * ti + 4 * quad + e) * 2048 + h * 128 + 16 * sl + l15] = acc[e];
                { const int nn = n + SCAN_D < 128 ? n + SCAN_D : 127; LOAD_O(h * 128 + nn, qef[k], qkf[k]); }
                LDS_BAR();
            }
        }
#undef LOAD_O
    }
    __syncthreads();
}
struct SampIn { float S[32]; float in[11]; float z0, z1; };
__device__ __forceinline__ void samp_load(SampIn& I, int u, int tid, int lane, int wave, const bf16* P, const float* AB, const float* state_conv, const float* conv_w, const float* a_log, const float* dt_bias, const float* S0p) {
    const int b = u >> 4, h = u & 15, j = tid >> 2, qd = tid & 3;
#pragma unroll
    for (int i = 0; i < 32; ++i) I.S[i] = S0p[((size_t)u * 128 + qd * 32 + i) * 128 + j];
    const bool cv = tid < 384, gt = !cv && tid < 388;
    const int part = cv ? tid >> 7 : 0, ch = tid & 127, c = part * 2048 + h * 128 + ch;
    const size_t grow = (size_t)TP + 4 * b + (gt ? tid - 384 : 0);
    const float* f[7];
#pragma unroll
    for (int r = 0; r < 3; ++r) f[r] = state_conv + ((size_t)b * 3 + r) * 6144 + c;
#pragma unroll
    for (int i = 0; i < 4; ++i) f[3 + i] = conv_w + (size_t)i * 6144 + c;
    if (gt) { f[0] = AB + grow * 32 + h; f[1] = AB + grow * 32 + 16 + h; f[2] = a_log + h; f[3] = dt_bias + h; }
    I.in[0] = *f[0]; I.in[1] = *f[1]; I.in[2] = *f[2];
#pragma unroll
    for (int t = 0; t < 4; ++t) I.in[3 + t] = bf2f(P[(size_t)(TP + 4 * b + t) * PW + C_QKVG + c]);
    I.in[7] = *f[3]; I.in[8] = *f[4]; I.in[9] = *f[5]; I.in[10] = *f[6];
    const size_t zrow = (size_t)TP + 4 * b + (wave & 3); I.z0 = bf2f(P[zrow * PW + C_ZG + h * 128 + lane]); I.z1 = bf2f(P[zrow * PW + C_ZG + h * 128 + lane + 64]);
}
__device__ __forceinline__ void gdn_sample_units(const Frame& F, int u0, int ustride, const bf16* P, const float* AB, const float* state_conv, const float* conv_w, const float* a_log, const float* dt_bias,
                                                 const float* gnw, const float* S0p, float* Sout, bf16* MIX) {
    LAS float* xs = (LAS float*)(F.lds + RING_OFF);
    LAS float* os = xs + 1536;
    LAS float* gs = os + 512; LAS float* bs = gs + 4;
    const int tid = F.tid, lane = F.lane, wave = F.wave, j = tid >> 2, qd = tid & 3;
    const float gn0 = gnw[lane], gn1 = gnw[lane + 64];
    SampIn C{}, N{};
    if (u0 < NSB * 16) samp_load(C, u0, tid, lane, wave, P, AB, state_conv, conv_w, a_log, dt_bias, S0p);
#pragma unroll 1
    for (int u = u0; u < NSB * 16; u += ustride) {
        const int b = u >> 4, h = u & 15, un = u + ustride;
        if (un < NSB * 16) samp_load(N, un, tid, lane, wave, P, AB, state_conv, conv_w, a_log, dt_bias, S0p);
        if (tid < 384) {
            const int part = tid >> 7, ch = tid & 127;
#pragma unroll
            for (int t = 0; t < 4; ++t) xs[(part * 4 + t) * 128 + ch] = silu_f(C.in[t] * C.in[7] + C.in[t + 1] * C.in[8] + C.in[t + 2] * C.in[9] + C.in[t + 3] * C.in[10]);
        } else if (tid < 388) {
            const int t = tid - 384;
            gs[t] = __expf(-__expf(C.in[2]) * softplus_f(C.in[0] + C.in[7])); bs[t] = sigmoid_f(C.in[1]);
        }
        LDS_BAR();
        { const int part = wave >> 2, t = wave & 3; LAS float* xv = xs + (part * 4 + t) * 128;
          const float v0 = xv[lane], v1 = xv[lane + 64];
          const float r = rsqrtf(wave_sum(v0 * v0 + v1 * v1) + NORM_EPS) * (part == 0 ? 0.08838834764831845f : 1.0f);
          xv[lane] = v0 * r; xv[lane + 64] = v1 * r; }
        LDS_BAR();
#pragma unroll 1
        for (int t = 0; t < 4; ++t) {
            const float a = gs[t], be = bs[t], v = xs[(8 + t) * 128 + j];
            const LAS float* kr = xs + (4 + t) * 128 + qd * 32; const LAS float* qr = xs + t * 128 + qd * 32;
            float r0 = 0.f, r1 = 0.f, r2 = 0.f, r3 = 0.f;
#pragma unroll
            for (int i = 0; i < 32; i += 4) { r0 += kr[i] * C.S[i]; r1 += kr[i + 1] * C.S[i + 1]; r2 += kr[i + 2] * C.S[i + 2]; r3 += kr[i + 3] * C.S[i + 3]; }
            float r = (r0 + r1) + (r2 + r3); r += __shfl_xor(r, 1); r += __shfl_xor(r, 2);
            const float c = be * (v - a * r);
            float o0 = 0.f, o1 = 0.f, o2 = 0.f, o3 = 0.f;
#pragma unroll
            for (int i = 0; i < 32; i += 4) {
                C.S[i] = a * C.S[i] + kr[i] * c; C.S[i + 1] = a * C.S[i + 1] + kr[i + 1] * c; C.S[i + 2] = a * C.S[i + 2] + kr[i + 2] * c; C.S[i + 3] = a * C.S[i + 3] + kr[i + 3] * c;
                o0 += qr[i] * C.S[i]; o1 += qr[i + 1] * C.S[i + 1]; o2 += qr[i + 2] * C.S[i + 2]; o3 += qr[i + 3] * C.S[i + 3]; }
            float o = (o0 + o1) + (o2 + o3); o += __shfl_xor(o, 1); o += __shfl_xor(o, 2);
            if (qd == 0) os[t * 128 + j] = o;
        }
#pragma unroll
        for (int i = 0; i < 32; ++i) Sout[((size_t)u * 128 + qd * 32 + i) * 128 + j] = C.S[i];
        LDS_BAR();
        if (wave < 4) { const int t = wave; const size_t row = (size_t)TP + 4 * b + t;
            const float o0 = os[t * 128 + lane], o1 = os[t * 128 + lane + 64];
            const float r = rsqrtf(wave_sum(o0 * o0 + o1 * o1) * (1.f / 128.f) + NORM_EPS);
            MIX[row * DM + 2048 + h * 128 + lane] = (bf16)f2bf(o0 * r * gn0 * silu_f(C.z0));
            MIX[row * DM + 2048 + h * 128 + lane + 64] = (bf16)f2bf(o1 * r * gn1 * silu_f(C.z1)); }
        LDS_BAR();
        C = N;
    }
}
constexpr int ATT_KIMG = 0, ATT_VIMG = 69632, ATT_IMG_ROWS = 272;
constexpr int ATT_BTAB_OFF = MISC_OFF + 128;
__device__ __forceinline__ void attn_tile(LAS unsigned char* L, const LAS float* btab, const bf16* qptr, int kt0, int dist0, int jlo, int jhi, float sink, int g, bf16* optr, int lane) {
    const int quad = lane >> 4, l15 = lane & 15;
    bf16x8 qf[4];
#pragma unroll
    for (int s = 0; s < 4; ++s) qf[s] = *(const bf16x8*)(qptr + 32 * s + 8 * quad);
    f32x4 sc[9];
#pragma unroll
    for (int i = 0; i < 9; ++i) { sc[i] = (f32x4){0.f, 0.f, 0.f, 0.f};
#pragma unroll
        for (int s = 0; s < 4; ++s) { const bf16x8 kf = *(const LAS bf16x8*)(L + ATT_KIMG + row_read_addr_16(lane, kt0 + i, s)); sc[i] = __builtin_amdgcn_mfma_f32_16x16x32_bf16(kf, qf[s], sc[i], 0, 0, 0); } }
    float m = sink;
#pragma unroll
    for (int i = 0; i < 9; ++i)
#pragma unroll
        for (int r = 0; r < 4; ++r) { const int dist = dist0 - 16 * i - r, j = 16 * (kt0 + i) + 4 * quad + r; const bool ok = dist >= 0 && dist <= 128 && j >= jlo && j < jhi;
            const float b = btab[g * 132 + (ok ? dist : 0)]; const float v = ok ? sc[i][r] * 0.08838834764831845f + b : -3.0e38f; sc[i][r] = v; m = fmaxf(m, v); }
    m = fmaxf(m, __shfl_xor(m, 16)); m = fmaxf(m, __shfl_xor(m, 32));
    float sum = 0.f;
#pragma unroll
    for (int i = 0; i < 9; ++i)
#pragma unroll
        for (int r = 0; r < 4; ++r) { const float pv = sc[i][r] > -1.0e38f ? __expf(sc[i][r] - m) : 0.f; sc[i][r] = pv; sum += pv; }
    sum += __shfl_xor(sum, 16); sum += __shfl_xor(sum, 32);
    const float inv = 1.0f / (sum + __expf(sink - m));
    bf16x8 pf[5];
#pragma unroll
    for (int p = 0; p < 5; ++p) {
        const f32x4 a = sc[2 * p] * inv; const f32x4 b = (p < 4) ? sc[2 * p + 1 < 9 ? 2 * p + 1 : 8] * inv : (f32x4){0.f, 0.f, 0.f, 0.f};
        const unsigned w0 = pk2(a[0], a[1]), w1 = pk2(a[2], a[3]), w2 = pk2(b[0], b[1]), w3 = pk2(b[2], b[3]);
        pf[p] = __builtin_bit_cast(bf16x8, (v4u){w0, w1, w2, w3});
    }
    const unsigned vbase = lds_addr(L) + ATT_VIMG; const unsigned q4 = (unsigned)l15 >> 2, p2 = (unsigned)lane & 3;
    const unsigned vrow = 16u * (unsigned)kt0 + 4u * (unsigned)quad + q4;
#pragma unroll
    for (int c = 0; c < 8; ++c) {
        const unsigned va = vbase + off_b(vrow, 2 * c + (p2 >> 1)) + 8 * (p2 & 1);
        s16x4 t0, t1, t2, t3, t4, t5, t6, t7, t8, t9;
        asm volatile("ds_read_b64_tr_b16 %0, %10\n\tds_read_b64_tr_b16 %1, %10 offset:4096\n\tds_read_b64_tr_b16 %2, %10 offset:8192\n\tds_read_b64_tr_b16 %3, %10 offset:12288\n\t"
                     "ds_read_b64_tr_b16 %4, %10 offset:16384\n\tds_read_b64_tr_b16 %5, %10 offset:20480\n\tds_read_b64_tr_b16 %6, %10 offset:24576\n\tds_read_b64_tr_b16 %7, %10 offset:28672\n\t"
                     "ds_read_b64_tr_b16 %8, %10 offset:32768\n\tds_read_b64_tr_b16 %9, %10 offset:36864\n\ts_waitcnt lgkmcnt(0)"
                     : "=&v"(t0), "=&v"(t1), "=&v"(t2), "=&v"(t3), "=&v"(t4), "=&v"(t5), "=&v"(t6), "=&v"(t7), "=&v"(t8), "=&v"(t9) : "v"(va) : "memory");
        f32x4 o = (f32x4){0.f, 0.f, 0.f, 0.f};
        o = __builtin_amdgcn_mfma_f32_16x16x32_bf16((bf16x8){t0[0], t0[1], t0[2], t0[3], t1[0], t1[1], t1[2], t1[3]}, pf[0], o, 0, 0, 0);
        o = __builtin_amdgcn_mfma_f32_16x16x32_bf16((bf16x8){t2[0], t2[1], t2[2], t2[3], t3[0], t3[1], t3[2], t3[3]}, pf[1], o, 0, 0, 0);
        o = __builtin_amdgcn_mfma_f32_16x16x32_bf16((bf16x8){t4[0], t4[1], t4[2], t4[3], t5[0], t5[1], t5[2], t5[3]}, pf[2], o, 0, 0, 0);
        o = __builtin_amdgcn_mfma_f32_16x16x32_bf16((bf16x8){t6[0], t6[1], t6[2], t6[3], t7[0], t7[1], t7[2], t7[3]}, pf[3], o, 0, 0, 0);
        o = __builtin_amdgcn_mfma_f32_16x16x32_bf16((bf16x8){t8[0], t8[1], t8[2], t8[3], t9[0], t9[1], t9[2], t9[3]}, pf[4], o, 0, 0, 0);
        v2u w; w.x = pk2(o[0], o[1]); w.y = pk2(o[2], o[3]);
        *(v2u*)(optr + 16 * c + 4 * quad) = w;
    }
}
__device__ __forceinline__ void attn_btab(const Frame& F, const float* rel_bias, int kvh) {
    LAS float* btab = (LAS float*)(F.lds + ATT_BTAB_OFF);
    for (int t = F.tid; t < 4 * 129; t += NWAVES * 64) { const int g = t / 129, d = t - g * 129; btab[g * 132 + d] = rel_bias[rel_bucket_dev(d) * 16 + kvh * 4 + g]; }
}
__device__ __forceinline__ void attn_prompt_unit(const Frame& F, int qb, int kvh, const bf16* P, const float* rel_bias, const float* sinks, bf16* MIX) {
    LAS unsigned char* L = F.lds + RING_OFF;
    const int tid = F.tid, lane = F.lane, wave = F.wave;
    attn_btab(F, rel_bias, kvh);
    const int krow0 = 128 * (qb - 1);
#pragma unroll 2
    for (int it = 0; it < 8; ++it) { const int cid = tid + 512 * it, row = cid >> 4, ch = cid & 15, gr = krow0 + row;
        v4u kv = (v4u){0u, 0u, 0u, 0u}, vv = kv;
        if (gr >= 0) { kv = *(const v4u*)(P + (size_t)gr * PW + C_KA + kvh * 128 + ch * 8); vv = *(const v4u*)(P + (size_t)gr * PW + C_VA + kvh * 128 + ch * 8); }
        *(LAS v4u*)(L + ATT_KIMG + off_b(row, ch)) = kv; *(LAS v4u*)(L + ATT_VIMG + off_b(row, ch)) = vv; }
    if (tid < 256) { const int row = 256 + (tid >> 4), ch = tid & 15; *(LAS v4u*)(L + ATT_VIMG + off_b(row, ch)) = (v4u){0u, 0u, 0u, 0u}; *(LAS v4u*)(L + ATT_KIMG + off_b(row, ch)) = (v4u){0u, 0u, 0u, 0u}; }
    __syncthreads();
    const LAS float* btab = (const LAS float*)(F.lds + ATT_BTAB_OFF);
    const int quad = lane >> 4, l15 = lane & 15, g = wave >> 1, h = kvh * 4 + g; const float sink = sinks[h];
#pragma unroll 1
    for (int k = 0; k < 4; ++k) { const int qt = (wave & 1) * 4 + k, row = 128 * qb + 16 * qt + l15;
        attn_tile(L, btab, P + (size_t)row * PW + C_QA + h * 128, qt, 128 + l15 - 4 * quad, qb == 0 ? 128 : 0, 256, sink, g, MIX + (size_t)row * DM + h * 128, lane); }
    __syncthreads();
}
__device__ __forceinline__ void attn_sample_unit(const Frame& F, int b, int kvh, const bf16* P, const float* ck, const float* cv, const float* rel_bias, const float* sinks, bf16* MIX) {
    LAS unsigned char* L = F.lds + RING_OFF;
    const int tid = F.tid, lane = F.lane, wave = F.wave;
    attn_btab(F, rel_bias, kvh);
#pragma unroll 1
    for (int it = 0; it < 5; ++it) { const int cid = tid + 512 * it, row = cid >> 4, ch = cid & 15;
        v4u kv = (v4u){0u, 0u, 0u, 0u}, vv = kv;
        if (row < 128) { const float* kp = ck + ((size_t)(b * 128 + row) * 4 + kvh) * 128 + ch * 8; const float* vp = cv + ((size_t)(b * 128 + row) * 4 + kvh) * 128 + ch * 8;
            const f32x4 k0 = *(const f32x4*)kp, k1 = *(const f32x4*)(kp + 4), v0 = *(const f32x4*)vp, v1 = *(const f32x4*)(vp + 4);
            kv = (v4u){pk2(k0.x, k0.y), pk2(k0.z, k0.w), pk2(k1.x, k1.y), pk2(k1.z, k1.w)}; vv = (v4u){pk2(v0.x, v0.y), pk2(v0.z, v0.w), pk2(v1.x, v1.y), pk2(v1.z, v1.w)}; }
        else if (row < 132) { const size_t gr = (size_t)TP + 4 * b + (row - 128); kv = *(const v4u*)(P + gr * PW + C_KA + kvh * 128 + ch * 8); vv = *(const v4u*)(P + gr * PW + C_VA + kvh * 128 + ch * 8); }
        *(LAS v4u*)(L + ATT_KIMG + off_b(row, ch)) = kv; *(LAS v4u*)(L + ATT_VIMG + off_b(row, ch)) = vv; }
    __syncthreads();
    if (wave == 0) {
        const LAS float* btab = (const LAS float*)(F.lds + ATT_BTAB_OFF);
        const int quad = lane >> 4, l15 = lane & 15, g = l15 >> 2, t = l15 & 3, h = kvh * 4 + g, row = TP + 4 * b + t;
        attn_tile(L, btab, P + (size_t)row * PW + C_QA + h * 128, 0, 128 + t - 4 * quad, 0, 132, sinks[h], g, MIX + (size_t)row * DM + h * 128, lane);
    }
    __syncthreads();
}
constexpr int N_PHASES = 10;
__global__ void __launch_bounds__(NWAVES * 64, 2) mega_fwd(Params p) {
    extern __shared__ __attribute__((aligned(16))) unsigned char lds[];
    Frame F;
    F.lds = (LAS unsigned char*)lds;
    F.MISC = (volatile LAS unsigned*)(F.lds + MISC_OFF);
    F.tid = threadIdx.x; F.lane = F.tid & 63; F.wave = __builtin_amdgcn_readfirstlane(F.tid >> 6);
    F.G = gridDim.x; { const int bx = blockIdx.x; F.vcu = (F.G % 8 == 0) ? (bx % 8) * (F.G / 8) + bx / 8 : bx; }
    unsigned char* ws = p.ws;
    F.ctl = (gu32*)(ws + WS_CTL);
    for (int u = F.tid; u < (LDS_BYTES - LDSCTL_OFF) / 4; u += NWAVES * 64) ((LAS unsigned*)(F.lds + LDSCTL_OFF))[u] = 0u;
    __syncthreads();
    XcdBarrier bar = xcd_barrier_post((unsigned*)(F.ctl + CW_BAR) + p.li * XCD_BAR_WORDS, F.MISC + 8);
    const int lo = p.ph_lo, hi = p.ph_hi;
#define IN(k) (lo <= (k) && (k) < hi)
#define BOTH(k) (IN(k) && IN((k) + 1))
#define GRID_BAR() xcd_barrier(bar)
    bf16* Win_t = (bf16*)(ws + WS_WIN); bf16* Wout_t = (bf16*)(ws + WS_WOUT); bf16* Wgu_t = (bf16*)(ws + WS_WGU); bf16* Wdn_t = (bf16*)(ws + WS_WDN);
    bf16* H = (bf16*)(ws + WS_H); bf16* MIX = (bf16*)(ws + WS_MIX); bf16* P = (bf16*)(ws + WS_P); bf16* ACT = (bf16*)(ws + WS_ACT);
    float* AB = (float*)(ws + WS_AB); bf16* MIXO = (bf16*)(ws + WS_MIXO); bf16* FFNO = (bf16*)(ws + WS_FFNO);
    float* ORAW = (float*)(ws + WS_ORAW); float* SLAB = (float*)(ws + WS_VBG);
    const ScanBufs sb{(bf16*)(ws + WS_WF), (bf16*)(ws + WS_KDF), (bf16*)(ws + WS_QEF), (bf16*)(ws + WS_QKF), (float*)(ws + WS_UF), (float*)(ws + WS_EGL), ws + WS_VBG};
    float* out = p.out;

    if (IN(0)) { p0_prologue(F, p); if (BOTH(0)) GRID_BAR(); }
    if (IN(1)) {
        pg8::Gemm g{H, Win_t, MROWS, PROJ_PAD, DM}; pg8::StaticOrder S; S.init(MROWS, PROJ_PAD, DM, F.G, (int)blockIdx.x);
        pg8::EpiProj E{P, AB, PW};
        pg8::gemm_phase<pg8::EpiProj, pg8::StaticOrder, true, true>(F.lds + RING_OFF, g, S, E);
        if (BOTH(1)) GRID_BAR();
    }
    if (IN(2)) {
        if (p.pad & 1) ph_copy_states(F, P, p.in[2], p.in[3], out);
        if (p.pad & 2) gdn_sample_units(F, F.vcu, F.G, P, AB, p.in[4], p.in[9], p.in[10], p.in[11], p.in[12], p.in[5], out + O_SGDN, MIX);
        if (p.pad & 4) gdn_prep_all(F, P, AB, p.in[9], p.in[10], p.in[11], sb);
        if (BOTH(2)) GRID_BAR();
    }
    if (IN(3)) {
        if (F.G == 256) {
            const int xcd = F.vcu >> 5, r = F.vcu & 31;
            if (r < 16) gdn_scan_unit(F, xcd * 2 + (r >> 3), r & 7, sb, ORAW, out + O_PGDN);
            else { const int aw = xcd * 16 + (r - 16);
                for (int u = aw; u < 256; u += 128) attn_prompt_unit(F, u >> 2, u & 3, P, p.in[6], p.in[8], MIX);
                for (int u = aw; u < 512; u += 128) attn_sample_unit(F, u >> 2, u & 3, P, p.in[2], p.in[3], p.in[6], p.in[8], MIX);
                w_up_convert(F, p, aw, 128); }
        } else {
            for (int su = F.vcu; su < 128; su += F.G) gdn_scan_unit(F, su >> 3, su & 7, sb, ORAW, out + O_PGDN);
            for (int u = F.vcu; u < 256; u += F.G) attn_prompt_unit(F, u >> 2, u & 3, P, p.in[6], p.in[8], MIX);
            for (int u = F.vcu; u < 512; u += F.G) attn_sample_unit(F, u >> 2, u & 3, P, p.in[2], p.in[3], p.in[6], p.in[8], MIX);
            w_up_convert(F, p, F.vcu, F.G);
        }
        if (BOTH(3)) GRID_BAR();
    }
    if (IN(4)) { ph_gated_norm(F, ORAW, P, p.in[12], MIX, 0, TP); if (BOTH(4)) GRID_BAR(); }
    if (IN(5)) {
        pg8::Gemm g{MIX, Wout_t, MROWS, DM, DM}; pg8::SplitTailOrder S; S.init(TP, NSB * NST, DM, DM, F.G, (int)blockIdx.x);
        pg8::EpiBfSlab E{MIXO, DM, SLAB, TP / 256, DM / 64, (size_t)NSB * NST * DM};
        pg8::gemm_phase<pg8::EpiBfSlab, pg8::SplitTailOrder, true, true>(F.lds + RING_OFF, g, S, E);
        if (BOTH(5)) GRID_BAR();
    }
    if (IN(6)) { ph_postmix(F, p, MIXO, SLAB, out, H); if (BOTH(6)) GRID_BAR(); }
    if (IN(7)) {
        pg8::Gemm g{H, Wgu_t, MROWS, NGU, DM}; pg8::StaticOrder S; S.init(MROWS, NGU, DM, F.G, (int)blockIdx.x);
        pg8::EpiSwiGLU E{ACT, FF};
        pg8::gemm_phase<pg8::EpiSwiGLU, pg8::StaticOrder, true, true>(F.lds + RING_OFF, g, S, E);
        { const int n12 = S.nwg % F.G, c = (int)blockIdx.x;
          if (n12 == 0) w_down_convert(F, p, c, F.G); else if (c >= n12) w_down_convert(F, p, c - n12, F.G - n12); }
        if (BOTH(7)) GRID_BAR();
    }
    if (IN(8)) {
        pg8::Gemm g{ACT, Wdn_t, MROWS, DM, FF}; pg8::SplitTailOrder S; S.init(TP, NSB * NST, DM, FF, F.G, (int)blockIdx.x);
        pg8::EpiBfSlab E{FFNO, DM, SLAB, TP / 256, FF / 64, (size_t)NSB * NST * DM};
        pg8::gemm_phase<pg8::EpiBfSlab, pg8::SplitTailOrder, true, true>(F.lds + RING_OFF, g, S, E);
        if (BOTH(8)) GRID_BAR();
    }
    if (IN(9)) ph_final(F, FFNO, SLAB, p.in[17], out);
#undef IN
#undef BOTH
#undef GRID_BAR
}
#ifndef MK_N_LAUNCHES
#define MK_N_LAUNCHES 1
#endif
extern "C" void kernel_launch(void* const* d_in, const int* in_sizes, int n_in, void* d_out, int out_size, void* d_ws, size_t ws_size, hipStream_t stream) {
    static int grid = 0;
    if (grid == 0) {
        if (n_in != 21 || out_size != (int)O_TOTAL || ws_size < WS_END) { fprintf(stderr, "kernel_launch: unexpected shapes (n_in %d, out %d, ws %zu < %zu)\n", n_in, out_size, ws_size, (size_t)WS_END); grid = -1; return; }
        int dev = 0, cus = 0;
        if (hipGetDevice(&dev) != hipSuccess || hipDeviceGetAttribute(&cus, hipDeviceAttributeMultiprocessorCount, dev) != hipSuccess) { grid = -1; return; }
        if (hipFuncSetAttribute((const void*)mega_fwd, hipFuncAttributeMaxDynamicSharedMemorySize, LDS_BYTES) != hipSuccess) { fprintf(stderr, "kernel_launch: hipFuncSetAttribute failed\n"); grid = -1; return; }
        int per_cu = 0; (void)hipOccupancyMaxActiveBlocksPerMultiprocessor(&per_cu, (const void*)mega_fwd, NWAVES * 64, LDS_BYTES); (void)hipGetLastError();
        grid = cus;
    }
    if (grid < 0) return;
    (void)hipMemsetAsync((char*)d_ws + WS_CTL, 0, CTL_ZERO_BYTES, stream);
    Params p{};
    for (int i = 0; i < 21; ++i) p.in[i] = (const float*)d_in[i];
    p.out = (float*)d_out; p.ws = (unsigned char*)d_ws;
#ifdef MK_PLAN
    const int plan[][3] = {MK_PLAN};
#else
    const int plan[][3] = {{0, N_PHASES, 7}};
#endif
    for (int li = 0; li < (int)(sizeof(plan) / sizeof(plan[0])); ++li) { p.ph_lo = plan[li][0]; p.ph_hi = plan[li][1]; p.li = li; p.pad = plan[li][2];
        hipLaunchKernelGGL(mega_fwd, dim3(grid), dim3(NWAVES * 64), LDS_BYTES, stream, p); }
}
```

```cpp
#include <hip/hip_runtime.h>
#include <cstdio>
#include <cstdint>
namespace pg8 {
#define PG8_LAS __attribute__((address_space(3)))
typedef unsigned short bf16_t;
typedef short bf16x8 __attribute__((ext_vector_type(8)));
typedef float f32x4 __attribute__((ext_vector_type(4)));
typedef unsigned u32x4 __attribute__((ext_vector_type(4)));
constexpr int BM = 256, BK = 64, HALF = 128, HTB = HALF * BK * 2  , STAGE_BYTES = 8 * HTB, NXCD = 8, WGM = 8;

__host__ __device__ __forceinline__ int lds_byte(int r, int c) { const int st = (r >> 4) * 2 + (c >> 5), rr = r & 15, cc = c & 31, ob = rr * 64 + cc * 2; return st * 1024 + (ob ^ (((ob >> 9) & 1) << 5)); }
__host__ __device__ __forceinline__ void stage_rc(int b, int& R, int& C) { const int st = b / 1024, sb = b % 1024, swz = sb ^ (((sb >> 9) & 1) << 5); R = (st >> 1) * 16 + swz / 64; C = (st & 1) * 32 + (swz % 64) / 2; }
__host__ __device__ __forceinline__ int perm32(int rho) { const int n = rho >> 4, i = rho & 15; return 8 * (i >> 2) + 4 * n + (i & 3); }

struct Unit { int pm, pn, k0, nk; };
struct Gemm { const bf16_t* A; const bf16_t* Bt; int M, N, K; };

struct StaticOrder {
    int nM, nN, nwg, G, c, ntf;
    __host__ __device__ void init(int M, int N, int K, int G_, int c_) { nM = M / BM; nN = N / BM; nwg = nM * nN; G = G_; c = c_; ntf = K / BK; }
    __host__ __device__ bool next(int i, Unit& u) const {
        const long L = (long)i * G + c; if (L >= nwg) return false;
        int wgid = (int)L; { const int q = nwg / NXCD, r = nwg % NXCD, xcd = wgid % NXCD, off = wgid / NXCD; wgid = (xcd < r ? xcd * (q + 1) : r * (q + 1) + (xcd - r) * q) + off; }
        const int nig = WGM * nN, gid = wgid / nig, fm = gid * WGM, gsz = (nM - fm) < WGM ? (nM - fm) : WGM;
        u.pm = fm + ((wgid % nig) % gsz); u.pn = (wgid % nig) / gsz; u.k0 = 0; u.nk = ntf; return true;
    }
    __device__ __forceinline__ void a_ready(const Unit&) const {}
    __device__ __forceinline__ void done(const Unit&) const {}
};
struct SplitTailOrder {
    StaticOrder base; int mp, ntail_items;
    __host__ __device__ void init(int Mprompt, int Msample, int N, int K, int G_, int c_) { base.init(Mprompt, N, K, G_, c_); mp = Mprompt / BM; ntail_items = (Msample / BM) * (N / BM) * 8; }
    __host__ __device__ bool next(int i, Unit& u) const {
        Unit t; t.pm = 0; t.pn = 0; t.k0 = 0; t.nk = base.ntf; const bool full = base.next(i, t);
        const int nb = (base.nwg - base.c + base.G - 1) / base.G;
        const int item = (i - nb) * base.G + base.c; const bool tail = !full && i >= nb && item < ntail_items;
        const int tt = item >> 3, sp = item & 7, per = (base.ntf / 16) * 2, rem = (base.ntf - 8 * per) / 2;
        u.pm = full ? t.pm : mp + tt / base.nN; u.pn = full ? t.pn : tt % base.nN; u.nk = full ? t.nk : per + (sp < rem ? 2 : 0); u.k0 = full ? 0 : sp * per + 2 * (sp < rem ? sp : rem);
        return full || tail;
    }
    __device__ __forceinline__ void a_ready(const Unit&) const {}
    __device__ __forceinline__ void done(const Unit&) const {}
};
__device__ __forceinline__ unsigned cvt_pk_bf16(float lo, float hi) { unsigned r; asm volatile("v_cvt_pk_bf16_f32 %0, %1, %2" : "=v"(r) : "v"(lo), "v"(hi)); return r; }
typedef float f32x2 __attribute__((ext_vector_type(2)));
__device__ __forceinline__ float silu_f(float x) { return x * __builtin_amdgcn_rcpf(1.0f + __expf(-x)); }
struct EpiProj {
    static constexpr bool PERM = true, AFTER_DRAIN = false;
    bf16_t* P; float* AB; int ldp;
    __device__ __forceinline__ void operator()(const f32x4 (&acc)[2][2][4][2], const Unit& u, int wr, int wc, int fr, int fq) const {
        const int row0 = u.pm * BM + wr * 64 + fr;
        if (u.pn < 44) {
            const int col0 = u.pn * BM + wc * 32 + 8 * fq;
#pragma unroll
            for (int ai = 0; ai < 2; ++ai)
#pragma unroll
                for (int m = 0; m < 4; ++m) { bf16_t* rowp = P + (size_t)(row0 + ai * HALF + m * 16) * ldp + col0;
#pragma unroll
                    for (int bj = 0; bj < 2; ++bj) { const f32x4 v0 = acc[ai][bj][m][0], v1 = acc[ai][bj][m][1];
                        u32x4 w; w.x = cvt_pk_bf16(v0[0], v0[1]); w.y = cvt_pk_bf16(v0[2], v0[3]); w.z = cvt_pk_bf16(v1[0], v1[1]); w.w = cvt_pk_bf16(v1[2], v1[3]);
                        *(u32x4*)(rowp + bj * HALF) = w; } }
        } else if (wc == 0) {
#pragma unroll
            for (int ai = 0; ai < 2; ++ai)
#pragma unroll
                for (int m = 0; m < 4; ++m) { float* rp = AB + (size_t)(row0 + ai * HALF + m * 16) * 32 + 8 * fq;
                    *(f32x4*)(rp) = acc[ai][0][m][0]; *(f32x4*)(rp + 4) = acc[ai][0][m][1]; }
        }
    }
};
struct EpiBfSlab {
    static constexpr bool PERM = true, AFTER_DRAIN = false;
    bf16_t* C; int ldc; float* slab; int mp, ntf; size_t slab_stride;
    __device__ __forceinline__ void operator()(const f32x4 (&acc)[2][2][4][2], const Unit& u, int wr, int wc, int fr, int fq) const {
        const int col0 = u.pn * BM + wc * 32 + 8 * fq, row0 = u.pm * BM + wr * 64 + fr;
        if (u.nk == ntf) {
#pragma unroll
            for (int ai = 0; ai < 2; ++ai)
#pragma unroll
                for (int m = 0; m < 4; ++m) { bf16_t* rowp = C + (size_t)(row0 + ai * HALF + m * 16) * ldc + col0;
#pragma unroll
                    for (int bj = 0; bj < 2; ++bj) { const f32x4 v0 = acc[ai][bj][m][0], v1 = acc[ai][bj][m][1];
                        u32x4 w; w.x = cvt_pk_bf16(v0[0], v0[1]); w.y = cvt_pk_bf16(v0[2], v0[3]); w.z = cvt_pk_bf16(v1[0], v1[1]); w.w = cvt_pk_bf16(v1[2], v1[3]);
                        *(u32x4*)(rowp + bj * HALF) = w; } }
        } else {
            const int per = (ntf / 16) * 2, rem = (ntf - 8 * per) / 2; const int sp = u.k0 < rem * (per + 2) ? u.k0 / (per + 2) : rem + (u.k0 - rem * (per + 2)) / per;
            float* Cb = slab + (size_t)sp * slab_stride; const int r0 = row0 - mp * BM;
#pragma unroll
            for (int ai = 0; ai < 2; ++ai)
#pragma unroll
                for (int m = 0; m < 4; ++m) { float* rowp = Cb + (size_t)(r0 + ai * HALF + m * 16) * ldc + col0;
#pragma unroll
                    for (int bj = 0; bj < 2; ++bj) { *(f32x4*)(rowp + bj * HALF) = acc[ai][bj][m][0]; *(f32x4*)(rowp + bj * HALF + 4) = acc[ai][bj][m][1]; } }
        }
    }
};
struct EpiSwiGLU {
    static constexpr bool PERM = true, AFTER_DRAIN = false;
    bf16_t* O; int ldc;
    __device__ __forceinline__ void operator()(const f32x4 (&acc)[2][2][4][2], const Unit& u, int wr, int wc, int fr, int fq) const {
        const int row0 = u.pm * BM + wr * 64 + fr, col0 = u.pn * HALF + wc * 32 + 8 * fq;
#pragma unroll
        for (int ai = 0; ai < 2; ++ai)
#pragma unroll
            for (int m = 0; m < 4; ++m) { bf16_t* rowp = O + (size_t)(row0 + ai * HALF + m * 16) * ldc + col0;
                const f32x4 g0 = acc[ai][0][m][0], g1 = acc[ai][0][m][1], u0 = acc[ai][1][m][0], u1 = acc[ai][1][m][1];
                u32x4 w; w.x = cvt_pk_bf16(silu_f(g0[0]) * u0[0], silu_f(g0[1]) * u0[1]); w.y = cvt_pk_bf16(silu_f(g0[2]) * u0[2], silu_f(g0[3]) * u0[3]);
                w.z = cvt_pk_bf16(silu_f(g1[0]) * u1[0], silu_f(g1[1]) * u1[1]); w.w = cvt_pk_bf16(silu_f(g1[2]) * u1[2], silu_f(g1[3]) * u1[3]);
                *(u32x4*)rowp = w; }
    }
};
template <class Epi, class Sched, bool ALIGN_EPI = false, bool SP2 = false>
__device__ __forceinline__ void gemm_phase(PG8_LAS unsigned char* lds, const Gemm g, const Sched& S, const Epi& E) {
    const int tid = threadIdx.x, wid = __builtin_amdgcn_readfirstlane(tid >> 6), lane = tid & 63, wr = wid >> 2, wc = wid & 3, fr = lane & 15, fq = lane >> 4;
    const int K = g.K;
    unsigned voffA[2], voffB[2];
#pragma unroll
    for (int i = 0; i < 2; ++i) { int R, C; stage_rc(tid * 16 + i * 8192, R, C); const int Rb = Epi::PERM ? ((R & ~31) + perm32(R & 31)) : R;
        voffA[i] = (unsigned)(R * K + C) * 2u; voffB[i] = (unsigned)(Rb * K + C) * 2u; }
    const size_t kstep = (size_t)(BK * 2);
    const size_t hstep = (size_t)HALF * K * 2;
    const size_t tstep = 2 * hstep;
    const unsigned ldsw = (unsigned)wid * 1024u;
    const int aoff = lds_byte(wr * 64 + fr, fq * 8), boff = lds_byte(wc * 32 + fr, fq * 8);
#define PG8_SA(b, h) (((b) * 2 + (h)) * HTB)
#define PG8_SB(b, h) ((4 + (b) * 2 + (h)) * HTB)
#define PG8_STAGE(bufoff, gbase, voff) do { _Pragma("unroll") for (int _i = 0; _i < 2; ++_i) \
        __builtin_amdgcn_global_load_lds((const unsigned*)((const char*)(gbase) + (voff)[_i]), (PG8_LAS unsigned*)(lds + (bufoff) + ldsw + _i * 8192), 16, 0, 0); } while (0)
#define PG8_LDA(dst, b, h) do { _Pragma("unroll") for (int m = 0; m < 4; ++m) _Pragma("unroll") for (int k = 0; k < 2; ++k) dst[m][k] = *(const PG8_LAS bf16x8*)(lds + PG8_SA(b, h) + aoff + m * 2048 + k * 1024); } while (0)
#define PG8_LDB(dst, b, h) do { _Pragma("unroll") for (int n = 0; n < 2; ++n) _Pragma("unroll") for (int k = 0; k < 2; ++k) dst[n][k] = *(const PG8_LAS bf16x8*)(lds + PG8_SB(b, h) + boff + n * 2048 + k * 1024); } while (0)
#define PG8_MMA(ai, bj, At, Bt) do { __builtin_amdgcn_s_setprio(1); _Pragma("unroll") for (int m = 0; m < 4; ++m) _Pragma("unroll") for (int n = 0; n < 2; ++n) _Pragma("unroll") for (int k = 0; k < 2; ++k) \
        acc[ai][bj][m][n] = __builtin_amdgcn_mfma_f32_16x16x32_bf16(Bt[n][k], At[m][k], acc[ai][bj][m][n], 0, 0, 0); __builtin_amdgcn_s_setprio(0); } while (0)
#define PG8_WAIT_V(n) asm volatile("s_waitcnt vmcnt(" #n ")" ::: "memory")
#define PG8_WAIT_L(n) asm volatile("s_waitcnt lgkmcnt(" #n ")" ::: "memory")
#define PG8_BAR __builtin_amdgcn_s_barrier()
#define PG8_SCHED __builtin_amdgcn_sched_barrier(0)
    Unit cur, nxt; int ui = 0;
    if (!S.next(0, cur)) return;
    f32x4 acc[2][2][4][2];
#pragma unroll
    for (int a = 0; a < 2; ++a)
#pragma unroll
        for (int b = 0; b < 2; ++b)
#pragma unroll
            for (int m = 0; m < 4; ++m)
#pragma unroll
                for (int n = 0; n < 2; ++n) acc[a][b][m][n] = (f32x4){0.f, 0.f, 0.f, 0.f};
    bf16x8 At[4][2], B0[2][2], B1[2][2];
    const char* cA = (const char*)g.A + (size_t)cur.pm * tstep + (size_t)cur.k0 * (BK * 2); const char* cB = (const char*)g.Bt + (size_t)cur.pn * tstep + (size_t)cur.k0 * (BK * 2);
    S.a_ready(cur);
    if constexpr (SP2) {
        PG8_STAGE(PG8_SB(0, 0), cB, voffB); PG8_STAGE(PG8_SB(0, 1), cB + hstep, voffB); PG8_STAGE(PG8_SA(0, 0), cA, voffA); PG8_STAGE(PG8_SA(0, 1), cA + hstep, voffA);
        if (wr == 1) PG8_BAR;
        PG8_WAIT_V(2); PG8_BAR;
        PG8_STAGE(PG8_SB(1, 0), cB + kstep, voffB); PG8_STAGE(PG8_SA(1, 0), cA + kstep, voffA); PG8_STAGE(PG8_SB(1, 1), cB + hstep + kstep, voffB);
        PG8_WAIT_V(6); PG8_BAR;
    } else {
        PG8_STAGE(PG8_SB(0, 0), cB, voffB); PG8_STAGE(PG8_SA(0, 0), cA, voffA); PG8_STAGE(PG8_SB(0, 1), cB + hstep, voffB); PG8_STAGE(PG8_SA(0, 1), cA + hstep, voffA);
        if (wr == 1) PG8_BAR;
        PG8_WAIT_V(4); PG8_BAR;
        PG8_STAGE(PG8_SB(1, 0), cB + kstep, voffB); PG8_STAGE(PG8_SA(1, 0), cA + kstep, voffA); PG8_STAGE(PG8_SB(1, 1), cB + hstep + kstep, voffB);
        PG8_WAIT_V(6); PG8_BAR;
    }
    for (;;) {
        const bool has_next = S.next(ui + 1, nxt);
        const char* nA = has_next ? (const char*)g.A + (size_t)nxt.pm * tstep + (size_t)nxt.k0 * (BK * 2) : cA; const char* nB = has_next ? (const char*)g.Bt + (size_t)nxt.pn * tstep + (size_t)nxt.k0 * (BK * 2) : cB;
        const int nt = cur.nk;
        for (int t = 0; t < nt; t += 2) {
            const bool last = (t == nt - 2);
            const char* a1 = cA + (size_t)(t + 1) * kstep;
            const char* a2 = last ? nA : cA + (size_t)(t + 2) * kstep; const char* b2 = last ? nB : cB + (size_t)(t + 2) * kstep;
            const char* a3 = a2 + kstep; const char* b3 = b2 + kstep;
            if (last && has_next) S.a_ready(nxt);
            if constexpr (SP2) {
            PG8_LDB(B0, 0, 0); PG8_LDB(B1, 0, 1); PG8_SCHED; PG8_LDA(At, 0, 0); PG8_STAGE(PG8_SA(1, 1), a1 + hstep, voffA);
            PG8_WAIT_V(8); PG8_WAIT_L(0); PG8_BAR; PG8_MMA(0, 0, At, B0); PG8_MMA(0, 1, At, B1); PG8_BAR; PG8_SCHED;
            PG8_LDA(At, 0, 1); PG8_STAGE(PG8_SB(0, 0), b2, voffB); PG8_STAGE(PG8_SB(0, 1), b2 + hstep, voffB); PG8_STAGE(PG8_SA(0, 0), a2, voffA);
            PG8_WAIT_V(8); PG8_WAIT_L(0); PG8_BAR; PG8_MMA(1, 0, At, B0); PG8_MMA(1, 1, At, B1); PG8_BAR; PG8_SCHED;
            PG8_LDB(B0, 1, 0); PG8_LDB(B1, 1, 1); PG8_SCHED; PG8_LDA(At, 1, 0); PG8_STAGE(PG8_SA(0, 1), a2 + hstep, voffA);
            PG8_WAIT_V(8); PG8_WAIT_L(0); PG8_BAR; PG8_MMA(0, 0, At, B0); PG8_MMA(0, 1, At, B1); PG8_BAR; PG8_SCHED;
            PG8_LDA(At, 1, 1); PG8_STAGE(PG8_SB(1, 0), b3, voffB); PG8_STAGE(PG8_SB(1, 1), b3 + hstep, voffB); PG8_STAGE(PG8_SA(1, 0), a3, voffA);
            PG8_WAIT_V(8); PG8_WAIT_L(0); PG8_BAR; PG8_MMA(1, 0, At, B0); PG8_MMA(1, 1, At, B1); PG8_BAR; PG8_SCHED;
            } else {
            PG8_LDB(B0, 0, 0); PG8_SCHED; PG8_LDA(At, 0, 0); PG8_STAGE(PG8_SA(1, 1), a1 + hstep, voffA);
            PG8_WAIT_L(8); PG8_BAR; PG8_WAIT_L(0); PG8_MMA(0, 0, At, B0); PG8_BAR; PG8_SCHED;
            PG8_LDB(B1, 0, 1); PG8_STAGE(PG8_SB(0, 0), b2, voffB);
            PG8_BAR; PG8_WAIT_L(0); PG8_MMA(0, 1, At, B1); PG8_BAR;
            PG8_LDA(At, 0, 1); PG8_STAGE(PG8_SA(0, 0), a2, voffA);
            PG8_BAR; PG8_WAIT_L(0); PG8_MMA(1, 0, At, B0); PG8_BAR; PG8_SCHED;
            PG8_STAGE(PG8_SB(0, 1), b2 + hstep, voffB);
            PG8_WAIT_V(6); PG8_BAR; PG8_MMA(1, 1, At, B1); PG8_BAR;
            PG8_LDB(B0, 1, 0); PG8_SCHED; PG8_LDA(At, 1, 0); PG8_STAGE(PG8_SA(0, 1), a2 + hstep, voffA);
            PG8_WAIT_L(8); PG8_BAR; PG8_WAIT_L(0); PG8_MMA(0, 0, At, B0); PG8_BAR; PG8_SCHED;
            PG8_LDB(B1, 1, 1); PG8_STAGE(PG8_SB(1, 0), b3, voffB);
            PG8_BAR; PG8_WAIT_L(0); PG8_MMA(0, 1, At, B1); PG8_BAR;
            PG8_LDA(At, 1, 1); PG8_STAGE(PG8_SA(1, 0), a3, voffA);
            PG8_BAR; PG8_WAIT_L(0); PG8_MMA(1, 0, At, B0); PG8_BAR; PG8_SCHED;
            PG8_STAGE(PG8_SB(1, 1), b3 + hstep, voffB);
            PG8_WAIT_V(6); PG8_BAR; PG8_MMA(1, 1, At, B1); PG8_BAR;
            }
        }
        if constexpr (ALIGN_EPI) { if (wr == 0) PG8_BAR; }
        if constexpr (!Epi::AFTER_DRAIN) { E(acc, cur, wr, wc, fr, fq); S.done(cur); }
        if (!has_next) break;
#pragma unroll
        for (int a = 0; a < 2; ++a)
#pragma unroll
            for (int b = 0; b < 2; ++b)
#pragma unroll
                for (int m = 0; m < 4; ++m)
#pragma unroll
                    for (int n = 0; n < 2; ++n) acc[a][b][m][n] = (f32x4){0.f, 0.f, 0.f, 0.f};
        cur = nxt; cA = nA; cB = nB; ++ui;
        if constexpr (ALIGN_EPI) { if (wr == 1) PG8_BAR; }
    }
    PG8_WAIT_V(0);
    if constexpr (!ALIGN_EPI) { if (wr == 0) PG8_BAR; }
    PG8_BAR;
    if constexpr (Epi::AFTER_DRAIN) { E.fused(acc, cur, wr, wc, fr, fq, lds, wid, lane); S.done(cur); }
#undef PG8_SA
#undef PG8_SB
#undef PG8_STAGE
#undef PG8_LDA
#undef PG8_LDB
#undef PG8_MMA
#undef PG8_WAIT_V
#undef PG8_WAIT_L
#undef PG8_BAR
#undef PG8_SCHED
}
}
constexpr int NWAVES = 8;
constexpr int DM = 4096, TP = 8192, NSB = 128, NST = 4, MROWS = TP + NSB * NST;
constexpr int PROJ_W = 11296, PROJ_PAD = 11520, PW = 11264;
constexpr int C_QA = 0, C_KA = 2048, C_VA = 2560, C_QKVG = 3072, C_ZG = 9216;
constexpr int FF = 11008, NGU = 2 * FF;
constexpr float NORM_EPS = 1e-6f;
constexpr size_t O_YP = 0, O_YS = 33554432, O_PWK = 35651584, O_PWV = 35717120, O_PCONV = 35782656, O_PGDN = 35801088,
                 O_SWK = 36063232, O_SWV = 44451840, O_SCONV = 52840448, O_SGDN = 55199744, O_TOTAL = 88754176;
constexpr size_t WS_CTL = 0, CTL_ZERO_BYTES = 1u << 20;
constexpr size_t WS_WIN = CTL_ZERO_BYTES;
constexpr size_t WS_WOUT = WS_WIN + (size_t)PROJ_PAD * DM * 2;
constexpr size_t WS_WGU = WS_WOUT + (size_t)DM * DM * 2;
constexpr size_t WS_WDN = WS_WGU + (size_t)NGU * DM * 2;
constexpr size_t WS_H = WS_WDN + (size_t)DM * FF * 2;
constexpr size_t WS_MIX = WS_H + (size_t)MROWS * DM * 2;
constexpr size_t WS_FFNO = WS_H;
constexpr size_t WS_P = WS_MIX + (size_t)MROWS * DM * 2;
constexpr size_t WS_MIXO = WS_P;
constexpr size_t WS_ACT = WS_P;
constexpr size_t WS_AB = WS_P + (size_t)MROWS * PW * 2;
constexpr size_t WS_QN = WS_AB + (size_t)MROWS * 32 * 4;
constexpr size_t WS_KN = WS_QN + (size_t)NSB * NST * 2048 * 4;
constexpr size_t WS_VN = WS_KN + (size_t)NSB * NST * 2048 * 4;
constexpr size_t WS_GB = WS_VN + (size_t)NSB * NST * 2048 * 4;
constexpr size_t WS_ORAW = WS_GB + (size_t)MROWS * 32 * 4;
constexpr int NUNIT = 16 * 128;
constexpr size_t WS_WF = WS_ORAW + (size_t)MROWS * 2048 * 4;
constexpr size_t WS_KDF = WS_WF + (size_t)NUNIT * 16384;
constexpr size_t WS_QEF = WS_KDF + (size_t)NUNIT * 16384;
constexpr size_t WS_QKF = WS_QEF + (size_t)NUNIT * 16384;
constexpr size_t WS_UF = WS_QKF + (size_t)NUNIT * 8192;
constexpr size_t WS_EGL = WS_UF + (size_t)NUNIT * 32768;
constexpr size_t WS_VBG = WS_EGL + (size_t)NUNIT * 4;
constexpr size_t WS_END = WS_VBG + (size_t)NUNIT * 32768;
static_assert((size_t)MROWS * DM * 4 <= 2 * (size_t)MROWS * DM * 2 && (size_t)MROWS * FF * 2 <= (size_t)MROWS * PW * 2, "overlays");
constexpr int CW_TMO = 0, CW_CODE = 1, CW_BAR = 4096;
constexpr int RING_OFF = 0, RING_BYTES = 139264;
constexpr int LDSCTL_OFF = RING_BYTES, MISC_OFF = LDSCTL_OFF + 320;
constexpr int LDS_BYTES = 147456;
#define GAS __attribute__((address_space(1)))
#define LAS __attribute__((address_space(3)))
typedef unsigned short bf16;
typedef unsigned v4u __attribute__((ext_vector_type(4)));
typedef unsigned v2u __attribute__((ext_vector_type(2)));
typedef float f32x4 __attribute__((ext_vector_type(4)));
typedef short bf16x8 __attribute__((ext_vector_type(8)));
typedef GAS unsigned gu32;
#define RLX_AGENT __ATOMIC_RELAXED, __HIP_MEMORY_SCOPE_AGENT
#define LDS_WAIT() asm volatile("s_waitcnt lgkmcnt(0)" ::: "memory")
#define VM_WAIT() asm volatile("s_waitcnt vmcnt(0)" ::: "memory")
#define LDS_BAR() do { asm volatile("s_waitcnt lgkmcnt(0)" ::: "memory"); __builtin_amdgcn_s_barrier(); asm volatile("" ::: "memory"); } while (0)
__device__ __forceinline__ unsigned f2bf(float f) { unsigned u = __builtin_bit_cast(unsigned, f); return (u + 0x7fffu + ((u >> 16) & 1u)) >> 16; }
__device__ __forceinline__ unsigned pk2(float lo, float hi) { return f2bf(lo) | (f2bf(hi) << 16); }
__device__ __forceinline__ float bf2f(unsigned short b) { return __builtin_bit_cast(float, ((unsigned)b) << 16); }
__device__ __forceinline__ float bflo(unsigned w) { return __builtin_bit_cast(float, w << 16); }
__device__ __forceinline__ float bfhi(unsigned w) { return __builtin_bit_cast(float, w & 0xffff0000u); }
__device__ __forceinline__ float wave_sum(float v) {
#pragma unroll
    for (int o = 1; o < 64; o <<= 1) v += __shfl_xor(v, o);
    return v;
}
__device__ __forceinline__ float wave_max(float v) {
#pragma unroll
    for (int o = 1; o < 64; o <<= 1) v = fmaxf(v, __shfl_xor(v, o));
    return v;
}
__device__ __forceinline__ float sigmoid_f(float x) { return 1.0f / (1.0f + __expf(-x)); }
__device__ __forceinline__ float silu_f(float x) { return x / (1.0f + __expf(-x)); }
__device__ __forceinline__ float softplus_f(float x) { return fmaxf(x, 0.f) + log1pf(__expf(-fabsf(x))); }
#define XB_TMO      128
#define XB_XCNT(j)  (256  + 64 * (j))
#define XB_XSUB(j)  (1280 + 64 * (j))
#define XB_XGEN(j)  (2304 + 64 * (j))
#define XB_TOP      3328
#define XB_TOPGEN   3392
#define XCD_BAR_WORDS 3456
#define XB_SPIN_CAP (1u << 18)

__device__ __forceinline__ unsigned xb_ld(unsigned* p)              { return __hip_atomic_load(p, __ATOMIC_RELAXED, __HIP_MEMORY_SCOPE_AGENT); }
__device__ __forceinline__ unsigned xb_add(unsigned* p, unsigned v) { return __hip_atomic_fetch_add(p, v, __ATOMIC_RELAXED, __HIP_MEMORY_SCOPE_AGENT); }
__device__ __forceinline__ unsigned xb_xcc_id() { return (unsigned)__builtin_amdgcn_s_getreg((3 << 11) | 20) & 0xFu; }
#define XB_SPIN(cond, bar) do { unsigned _sp = 0; while (cond) { __builtin_amdgcn_s_sleep(1); \
    if ((++_sp & 255u) == 0u) { if (xb_ld(&(bar)[XB_TMO])) break; if (_sp > XB_SPIN_CAP) { atomicAdd(&(bar)[XB_TMO], 1u); break; } } } } while (0)

struct XcdBarrier {
    unsigned* bar; unsigned x;
    volatile LAS unsigned* st;
};

__device__ __forceinline__ XcdBarrier xcd_barrier_post(unsigned* bar, volatile LAS unsigned* st) {
    XcdBarrier b; b.bar = bar; b.x = xb_xcc_id(); b.st = st;
    if (threadIdx.x == 0) (void)xb_add(&bar[XB_XCNT(b.x)], 1u);
    return b;
}
__device__ __forceinline__ void xcd_barrier_complete(unsigned* bar, unsigned x, unsigned& nloc, unsigned& nx) {
    const unsigned G = gridDim.x * gridDim.y * gridDim.z;
    unsigned sum, cnt, mine, sp = 0u;
    for (;;) {
        sum = 0u; cnt = 0u; mine = 0u;
#pragma unroll
        for (unsigned j = 0; j < 16; ++j) { const unsigned c = xb_ld(&bar[XB_XCNT(j)]); sum += c; cnt += (c > 0u) ? 1u : 0u; mine = (j == x) ? c : mine; }
        if (sum == G) break;
        __builtin_amdgcn_s_sleep(1);
        if ((++sp & 255u) == 0u) { if (xb_ld(&bar[XB_TMO])) break; if (sp > XB_SPIN_CAP) { atomicAdd(&bar[XB_TMO], 1u); break; } }
    }
    nloc = mine > 0u ? mine : 1u; nx = cnt > 0u ? cnt : 1u;
}

__device__ __forceinline__ void xcd_barrier(const XcdBarrier& b) {
    asm volatile("s_waitcnt vmcnt(0)" ::: "memory");
    __syncthreads();
    if (threadIdx.x == 0) {
        unsigned* bar = b.bar;
        __builtin_amdgcn_s_waitcnt(0);
        unsigned nloc = b.st[0], nx = b.st[1];
        if (nloc == 0u) { xcd_barrier_complete(bar, b.x, nloc, nx); b.st[0] = nloc; b.st[1] = nx; }
        const unsigned old = xb_add(&bar[XB_XSUB(b.x)], 1u);
        const unsigned gen = old / nloc;
        if (old + 1u == (gen + 1u) * nloc) {
            __builtin_amdgcn_fence(__ATOMIC_RELEASE, "agent");
            asm volatile("s_waitcnt vmcnt(0)" ::: "memory");
            const unsigned og = xb_add(&bar[XB_TOP], 1u);
            const unsigned tg = og / nx;
            if (og + 1u == (tg + 1u) * nx) xb_add(&bar[XB_TOPGEN], 1u);
            else XB_SPIN(xb_ld(&bar[XB_TOPGEN]) == tg, bar);
            __builtin_amdgcn_fence(__ATOMIC_ACQUIRE, "agent");
            xb_add(&bar[XB_XGEN(b.x)], 1u);
            asm volatile("s_waitcnt vmcnt(0)" ::: "memory");
        } else {
            XB_SPIN(xb_ld(&bar[XB_XGEN(b.x)]) == gen, bar);
            __builtin_amdgcn_fence(__ATOMIC_ACQUIRE, "agent");
            asm volatile("s_waitcnt vmcnt(0)" ::: "memory");
        }
    }
    __syncthreads();
}
struct Params {
    const float* in[21]; float* out; unsigned char* ws; int ph_lo, ph_hi, li, pad;
};
struct Frame {
    LAS unsigned char* lds;
    volatile LAS unsigned* MISC;
    gu32* ctl;
    int tid, lane, wave, vcu, G;
};
__device__ __forceinline__ void p0_transpose_item(const float* W, int K, int N, bf16* WT, int k0, int n0, int dst_row0, LAS float* scr, int lane) {
#pragma unroll 8
    for (int i = 0; i < 32; ++i) { const int kk = 2 * i + (lane >> 5); scr[kk * 33 + (lane & 31)] = W[(size_t)(k0 + kk) * N + n0 + (lane & 31)]; }
    LDS_WAIT(); asm volatile("" ::: "memory");
    const int c = lane & 7;
#pragma unroll
    for (int j = 0; j < 4; ++j) { const int n = (lane >> 3) + 8 * j; const LAS float* s = scr + (8 * c) * 33 + n;
        v4u o; o.x = pk2(s[0 * 33], s[1 * 33]); o.y = pk2(s[2 * 33], s[3 * 33]); o.z = pk2(s[4 * 33], s[5 * 33]); o.w = pk2(s[6 * 33], s[7 * 33]);
        *(GAS v4u*)(WT + (size_t)(dst_row0 + n) * K + k0 + 8 * c) = o; }
    LDS_WAIT(); asm volatile("" ::: "memory");
}
__device__ __forceinline__ const float* x_row(const Params& p, int m) { return m < TP ? p.in[0] + (size_t)m * DM : p.in[1] + (size_t)(m - TP) * DM; }
__device__ __forceinline__ void rms_row_to_bf16(const float* xrow, const float* w, bf16* orow, int lane) {
    const GAS f32x4* xr = (const GAS f32x4*)xrow + lane; const GAS f32x4* wr = (const GAS f32x4*)w + lane;
    f32x4 v[16]; float s = 0.f;
#pragma unroll
    for (int j = 0; j < 16; ++j) { v[j] = xr[64 * j]; s += (v[j].x * v[j].x + v[j].y * v[j].y) + (v[j].z * v[j].z + v[j].w * v[j].w); }
    const float r = rsqrtf(wave_sum(s) * (1.f / DM) + NORM_EPS);
    GAS v2u* o8 = (GAS v2u*)orow + lane;
#pragma unroll
    for (int j = 0; j < 16; ++j) { const f32x4 ww = wr[64 * j]; v2u o; o.x = pk2(v[j].x * r * ww.x, v[j].y * r * ww.y); o.y = pk2(v[j].z * r * ww.z, v[j].w * r * ww.w); o8[64 * j] = o; }
}
__device__ __forceinline__ void p0_prologue(Frame& F, const Params& p) {
    LAS float* scr = (LAS float*)(F.lds + RING_OFF + F.wave * 16384);
    const int gw = F.vcu * NWAVES + F.wave, NGW = F.G * NWAVES;
    unsigned char* ws = p.ws;
    bf16* Win_t = (bf16*)(ws + WS_WIN); bf16* Wout_t = (bf16*)(ws + WS_WOUT); bf16* Wgu_t = (bf16*)(ws + WS_WGU);
    constexpr int I_IN = (DM / 64) * (PROJ_W / 32), I_OUT = (DM / 64) * (DM / 32), I_G = (DM / 64) * (FF / 32);
    constexpr int NITEMS = I_IN + I_OUT + I_G;
    for (int it = gw; it < NITEMS; it += NGW) {
        int r = it;
        if (r < I_IN) { const int nb = r % (PROJ_W / 32), kb = r / (PROJ_W / 32); p0_transpose_item(p.in[7], DM, PROJ_W, Win_t, 64 * kb, 32 * nb, 32 * nb, scr, F.lane); continue; } r -= I_IN;
        if (r < I_OUT) { const int nb = r % (DM / 32), kb = r / (DM / 32); p0_transpose_item(p.in[13], DM, DM, Wout_t, 64 * kb, 32 * nb, 32 * nb, scr, F.lane); continue; } r -= I_OUT;
        { const int nb = r % (FF / 32), kb = r / (FF / 32), n0 = 32 * nb; p0_transpose_item(p.in[18], DM, FF, Wgu_t, 64 * kb, n0, 256 * (n0 >> 7) + (n0 & 127), scr, F.lane); }
    }
    { GAS v4u* z = (GAS v4u*)(Win_t + (size_t)PROJ_W * DM); const size_t n16 = (size_t)(PROJ_PAD - PROJ_W) * DM * 2 / 16;
      for (size_t i = (size_t)gw * 64 + F.lane; i < n16; i += (size_t)NGW * 64) z[i] = (v4u){0u, 0u, 0u, 0u}; }
    bf16* H = (bf16*)(ws + WS_H);
    for (int m = gw; m < MROWS; m += NGW) rms_row_to_bf16(x_row(p, m), p.in[14], H + (size_t)m * DM, F.lane);
}
__device__ __forceinline__ void w_down_convert(const Frame& F, const Params& p, int wi, int nw) {
    LAS float* scr = (LAS float*)(F.lds + RING_OFF + F.wave * 16384);
    bf16* Wdn_t = (bf16*)(p.ws + WS_WDN);
    constexpr int I_D = (FF / 64) * (DM / 32);
    for (int r = wi * NWAVES + F.wave; r < I_D; r += nw * NWAVES) { const int nb = r % (DM / 32), kb = r / (DM / 32); p0_transpose_item(p.in[20], FF, DM, Wdn_t, 64 * kb, 32 * nb, 32 * nb, scr, F.lane); }
}
__device__ __forceinline__ void w_up_convert(const Frame& F, const Params& p, int wi, int nw) {
    LAS float* scr = (LAS float*)(F.lds + RING_OFF + F.wave * 16384);
    bf16* Wgu_t = (bf16*)(p.ws + WS_WGU);
    constexpr int I_G = (DM / 64) * (FF / 32);
    for (int r = wi * NWAVES + F.wave; r < I_G; r += nw * NWAVES) { const int nb = r % (FF / 32), kb = r / (FF / 32), n0 = 32 * nb; p0_transpose_item(p.in[19], DM, FF, Wgu_t, 64 * kb, n0, 256 * (n0 >> 7) + 128 + (n0 & 127), scr, F.lane); }
}
__device__ __forceinline__ int rel_bucket_dev(int n) {
    if (n < 16) return n;
    int large = 16 + (int)(logf((float)n * 0.0625f) / 2.0794415416798357f * 16.0f);
    return large < 31 ? large : 31;
}
__device__ __forceinline__ void ph_copy_states(const Frame& F, const bf16* P, const float* ck, const float* cv, float* out) {
    const size_t gid = (size_t)F.vcu * 512 + F.tid, gs = (size_t)F.G * 512;
    for (size_t i = gid; i < 65536; i += gs) { const size_t j = i >> 9, c = i & 511; out[O_PWK + i] = bf2f(P[(TP - 128 + j) * PW + C_KA + c]); out[O_PWV + i] = bf2f(P[(TP - 128 + j) * PW + C_VA + c]); }
    for (size_t i = gid; i < 18432; i += gs) { const size_t r = i / 6144, c = i % 6144; out[O_PCONV + i] = bf2f(P[(TP - 3 + r) * PW + C_QKVG + c]); }
    for (size_t i = gid; i < 8388608; i += gs) { const size_t b = i >> 16, j = ((i >> 9) & 127) + 4, c = i & 511;
        float k, v;
        if (j < 128) { k = ck[(b * 128 + j) * 512 + c]; v = cv[(b * 128 + j) * 512 + c]; }
        else { const size_t r = TP + 4 * b + (j - 128); k = bf2f(P[r * PW + C_KA + c]); v = bf2f(P[r * PW + C_VA + c]); }
        out[O_SWK + i] = k; out[O_SWV + i] = v; }
    for (size_t i = gid; i < 2359296; i += gs) { const size_t b = i / 18432, r = (i % 18432) / 6144, c = i % 6144; out[O_SCONV + i] = bf2f(P[(TP + 4 * b + r + 1) * PW + C_QKVG + c]); }
}
__device__ __forceinline__ void ph_gated_norm(const Frame& F, const float* ORAW, const bf16* P, const float* gw, bf16* MIX, int row_lo, int row_hi) {
    const int lane = F.lane;
    for (int g = row_lo * 16 + F.vcu * NWAVES + F.wave; g < row_hi * 16; g += F.G * NWAVES) {
        const int row = g >> 4, h = g & 15;
        const float o0 = ORAW[(size_t)row * 2048 + h * 128 + 2 * lane], o1 = ORAW[(size_t)row * 2048 + h * 128 + 2 * lane + 1];
        const float r = rsqrtf(wave_sum(o0 * o0 + o1 * o1) * (1.f / 128.f) + NORM_EPS);
        const unsigned z = *(const unsigned*)(P + (size_t)row * PW + C_ZG + h * 128 + 2 * lane);
        const float y0 = o0 * r * gw[2 * lane] * silu_f(bflo(z)), y1 = o1 * r * gw[2 * lane + 1] * silu_f(bfhi(z));
        *(unsigned*)(MIX + (size_t)row * DM + 2048 + h * 128 + 2 * lane) = pk2(y0, y1);
    }
}
__device__ __forceinline__ f32x4 gemm_row_ld(const bf16* C, const float* slab, int row, int idx4) {
    if (row < TP) { const v2u w = ((const v2u*)(C + (size_t)row * DM))[idx4]; return (f32x4){bflo(w.x), bfhi(w.x), bflo(w.y), bfhi(w.y)}; }
    const f32x4* s = (const f32x4*)(slab + (size_t)(row - TP) * DM) + idx4; constexpr size_t st = (size_t)NSB * NST * DM / 4;
    return ((s[0] + s[st]) + (s[2 * st] + s[3 * st])) + ((s[4 * st] + s[5 * st]) + (s[6 * st] + s[7 * st]));
}
__device__ __forceinline__ void ph_postmix(const Frame& F, const Params& p, const bf16* MIXO, const float* SLAB, float* out, bf16* H) {
    const int lane = F.lane; const float* w_post = p.in[15]; const float* w_pre = p.in[16];
    for (int row = F.vcu * NWAVES + F.wave; row < MROWS; row += F.G * NWAVES) {
        const float* xrow = x_row(p, row);
        const f32x4* xr = (const f32x4*)xrow + lane;
        f32x4 v[16]; float s = 0.f;
#pragma unroll
        for (int j = 0; j < 16; ++j) { v[j] = gemm_row_ld(MIXO, SLAB, row, lane + 64 * j); s += (v[j].x * v[j].x + v[j].y * v[j].y) + (v[j].z * v[j].z + v[j].w * v[j].w); }
        const float r = rsqrtf(wave_sum(s) * (1.f / DM) + NORM_EPS); float s2 = 0.f;
        f32x4* orow = (f32x4*)(out + (size_t)row * DM) + lane;
#pragma unroll
        for (int j = 0; j < 16; ++j) { const f32x4 w = ((const f32x4*)w_post)[lane + 64 * j], x = xr[64 * j];
            v[j].x = x.x + v[j].x * r * w.x; v[j].y = x.y + v[j].y * r * w.y; v[j].z = x.z + v[j].z * r * w.z; v[j].w = x.w + v[j].w * r * w.w;
            orow[64 * j] = v[j]; s2 += (v[j].x * v[j].x + v[j].y * v[j].y) + (v[j].z * v[j].z + v[j].w * v[j].w); }
        const float r2 = rsqrtf(wave_sum(s2) * (1.f / DM) + NORM_EPS);
        v2u* hrow = (v2u*)(H + (size_t)row * DM) + lane;
#pragma unroll
        for (int j = 0; j < 16; ++j) { const f32x4 w = ((const f32x4*)w_pre)[lane + 64 * j]; v2u o; o.x = pk2(v[j].x * r2 * w.x, v[j].y * r2 * w.y); o.y = pk2(v[j].z * r2 * w.z, v[j].w * r2 * w.w); hrow[64 * j] = o; }
    }
}
__device__ __forceinline__ void ph_final(const Frame& F, const bf16* FFNO, const float* SLAB, const float* w_post, float* out) {
    const int lane = F.lane;
    for (int row = F.vcu * NWAVES + F.wave; row < MROWS; row += F.G * NWAVES) {
        f32x4* orow = (f32x4*)(out + (size_t)row * DM) + lane;
        f32x4 v[16]; float s = 0.f;
#pragma unroll
        for (int j = 0; j < 16; ++j) { v[j] = gemm_row_ld(FFNO, SLAB, row, lane + 64 * j); s += (v[j].x * v[j].x + v[j].y * v[j].y) + (v[j].z * v[j].z + v[j].w * v[j].w); }
        const float r = rsqrtf(wave_sum(s) * (1.f / DM) + NORM_EPS);
#pragma unroll
        for (int j = 0; j < 16; ++j) { const f32x4 w = ((const f32x4*)w_post)[lane + 64 * j], x = orow[64 * j];
            orow[64 * j] = (f32x4){x.x + v[j].x * r * w.x, x.y + v[j].y * r * w.y, x.z + v[j].z * r * w.z, x.w + v[j].w * r * w.w}; }
    }
}
__device__ __forceinline__ unsigned off_b(unsigned row, unsigned ch) { return 256u * row + 16u * (ch ^ (((row & 3) << 2) | ((row >> 2) & 3))); }
__device__ __forceinline__ unsigned row_read_addr_16(unsigned lane, unsigned rb, unsigned s) { return off_b((lane & 15) + 16 * rb, 4 * s + (lane >> 4)); }
__device__ __forceinline__ unsigned tr_read_addr_16(unsigned lane, unsigned c, unsigned ks, unsigned t) {
    const unsigned g = lane >> 4, q = (lane & 15) >> 2, p = lane & 3;
    return off_b(32 * ks + 8 * g + 4 * t + q, 2 * c + (p >> 1)) + 8 * (p & 1);
}
typedef short s16x4 __attribute__((ext_vector_type(4)));
__device__ __forceinline__ unsigned lds_addr(const LAS unsigned char* p) { return (unsigned)(__UINTPTR_TYPE__)p; }
__device__ __forceinline__ s16x4 tr_read_wait(unsigned a) { s16x4 r; asm volatile("ds_read_b64_tr_b16 %0, %1\n\ts_waitcnt lgkmcnt(0)" : "=&v"(r) : "v"(a) : "memory"); return r; }
__device__ __forceinline__ bf16x8 tr_frag(unsigned base, unsigned lane, unsigned c, unsigned ks) {
    const s16x4 lo = tr_read_wait(base + tr_read_addr_16(lane, c, ks, 0)), hi = tr_read_wait(base + tr_read_addr_16(lane, c, ks, 1));
    return (bf16x8){lo[0], lo[1], lo[2], lo[3], hi[0], hi[1], hi[2], hi[3]};
}
__device__ __forceinline__ v4u pack8(const float* y) { v4u o; o.x = pk2(y[0], y[1]); o.y = pk2(y[2], y[3]); o.z = pk2(y[4], y[5]); o.w = pk2(y[6], y[7]); return o; }
struct ScanBufs { bf16* wF; bf16* kdF; bf16* qeF; bf16* qkF; float* uF; float* egl; unsigned char* vbg; };
constexpr int PREP_B = 4;
constexpr int PA_SLOT = 17408;
constexpr int PA_IMG = PREP_B * PA_SLOT;
constexpr int PA_MSC = PA_IMG + 65536;
__device__ __forceinline__ void gdn_prep_a(const Frame& F, int un, int slot, const bf16* P, const float* AB, const float* conv_w, const float* a_log, const float* dt_bias, const ScanBufs sb) {
    constexpr int KIMG = PA_IMG, QIMG = PA_IMG + 16384, QEIMG = PA_IMG + 32768, KDIMG = PA_IMG + 49152, QKB = QIMG;
    LAS unsigned char* L = F.lds + RING_OFF;
    LAS float* gcs = (LAS float*)(L + PA_MSC); LAS float* bts = gcs + 64; LAS float* Af = (LAS float*)(L + slot * PA_SLOT);
    int zv = 0; asm volatile("" : "+v"(zv));
    const int tid = F.tid + zv, lane = tid & 63, wave = F.wave, quad = lane >> 4, l15 = lane & 15;
    const int h = un >> 7, n = un & 127, row0 = 64 * n;
    const int part = tid >> 7, tok0 = ((tid >> 4) & 7) * 8, cl = tid & 15, ch = part * 2048 + h * 128 + cl * 8;
    v4u xw[11]; f32x4 w0[4], w1[4];
    unsigned char* vbg = sb.vbg + (size_t)un * 32768;
    if (tid < 384) {
#pragma unroll
        for (int k = 0; k < 11; ++k) { const int r = row0 + tok0 - 3 + k, rc = r < 0 ? 0 : r; xw[k] = *(const v4u*)(P + (size_t)rc * PW + C_QKVG + ch); if (r < 0) xw[k] = (v4u){0u, 0u, 0u, 0u}; }
#pragma unroll
        for (int i = 0; i < 4; ++i) { const float* wp = conv_w + (size_t)i * 6144 + ch; w0[i] = *(const f32x4*)wp; w1[i] = *(const f32x4*)(wp + 4); }
    } else if (wave == 6) {
        const float a = AB[(size_t)(row0 + lane) * 32 + h], bb = AB[(size_t)(row0 + lane) * 32 + 16 + h];
        float g = -__expf(a_log[h]) * softplus_f(a + dt_bias[h]);
#pragma unroll
        for (int o = 1; o < 64; o <<= 1) { const float t = __shfl_up(g, o); if (lane >= o) g += t; }
        gcs[lane] = g; bts[lane] = sigmoid_f(bb);
    }
    LDS_BAR();
    const float glast = gcs[63];
    if (tid < 384) {
#pragma unroll
        for (int t = 0; t < 8; ++t) {
            const int tok = tok0 + t; float y[8];
#pragma unroll
            for (int e = 0; e < 8; ++e) y[e] = 0.f;
#pragma unroll
            for (int i = 0; i < 4; ++i) { const v4u w = xw[t + i];
                y[0] += bflo(w.x) * w0[i].x; y[1] += bfhi(w.x) * w0[i].y; y[2] += bflo(w.y) * w0[i].z; y[3] += bfhi(w.y) * w0[i].w;
                y[4] += bflo(w.z) * w1[i].x; y[5] += bfhi(w.z) * w1[i].y; y[6] += bflo(w.w) * w1[i].z; y[7] += bfhi(w.w) * w1[i].w; }
            float ss = 0.f;
#pragma unroll
            for (int e = 0; e < 8; ++e) { y[e] = silu_f(y[e]); ss += y[e] * y[e]; }
            const float gc = gcs[tok], be = bts[tok], egc = __expf(gc), ekd = __expf(glast - gc);
            const unsigned o = off_b(tok, cl); float t8[8];
            if (part < 2) {
#pragma unroll
                for (int sh = 1; sh < 16; sh <<= 1) ss += __shfl_xor(ss, sh);
                const float rn = rsqrtf(ss + NORM_EPS) * (part == 0 ? 0.08838834764831845f : 1.0f);
#pragma unroll
                for (int e = 0; e < 8; ++e) y[e] *= rn;
            }
            if (part == 0) {
                *(LAS v4u*)(L + QIMG + o) = pack8(y);
#pragma unroll
                for (int e = 0; e < 8; ++e) t8[e] = y[e] * egc;
                *(LAS v4u*)(L + QEIMG + o) = pack8(t8);
            } else if (part == 1) {
                *(LAS v4u*)(L + KIMG + o) = pack8(y);
#pragma unroll
                for (int e = 0; e < 8; ++e) t8[e] = y[e] * (be * egc);
                *(v4u*)(vbg + 16384 + o) = pack8(t8);
#pragma unroll
                for (int e = 0; e < 8; ++e) t8[e] = y[e] * ekd;
                *(LAS v4u*)(L + KDIMG + o) = pack8(t8);
            } else {
#pragma unroll
                for (int e = 0; e < 8; ++e) t8[e] = y[e] * be;
                *(v4u*)(vbg + o) = pack8(t8);
            }
        }
    }
    LDS_BAR();
    f32x4 accj[3];
#pragma unroll
    for (int r = 0; r < 3; ++r) {
        const int job = wave + 8 * r; accj[r] = (f32x4){0.f, 0.f, 0.f, 0.f};
        if (job < 20) {
            const int idx = job < 10 ? job : job - 10, ti = idx >= 6 ? 3 : idx >= 3 ? 2 : idx >= 1 ? 1 : 0, tj = idx - ti * (ti + 1) / 2;
            const int aimg = job < 10 ? KIMG : QIMG;
#pragma unroll
            for (int s = 0; s < 4; ++s) { const bf16x8 a = *(const LAS bf16x8*)(L + aimg + row_read_addr_16(lane, ti, s)), b = *(const LAS bf16x8*)(L + KIMG + row_read_addr_16(lane, tj, s));
                accj[r] = __builtin_amdgcn_mfma_f32_16x16x32_bf16(a, b, accj[r], 0, 0, 0); }
        }
    }
    LDS_BAR();
#pragma unroll
    for (int r = 0; r < 3; ++r) {
        const int job = wave + 8 * r;
        if (job < 20) {
            const int idx = job < 10 ? job : job - 10, ti = idx >= 6 ? 3 : idx >= 3 ? 2 : idx >= 1 ? 1 : 0, tj = idx - ti * (ti + 1) / 2;
            const int j = 16 * tj + l15; const float gj = gcs[j];
#pragma unroll
            for (int e = 0; e < 4; ++e) { const int i = 16 * ti + 4 * quad + e; const float dec = __expf(fminf(gcs[i] - gj, 0.f));
                if (job < 10) Af[i * 68 + j] = (i > j) ? bts[i] * accj[r][e] * dec : 0.f;
                else ((LAS bf16*)(L + QKB))[i * 72 + j] = (bf16)f2bf(accj[r][e] * dec); }
        }
    }
    LDS_BAR();
    {
        const unsigned base = lds_addr(L);
#pragma unroll 1
        for (int job = wave; job < 40; job += 8) {
            if (job < 16) { const int ti = job >> 2, s = job & 3;
                *(v4u*)(sb.qeF + ((size_t)(un * 16 + job) * 64 + lane) * 8) = *(const LAS v4u*)(L + QEIMG + row_read_addr_16(lane, ti, s)); }
            else if (job < 32) { const int f = job - 16, di = f >> 1, s2 = f & 1;
                const bf16x8 fr = tr_frag(base + KDIMG, lane, di, s2);
                *(bf16x8*)(sb.kdF + ((size_t)(un * 16 + f) * 64 + lane) * 8) = fr; }
            else { const int f = job - 32, ti = f >> 1, s2 = f & 1, i = 16 * ti + l15, j0 = 32 * s2 + 8 * quad;
                v4u w = *(const LAS v4u*)(L + QKB + i * 144 + j0 * 2);
                w.x = (j0 + 0 <= i ? w.x & 0xffffu : 0u) | (j0 + 1 <= i ? w.x & 0xffff0000u : 0u); w.y = (j0 + 2 <= i ? w.y & 0xffffu : 0u) | (j0 + 3 <= i ? w.y & 0xffff0000u : 0u);
                w.z = (j0 + 4 <= i ? w.z & 0xffffu : 0u) | (j0 + 5 <= i ? w.z & 0xffff0000u : 0u); w.w = (j0 + 6 <= i ? w.w & 0xffffu : 0u) | (j0 + 7 <= i ? w.w & 0xffff0000u : 0u);
                *(v4u*)(sb.qkF + ((size_t)(un * 8 + f) * 64 + lane) * 8) = w; }
        }
    }
    if (tid == 0) sb.egl[un] = __expf(glast);
    LDS_BAR();
}
__device__ __forceinline__ void gdn_prep_c(const Frame& F, int un, int slot, const ScanBufs sb) {
    constexpr int VBIMG = PA_IMG, KGIMG = PA_IMG + 16384, WT = PA_IMG + 32768;
    LAS unsigned char* L = F.lds + RING_OFF;
    int zv = 0; asm volatile("" : "+v"(zv));
    const int tid = F.tid + zv, lane = tid & 63, wave = F.wave, quad = lane >> 4, l15 = lane & 15;
    const unsigned char* vbg = sb.vbg + (size_t)un * 32768;
#pragma unroll
    for (int it = 0; it < 4; ++it) { const int o = (tid + 512 * it) * 16; *(LAS v4u*)(L + VBIMG + o) = *(const v4u*)(vbg + o); }
    LDS_BAR();
    {
        const int ti = wave & 3, which = wave >> 2; const unsigned base = lds_addr(L) + (which ? KGIMG : VBIMG);
        bf16x8 ta[2];
#pragma unroll
        for (int s2 = 0; s2 < 2; ++s2) ta[s2] = *(const LAS bf16x8*)(L + slot * PA_SLOT + (16 * ti + l15) * 144 + (32 * s2 + 8 * quad) * 2);
#pragma unroll 2
        for (int ct = 0; ct < 8; ++ct) {
            f32x4 acc = (f32x4){0.f, 0.f, 0.f, 0.f};
            { const unsigned a0 = base + tr_read_addr_16(lane, ct, 0, 0), a1 = base + tr_read_addr_16(lane, ct, 0, 1), a2 = base + tr_read_addr_16(lane, ct, 1, 0), a3 = base + tr_read_addr_16(lane, ct, 1, 1);
              s16x4 t0, t1, t2, t3;
              asm volatile("ds_read_b64_tr_b16 %0, %4\n\tds_read_b64_tr_b16 %1, %5\n\tds_read_b64_tr_b16 %2, %6\n\tds_read_b64_tr_b16 %3, %7\n\ts_waitcnt lgkmcnt(0)"
                           : "=&v"(t0), "=&v"(t1), "=&v"(t2), "=&v"(t3) : "v"(a0), "v"(a1), "v"(a2), "v"(a3) : "memory");
              acc = __builtin_amdgcn_mfma_f32_16x16x32_bf16(ta[0], (bf16x8){t0[0], t0[1], t0[2], t0[3], t1[0], t1[1], t1[2], t1[3]}, acc, 0, 0, 0);
              acc = __builtin_amdgcn_mfma_f32_16x16x32_bf16(ta[1], (bf16x8){t2[0], t2[1], t2[2], t2[3], t3[0], t3[1], t3[2], t3[3]}, acc, 0, 0, 0); }
            if (which == 0) *(f32x4*)(sb.uF + ((size_t)((un * 4 + ti) * 8 + ct) * 64 + lane) * 4) = acc;
            else {
#pragma unroll
                for (int e = 0; e < 4; ++e) ((LAS bf16*)(L + WT))[(16 * ti + 4 * quad + e) * 136 + 16 * ct + l15] = (bf16)f2bf(acc[e]); }
        }
    }
    LDS_BAR();
#pragma unroll
    for (int it = 0; it < 2; ++it) { const int idx = tid + 512 * it, fr = idx >> 6, ln = idx & 63, ti = fr >> 2, s = fr & 3;
        *(v4u*)(sb.wF + ((size_t)(un * 16 + fr) * 64 + ln) * 8) = *(const LAS v4u*)(L + WT + (16 * ti + (ln & 15)) * 272 + (32 * s + 8 * (ln >> 4)) * 2); }
    LDS_BAR();
}
__device__ __forceinline__ void gdn_prep_invert_blocked(const Frame& F, int nslots) {
    LAS unsigned char* L = F.lds + RING_OFF;
    int zv = 0; asm volatile("" : "+v"(zv));
    const int tid = F.tid + zv, lane = tid & 63, wave = F.wave, q = lane >> 4, l15 = lane & 15;
    if (wave < nslots) {
        const LAS float* Af = (const LAS float*)(L + wave * PA_SLOT); LAS float* Tf = (LAS float*)(L + PA_IMG + wave * 16384);
        float t[16];
#pragma unroll
        for (int i = 0; i < 16; ++i) {
            const LAS float* rp = Af + (16 * q + i) * 68 + 16 * q; f32x4 ar[4];
#pragma unroll
            for (int jb = 0; jb < 4; ++jb) if (4 * jb < i) ar[jb] = *(const LAS f32x4*)(rp + 4 * jb);
            float acc = (l15 == i) ? 1.f : 0.f;
#pragma unroll
            for (int j = 0; j < i; ++j) acc -= ar[j >> 2][j & 3] * t[j];
            t[i] = acc;
        }
#pragma unroll
        for (int i = 0; i < 16; ++i) Tf[(16 * q + i) * 64 + 16 * q + l15] = t[i];
    }
    LDS_BAR();
#pragma unroll
    for (int d = 1; d < 4; ++d) {
        const int per = 4 - d, total = nslots * per;
#pragma unroll 1
        for (int job = wave; job < total; job += NWAVES) {
            const int slot = job / per, b = job - slot * per, a = b + d;
            const LAS float* Af = (const LAS float*)(L + slot * PA_SLOT); LAS float* Tf = (LAS float*)(L + PA_IMG + slot * 16384);
            f32x4 acc = (f32x4){0.f, 0.f, 0.f, 0.f};
#pragma unroll 1
            for (int c = b; c < a; ++c)
#pragma unroll
                for (int s4 = 0; s4 < 4; ++s4) acc = __builtin_amdgcn_mfma_f32_16x16x4f32(Af[(16 * a + l15) * 68 + 16 * c + 4 * s4 + q], Tf[(16 * c + 4 * s4 + q) * 64 + 16 * b + l15], acc, 0, 0, 0);
            f32x4 res = (f32x4){0.f, 0.f, 0.f, 0.f};
#pragma unroll
            for (int s4 = 0; s4 < 4; ++s4) res = __builtin_amdgcn_mfma_f32_16x16x4f32(-Tf[(16 * a + l15) * 64 + 16 * a + 4 * q + s4], acc[s4], res, 0, 0, 0);
#pragma unroll
            for (int r = 0; r < 4; ++r) Tf[(16 * a + 4 * q + r) * 64 + 16 * b + l15] = res[r];
        }
        LDS_BAR();
    }
    for (int idx = tid; idx < nslots * 4096; idx += NWAVES * 64) { const int slot = idx >> 12, e = idx & 4095, i = e >> 6, c = e & 63;
        const float v = ((c >> 4) <= (i >> 4)) ? ((const LAS float*)(L + PA_IMG + slot * 16384))[e] : 0.f;
        ((LAS bf16*)(L + slot * PA_SLOT))[i * 72 + c] = (bf16)f2bf(v); }
    VM_WAIT();
    LDS_BAR();
}
__device__ __forceinline__ void gdn_prep_all(const Frame& F, const bf16* P, const float* AB, const float* conv_w, const float* a_log, const float* dt_bias, const ScanBufs sb) {
#pragma unroll 1
    for (int u0 = F.vcu; u0 < NUNIT; u0 += F.G * PREP_B) {
#pragma unroll 1
        for (int s = 0; s < PREP_B; ++s) { const int un = u0 + s * F.G; if (un < NUNIT) gdn_prep_a(F, un, s, P, AB, conv_w, a_log, dt_bias, sb); }
        { int ns = 0;
#pragma unroll
          for (int k = 0; k < PREP_B; ++k) ns += (u0 + k * F.G < NUNIT) ? 1 : 0;
          gdn_prep_invert_blocked(F, ns); }
#pragma unroll 1
        for (int s = 0; s < PREP_B; ++s) { const int un = u0 + s * F.G; if (un < NUNIT) gdn_prep_c(F, un, s, sb); }
    }
}
constexpr int SCAN_D = 4;
__device__ __forceinline__ void gdn_scan_unit(const Frame& F, int h, int sl, const ScanBufs sb, float* ORAW, float* Sout) {
    constexpr int SB_PITCH = 272, VN_PITCH = 144, SB_OFF = 0, VN_OFF = 16 * SB_PITCH;
    LAS unsigned char* L = F.lds + RING_OFF;
    const int lane = F.lane, wave = F.wave, quad = lane >> 4, l15 = lane & 15;
    for (int i = F.tid; i < (16 * SB_PITCH) / 4; i += NWAVES * 64) ((LAS unsigned*)(L + SB_OFF))[i] = 0u;
    __syncthreads();
    const LAS unsigned char* sfp = L + SB_OFF + l15 * SB_PITCH + quad * 16;
    const LAS unsigned char* vfp = L + VN_OFF + l15 * VN_PITCH + quad * 16;
    if (wave < 4) {
        const int ti = wave;
        f32x4 S0 = (f32x4){0.f, 0.f, 0.f, 0.f}, S1 = S0;
        bf16x8 wf[SCAN_D][4], kdf[SCAN_D][2][2]; f32x4 uf[SCAN_D]; float gl[SCAN_D];
#define LOAD_C(un_, W, KD, U, G) do { \
        _Pragma("unroll") for (int s = 0; s < 4; ++s) W[s] = *(const bf16x8*)(sb.wF + ((size_t)((un_) * 16 + ti * 4 + s) * 64 + lane) * 8); \
        _Pragma("unroll") for (int d = 0; d < 2; ++d) _Pragma("unroll") for (int s2 = 0; s2 < 2; ++s2) KD[d][s2] = *(const bf16x8*)(sb.kdF + ((size_t)((un_) * 16 + (2 * ti + d) * 2 + s2) * 64 + lane) * 8); \
        U = *(const f32x4*)(sb.uF + ((size_t)(((un_) * 4 + ti) * 8 + sl) * 64 + lane) * 4); G = sb.egl[un_]; } while (0)
#pragma unroll
        for (int k = 0; k < SCAN_D; ++k) LOAD_C(h * 128 + k, wf[k], kdf[k], uf[k], gl[k]);
#pragma unroll 1
        for (int n0 = 0; n0 < 128; n0 += SCAN_D) {
#pragma unroll
            for (int k = 0; k < SCAN_D; ++k) {
                f32x4 acc = (f32x4){0.f, 0.f, 0.f, 0.f};
#pragma unroll
                for (int s = 0; s < 4; ++s) { const bf16x8 sf = *(const LAS bf16x8*)(sfp + s * 64); acc = __builtin_amdgcn_mfma_f32_16x16x32_bf16(wf[k][s], sf, acc, 0, 0, 0); }
                const f32x4 vn = uf[k] - acc;
                { v2u w; w.x = pk2(vn[0], vn[1]); w.y = pk2(vn[2], vn[3]); *(LAS v2u*)(L + VN_OFF + l15 * VN_PITCH + (16 * ti + 4 * quad) * 2) = w; }
                LDS_BAR();
                S0 = S0 * gl[k]; S1 = S1 * gl[k];
#pragma unroll
                for (int s2 = 0; s2 < 2; ++s2) { const bf16x8 vf = *(const LAS bf16x8*)(vfp + s2 * 64);
                    S0 = __builtin_amdgcn_mfma_f32_16x16x32_bf16(kdf[k][0][s2], vf, S0, 0, 0, 0); S1 = __builtin_amdgcn_mfma_f32_16x16x32_bf16(kdf[k][1][s2], vf, S1, 0, 0, 0); }
                { v2u w; w.x = pk2(S0[0], S0[1]); w.y = pk2(S0[2], S0[3]); *(LAS v2u*)(L + SB_OFF + l15 * SB_PITCH + (16 * (2 * ti) + 4 * quad) * 2) = w;
                  w.x = pk2(S1[0], S1[1]); w.y = pk2(S1[2], S1[3]); *(LAS v2u*)(L + SB_OFF + l15 * SB_PITCH + (16 * (2 * ti + 1) + 4 * quad) * 2) = w; }
                { const int nn = n0 + k + SCAN_D < 128 ? n0 + k + SCAN_D : 127; LOAD_C(h * 128 + nn, wf[k], kdf[k], uf[k], gl[k]); }
                LDS_BAR();
            }
        }
#undef LOAD_C
#pragma unroll
        for (int e = 0; e < 4; ++e) { Sout[((size_t)h * 128 + 16 * (2 * ti) + 4 * quad + e) * 128 + 16 * sl + l15] = S0[e]; Sout[((size_t)h * 128 + 16 * (2 * ti + 1) + 4 * quad + e) * 128 + 16 * sl + l15] = S1[e]; }
    } else {
        const int ti = wave - 4;
        bf16x8 qef[SCAN_D][4], qkf[SCAN_D][2];
#define LOAD_O(un_, QE, QK) do { \
        _Pragma("unroll") for (int s = 0; s < 4; ++s) QE[s] = *(const bf16x8*)(sb.qeF + ((size_t)((un_) * 16 + ti * 4 + s) * 64 + lane) * 8); \
        _Pragma("unroll") for (int s2 = 0; s2 < 2; ++s2) QK[s2] = *(const bf16x8*)(sb.qkF + ((size_t)((un_) * 8 + ti * 2 + s2) * 64 + lane) * 8); } while (0)
#pragma unroll
        for (int k = 0; k < SCAN_D; ++k) LOAD_O(h * 128 + k, qef[k], qkf[k]);
#pragma unroll 1
        for (int n0 = 0; n0 < 128; n0 += SCAN_D) {
#pragma unroll
            for (int k = 0; k < SCAN_D; ++k) {
                const int n = n0 + k;
                f32x4 acc = (f32x4){0.f, 0.f, 0.f, 0.f};
#pragma unroll
                for (int s = 0; s < 4; ++s) { const bf16x8 sf = *(const LAS bf16x8*)(sfp + s * 64); acc = __builtin_amdgcn_mfma_f32_16x16x32_bf16(qef[k][s], sf, acc, 0, 0, 0); }
                LDS_BAR();
#pragma unroll
                for (int s2 = 0; s2 < 2; ++s2) { const bf16x8 vf = *(const LAS bf16x8*)(vfp + s2 * 64); acc = __builtin_amdgcn_mfma_f32_16x16x32_bf16(qkf[k][s2], vf, acc, 0, 0, 0); }
#pragma unroll
                for (int e = 0; e < 4; ++e) ORAW[(size_t)(64 * n + 16 * ti + 4 * quad + e) * 2048 + h * 128 + 16 * sl + l15] = acc[e];
                { const int nn = n + SCAN_D < 128 ? n + SCAN_D : 127; LOAD_O(h * 128 + nn, qef[k], qkf[k]); }
                LDS_BAR();
            }
        }
#undef LOAD_O
    }
    __syncthreads();
}
struct SampIn { float S[32]; float in[11]; float z0, z1; };
__device__ __forceinline__ void samp_load(SampIn& I, int u, int tid, int lane, int wave, const bf16* P, const float* AB, const float* state_conv, const float* conv_w, const float* a_log, const float* dt_bias, const float* S0p) {
    const int b = u >> 4, h = u & 15, j = tid >> 2, qd = tid & 3;
#pragma unroll
    for (int i = 0; i < 32; ++i) I.S[i] = S0p[((size_t)u * 128 + qd * 32 + i) * 128 + j];
    const bool cv = tid < 384, gt = !cv && tid < 388;
    const int part = cv ? tid >> 7 : 0, ch = tid & 127, c = part * 2048 + h * 128 + ch;
    const size_t grow = (size_t)TP + 4 * b + (gt ? tid - 384 : 0);
    const float* f[7];
#pragma unroll
    for (int r = 0; r < 3; ++r) f[r] = state_conv + ((size_t)b * 3 + r) * 6144 + c;
#pragma unroll
    for (int i = 0; i < 4; ++i) f[3 + i] = conv_w + (size_t)i * 6144 + c;
    if (gt) { f[0] = AB + grow * 32 + h; f[1] = AB + grow * 32 + 16 + h; f[2] = a_log + h; f[3] = dt_bias + h; }
    I.in[0] = *f[0]; I.in[1] = *f[1]; I.in[2] = *f[2];
#pragma unroll
    for (int t = 0; t < 4; ++t) I.in[3 + t] = bf2f(P[(size_t)(TP + 4 * b + t) * PW + C_QKVG + c]);
    I.in[7] = *f[3]; I.in[8] = *f[4]; I.in[9] = *f[5]; I.in[10] = *f[6];
    const size_t zrow = (size_t)TP + 4 * b + (wave & 3); I.z0 = bf2f(P[zrow * PW + C_ZG + h * 128 + lane]); I.z1 = bf2f(P[zrow * PW + C_ZG + h * 128 + lane + 64]);
}
__device__ __forceinline__ void gdn_sample_units(const Frame& F, int u0, int ustride, const bf16* P, const float* AB, const float* state_conv, const float* conv_w, const float* a_log, const float* dt_bias,
                                                 const float* gnw, const float* S0p, float* Sout, bf16* MIX) {
    LAS float* xs = (LAS float*)(F.lds + RING_OFF);
    LAS float* os = xs + 1536;
    LAS float* gs = os + 512; LAS float* bs = gs + 4;
    const int tid = F.tid, lane = F.lane, wave = F.wave, j = tid >> 2, qd = tid & 3;
    const float gn0 = gnw[lane], gn1 = gnw[lane + 64];
    SampIn C{}, N{};
    if (u0 < NSB * 16) samp_load(C, u0, tid, lane, wave, P, AB, state_conv, conv_w, a_log, dt_bias, S0p);
#pragma unroll 1
    for (int u = u0; u < NSB * 16; u += ustride) {
        const int b = u >> 4, h = u & 15, un = u + ustride;
        if (un < NSB * 16) samp_load(N, un, tid, lane, wave, P, AB, state_conv, conv_w, a_log, dt_bias, S0p);
        if (tid < 384) {
            const int part = tid >> 7, ch = tid & 127;
#pragma unroll
            for (int t = 0; t < 4; ++t) xs[(part * 4 + t) * 128 + ch] = silu_f(C.in[t] * C.in[7] + C.in[t + 1] * C.in[8] + C.in[t + 2] * C.in[9] + C.in[t + 3] * C.in[10]);
        } else if (tid < 388) {
            const int t = tid - 384;
            gs[t] = __expf(-__expf(C.in[2]) * softplus_f(C.in[0] + C.in[7])); bs[t] = sigmoid_f(C.in[1]);
        }
        LDS_BAR();
        { const int part = wave >> 2, t = wave & 3; LAS float* xv = xs + (part * 4 + t) * 128;
          const float v0 = xv[lane], v1 = xv[lane + 64];
          const float r = rsqrtf(wave_sum(v0 * v0 + v1 * v1) + NORM_EPS) * (part == 0 ? 0.08838834764831845f : 1.0f);
          xv[lane] = v0 * r; xv[lane + 64] = v1 * r; }
        LDS_BAR();
#pragma unroll 1
        for (int t = 0; t < 4; ++t) {
            const float a = gs[t], be = bs[t], v = xs[(8 + t) * 128 + j];
            const LAS float* kr = xs + (4 + t) * 128 + qd * 32; const LAS float* qr = xs + t * 128 + qd * 32;
            float r0 = 0.f, r1 = 0.f, r2 = 0.f, r3 = 0.f;
#pragma unroll
            for (int i = 0; i < 32; i += 4) { r0 += kr[i] * C.S[i]; r1 += kr[i + 1] * C.S[i + 1]; r2 += kr[i + 2] * C.S[i + 2]; r3 += kr[i + 3] * C.S[i + 3]; }
            float r = (r0 + r1) + (r2 + r3); r += __shfl_xor(r, 1); r += __shfl_xor(r, 2);
            const float c = be * (v - a * r);
            float o0 = 0.f, o1 = 0.f, o2 = 0.f, o3 = 0.f;
#pragma unroll
            for (int i = 0; i < 32; i += 4) {
                C.S[i] = a * C.S[i] + kr[i] * c; C.S[i + 1] = a * C.S[i + 1] + kr[i + 1] * c; C.S[i + 2] = a * C.S[i + 2] + kr[i + 2] * c; C.S[i + 3] = a * C.S[i + 3] + kr[i + 3] * c;
                o0 += qr[i] * C.S[i]; o1 += qr[i + 1] * C.S[i + 1]; o2 += qr[i + 2] * C.S[i + 2]; o3 += qr[i + 3] * C.S[i + 3]; }
            float o = (o0 + o1) + (o2 + o3); o += __shfl_xor(o, 1); o += __shfl_xor(o, 2);
            if (qd == 0) os[t * 128 + j] = o;
        }
#pragma unroll
        for (int i = 0; i < 32; ++i) Sout[((size_t)u * 128 + qd * 32 + i) * 128 + j] = C.S[i];
        LDS_BAR();
        if (wave < 4) { const int t = wave; const size_t row = (size_t)TP + 4 * b + t;
            const float o0 = os[t * 128 + lane], o1 = os[t * 128 + lane + 64];
            const float r = rsqrtf(wave_sum(o0 * o0 + o1 * o1) * (1.f / 128.f) + NORM_EPS);
            MIX[row * DM + 2048 + h * 128 + lane] = (bf16)f2bf(o0 * r * gn0 * silu_f(C.z0));
            MIX[row * DM + 2048 + h * 128 + lane + 64] = (bf16)f2bf(o1 * r * gn1 * silu_f(C.z1)); }
        LDS_BAR();
        C = N;
    }
}
constexpr int ATT_KIMG = 0, ATT_VIMG = 69632, ATT_IMG_ROWS = 272;
constexpr int ATT_BTAB_OFF = MISC_OFF + 128;
__device__ __forceinline__ void attn_tile(LAS unsigned char* L, const LAS float* btab, const bf16* qptr, int kt0, int dist0, int jlo, int jhi, float sink, int g, bf16* optr, int lane) {
    const int quad = lane >> 4, l15 = lane & 15;
    bf16x8 qf[4];
#pragma unroll
    for (int s = 0; s < 4; ++s) qf[s] = *(const bf16x8*)(qptr + 32 * s + 8 * quad);
    f32x4 sc[9];
#pragma unroll
    for (int i = 0; i < 9; ++i) { sc[i] = (f32x4){0.f, 0.f, 0.f, 0.f};
#pragma unroll
        for (int s = 0; s < 4; ++s) { const bf16x8 kf = *(const LAS bf16x8*)(L + ATT_KIMG + row_read_addr_16(lane, kt0 + i, s)); sc[i] = __builtin_amdgcn_mfma_f32_16x16x32_bf16(kf, qf[s], sc[i], 0, 0, 0); } }
    float m = sink;
#pragma unroll
    for (int i = 0; i < 9; ++i)
#pragma unroll
        for (int r = 0; r < 4; ++r) { const int dist = dist0 - 16 * i - r, j = 16 * (kt0 + i) + 4 * quad + r; const bool ok = dist >= 0 && dist <= 128 && j >= jlo && j < jhi;
            const float b = btab[g * 132 + (ok ? dist : 0)]; const float v = ok ? sc[i][r] * 0.08838834764831845f + b : -3.0e38f; sc[i][r] = v; m = fmaxf(m, v); }
    m = fmaxf(m, __shfl_xor(m, 16)); m = fmaxf(m, __shfl_xor(m, 32));
    float sum = 0.f;
#pragma unroll
    for (int i = 0; i < 9; ++i)
#pragma unroll
        for (int r = 0; r < 4; ++r) { const float pv = sc[i][r] > -1.0e38f ? __expf(sc[i][r] - m) : 0.f; sc[i][r] = pv; sum += pv; }
    sum += __shfl_xor(sum, 16); sum += __shfl_xor(sum, 32);
    const float inv = 1.0f / (sum + __expf(sink - m));
    bf16x8 pf[5];
#pragma unroll
    for (int p = 0; p < 5; ++p) {
        const f32x4 a = sc[2 * p] * inv; const f32x4 b = (p < 4) ? sc[2 * p + 1 < 9 ? 2 * p + 1 : 8] * inv : (f32x4){0.f, 0.f, 0.f, 0.f};
        const unsigned w0 = pk2(a[0], a[1]), w1 = pk2(a[2], a[3]), w2 = pk2(b[0], b[1]), w3 = pk2(b[2], b[3]);
        pf[p] = __builtin_bit_cast(bf16x8, (v4u){w0, w1, w2, w3});
    }
    const unsigned vbase = lds_addr(L) + ATT_VIMG; const unsigned q4 = (unsigned)l15 >> 2, p2 = (unsigned)lane & 3;
    const unsigned vrow = 16u * (unsigned)kt0 + 4u * (unsigned)quad + q4;
#pragma unroll
    for (int c = 0; c < 8; ++c) {
        const unsigned va = vbase + off_b(vrow, 2 * c + (p2 >> 1)) + 8 * (p2 & 1);
        s16x4 t0, t1, t2, t3, t4, t5, t6, t7, t8, t9;
        asm volatile("ds_read_b64_tr_b16 %0, %10\n\tds_read_b64_tr_b16 %1, %10 offset:4096\n\tds_read_b64_tr_b16 %2, %10 offset:8192\n\tds_read_b64_tr_b16 %3, %10 offset:12288\n\t"
                     "ds_read_b64_tr_b16 %4, %10 offset:16384\n\tds_read_b64_tr_b16 %5, %10 offset:20480\n\tds_read_b64_tr_b16 %6, %10 offset:24576\n\tds_read_b64_tr_b16 %7, %10 offset:28672\n\t"
                     "ds_read_b64_tr_b16 %8, %10 offset:32768\n\tds_read_b64_tr_b16 %9, %10 offset:36864\n\ts_waitcnt lgkmcnt(0)"
                     : "=&v"(t0), "=&v"(t1), "=&v"(t2), "=&v"(t3), "=&v"(t4), "=&v"(t5), "=&v"(t6), "=&v"(t7), "=&v"(t8), "=&v"(t9) : "v"(va) : "memory");
        f32x4 o = (f32x4){0.f, 0.f, 0.f, 0.f};
        o = __builtin_amdgcn_mfma_f32_16x16x32_bf16((bf16x8){t0[0], t0[1], t0[2], t0[3], t1[0], t1[1], t1[2], t1[3]}, pf[0], o, 0, 0, 0);
        o = __builtin_amdgcn_mfma_f32_16x16x32_bf16((bf16x8){t2[0], t2[1], t2[2], t2[3], t3[0], t3[1], t3[2], t3[3]}, pf[1], o, 0, 0, 0);
        o = __builtin_amdgcn_mfma_f32_16x16x32_bf16((bf16x8){t4[0], t4[1], t4[2], t4[3], t5[0], t5[1], t5[2], t5[3]}, pf[2], o, 0, 0, 0);
        o = __builtin_amdgcn_mfma_f32_16x16x32_bf16((bf16x8){t6[0], t6[1], t6[2], t6[3], t7[0], t7[1], t7[2], t7[3]}, pf[3], o, 0, 0, 0);
        o = __builtin_amdgcn_mfma_f32_16x16x32_bf16((bf16x8){t8[0], t8[1], t8[2], t8[3], t9[0], t9[1], t9[2], t9[3]}, pf[4], o, 0, 0, 0);
        v2u w; w.x = pk2(o[0], o[1]); w.y = pk2(o[2], o[3]);
        *(v2u*)(optr + 16 * c + 4 * quad) = w;
    }
}
__device__ __forceinline__ void attn_btab(const Frame& F, const float* rel_bias, int kvh) {
    LAS float* btab = (LAS float*)(F.lds + ATT_BTAB_OFF);
    for (int t = F.tid; t < 4 * 129; t += NWAVES * 64) { const int g = t / 129, d = t - g * 129; btab[g * 132 + d] = rel_bias[rel_bucket_dev(d) * 16 + kvh * 4 + g]; }
}
__device__ __forceinline__ void attn_prompt_unit(const Frame& F, int qb, int kvh, const bf16* P, const float* rel_bias, const float* sinks, bf16* MIX) {
    LAS unsigned char* L = F.lds + RING_OFF;
    const int tid = F.tid, lane = F.lane, wave = F.wave;
    attn_btab(F, rel_bias, kvh);
    const int krow0 = 128 * (qb - 1);
#pragma unroll 2
    for (int it = 0; it < 8; ++it) { const int cid = tid + 512 * it, row = cid >> 4, ch = cid & 15, gr = krow0 + row;
        v4u kv = (v4u){0u, 0u, 0u, 0u}, vv = kv;
        if (gr >= 0) { kv = *(const v4u*)(P + (size_t)gr * PW + C_KA + kvh * 128 + ch * 8); vv = *(const v4u*)(P + (size_t)gr * PW + C_VA + kvh * 128 + ch * 8); }
        *(LAS v4u*)(L + ATT_KIMG + off_b(row, ch)) = kv; *(LAS v4u*)(L + ATT_VIMG + off_b(row, ch)) = vv; }
    if (tid < 256) { const int row = 256 + (tid >> 4), ch = tid & 15; *(LAS v4u*)(L + ATT_VIMG + off_b(row, ch)) = (v4u){0u, 0u, 0u, 0u}; *(LAS v4u*)(L + ATT_KIMG + off_b(row, ch)) = (v4u){0u, 0u, 0u, 0u}; }
    __syncthreads();
    const LAS float* btab = (const LAS float*)(F.lds + ATT_BTAB_OFF);
    const int quad = lane >> 4, l15 = lane & 15, g = wave >> 1, h = kvh * 4 + g; const float sink = sinks[h];
#pragma unroll 1
    for (int k = 0; k < 4; ++k) { const int qt = (wave & 1) * 4 + k, row = 128 * qb + 16 * qt + l15;
        attn_tile(L, btab, P + (size_t)row * PW + C_QA + h * 128, qt, 128 + l15 - 4 * quad, qb == 0 ? 128 : 0, 256, sink, g, MIX + (size_t)row * DM + h * 128, lane); }
    __syncthreads();
}
__device__ __forceinline__ void attn_sample_unit(const Frame& F, int b, int kvh, const bf16* P, const float* ck, const float* cv, const float* rel_bias, const float* sinks, bf16* MIX) {
    LAS unsigned char* L = F.lds + RING_OFF;
    const int tid = F.tid, lane = F.lane, wave = F.wave;
    attn_btab(F, rel_bias, kvh);
#pragma unroll 1
    for (int it = 0; it < 5; ++it) { const int cid = tid + 512 * it, row = cid >> 4, ch = cid & 15;
        v4u kv = (v4u){0u, 0u, 0u, 0u}, vv = kv;
        if (row < 128) { const float* kp = ck + ((size_t)(b * 128 + row) * 4 + kvh) * 128 + ch * 8; const float* vp = cv + ((size_t)(b * 128 + row) * 4 + kvh) * 128 + ch * 8;
            const f32x4 k0 = *(const f32x4*)kp, k1 = *(const f32x4*)(kp + 4), v0 = *(const f32x4*)vp, v1 = *(const f32x4*)(vp + 4);
            kv = (v4u){pk2(k0.x, k0.y), pk2(k0.z, k0.w), pk2(k1.x, k1.y), pk2(k1.z, k1.w)}; vv = (v4u){pk2(v0.x, v0.y), pk2(v0.z, v0.w), pk2(v1.x, v1.y), pk2(v1.z, v1.w)}; }
        else if (row < 132) { const size_t gr = (size_t)TP + 4 * b + (row - 128); kv = *(const v4u*)(P + gr * PW + C_KA + kvh * 128 + ch * 8); vv = *(const v4u*)(P + gr * PW + C_VA + kvh * 128 + ch * 8); }
        *(LAS v4u*)(L + ATT_KIMG + off_b(row, ch)) = kv; *(LAS v4u*)(L + ATT_VIMG + off_b(row, ch)) = vv; }
    __syncthreads();
    if (wave == 0) {
        const LAS float* btab = (const LAS float*)(F.lds + ATT_BTAB_OFF);
        const int quad = lane >> 4, l15 = lane & 15, g = l15 >> 2, t = l15 & 3, h = kvh * 4 + g, row = TP + 4 * b + t;
        attn_tile(L, btab, P + (size_t)row * PW + C_QA + h * 128, 0, 128 + t - 4 * quad, 0, 132, sinks[h], g, MIX + (size_t)row * DM + h * 128, lane);
    }
    __syncthreads();
}
constexpr int N_PHASES = 10;
__global__ void __launch_bounds__(NWAVES * 64, 2) mega_fwd(Params p) {
    extern __shared__ __attribute__((aligned(16))) unsigned char lds[];
    Frame F;
    F.lds = (LAS unsigned char*)lds;
    F.MISC = (volatile LAS unsigned*)(F.lds + MISC_OFF);
    F.tid = threadIdx.x; F.lane = F.tid & 63; F.wave = __builtin_amdgcn_readfirstlane(F.tid >> 6);
    F.G = gridDim.x; { const int bx = blockIdx.x; F.vcu = (F.G % 8 == 0) ? (bx % 8) * (F.G / 8) + bx / 8 : bx; }
    unsigned char* ws = p.ws;
    F.ctl = (gu32*)(ws + WS_CTL);
    for (int u = F.tid; u < (LDS_BYTES - LDSCTL_OFF) / 4; u += NWAVES * 64) ((LAS unsigned*)(F.lds + LDSCTL_OFF))[u] = 0u;
    __syncthreads();
    XcdBarrier bar = xcd_barrier_post((unsigned*)(F.ctl + CW_BAR) + p.li * XCD_BAR_WORDS, F.MISC + 8);
    const int lo = p.ph_lo, hi = p.ph_hi;
#define IN(k) (lo <= (k) && (k) < hi)
#define BOTH(k) (IN(k) && IN((k) + 1))
#define GRID_BAR() xcd_barrier(bar)
    bf16* Win_t = (bf16*)(ws + WS_WIN); bf16* Wout_t = (bf16*)(ws + WS_WOUT); bf16* Wgu_t = (bf16*)(ws + WS_WGU); bf16* Wdn_t = (bf16*)(ws + WS_WDN);
    bf16* H = (bf16*)(ws + WS_H); bf16* MIX = (bf16*)(ws + WS_MIX); bf16* P = (bf16*)(ws + WS_P); bf16* ACT = (bf16*)(ws + WS_ACT);
    float* AB = (float*)(ws + WS_AB); bf16* MIXO = (bf16*)(ws + WS_MIXO); bf16* FFNO = (bf16*)(ws + WS_FFNO);
    float* ORAW = (float*)(ws + WS_ORAW); float* SLAB = (float*)(ws + WS_VBG);
    const ScanBufs sb{(bf16*)(ws + WS_WF), (bf16*)(ws + WS_KDF), (bf16*)(ws + WS_QEF), (bf16*)(ws + WS_QKF), (float*)(ws + WS_UF), (float*)(ws + WS_EGL), ws + WS_VBG};
    float* out = p.out;

    if (IN(0)) { p0_prologue(F, p); if (BOTH(0)) GRID_BAR(); }
    if (IN(1)) {
        pg8::Gemm g{H, Win_t, MROWS, PROJ_PAD, DM}; pg8::StaticOrder S; S.init(MROWS, PROJ_PAD, DM, F.G, (int)blockIdx.x);
        pg8::EpiProj E{P, AB, PW};
        pg8::gemm_phase<pg8::EpiProj, pg8::StaticOrder, true, true>(F.lds + RING_OFF, g, S, E);
        if (BOTH(1)) GRID_BAR();
    }
    if (IN(2)) {
        if (p.pad & 1) ph_copy_states(F, P, p.in[2], p.in[3], out);
        if (p.pad & 2) gdn_sample_units(F, F.vcu, F.G, P, AB, p.in[4], p.in[9], p.in[10], p.in[11], p.in[12], p.in[5], out + O_SGDN, MIX);
        if (p.pad & 4) gdn_prep_all(F, P, AB, p.in[9], p.in[10], p.in[11], sb);
        if (BOTH(2)) GRID_BAR();
    }
    if (IN(3)) {
        if (F.G == 256) {
            const int xcd = F.vcu >> 5, r = F.vcu & 31;
            if (r < 16) gdn_scan_unit(F, xcd * 2 + (r >> 3), r & 7, sb, ORAW, out + O_PGDN);
            else { const int aw = xcd * 16 + (r - 16);
                for (int u = aw; u < 256; u += 128) attn_prompt_unit(F, u >> 2, u & 3, P, p.in[6], p.in[8], MIX);
                for (int u = aw; u < 512; u += 128) attn_sample_unit(F, u >> 2, u & 3, P, p.in[2], p.in[3], p.in[6], p.in[8], MIX);
                w_up_convert(F, p, aw, 128); }
        } else {
            for (int su = F.vcu; su < 128; su += F.G) gdn_scan_unit(F, su >> 3, su & 7, sb, ORAW, out + O_PGDN);
            for (int u = F.vcu; u < 256; u += F.G) attn_prompt_unit(F, u >> 2, u & 3, P, p.in[6], p.in[8], MIX);
            for (int u = F.vcu; u < 512; u += F.G) attn_sample_unit(F, u >> 2, u & 3, P, p.in[2], p.in[3], p.in[6], p.in[8], MIX);
            w_up_convert(F, p, F.vcu, F.G);
        }
        if (BOTH(3)) GRID_BAR();
    }
    if (IN(4)) { ph_gated_norm(F, ORAW, P, p.in[12], MIX, 0, TP); if (BOTH(4)) GRID_BAR(); }
    if (IN(5)) {
        pg8::Gemm g{MIX, Wout_t, MROWS, DM, DM}; pg8::SplitTailOrder S; S.init(TP, NSB * NST, DM, DM, F.G, (int)blockIdx.x);
        pg8::EpiBfSlab E{MIXO, DM, SLAB, TP / 256, DM / 64, (size_t)NSB * NST * DM};
        pg8::gemm_phase<pg8::EpiBfSlab, pg8::SplitTailOrder, true, true>(F.lds + RING_OFF, g, S, E);
        if (BOTH(5)) GRID_BAR();
    }
    if (IN(6)) { ph_postmix(F, p, MIXO, SLAB, out, H); if (BOTH(6)) GRID_BAR(); }
    if (IN(7)) {
        pg8::Gemm g{H, Wgu_t, MROWS, NGU, DM}; pg8::StaticOrder S; S.init(MROWS, NGU, DM, F.G, (int)blockIdx.x);
        pg8::EpiSwiGLU E{ACT, FF};
        pg8::gemm_phase<pg8::EpiSwiGLU, pg8::StaticOrder, true, true>(F.lds + RING_OFF, g, S, E);
        { const int n12 = S.nwg % F.G, c = (int)blockIdx.x;
          if (n12 == 0) w_down_convert(F, p, c, F.G); else if (c >= n12) w_down_convert(F, p, c - n12, F.G - n12); }
        if (BOTH(7)) GRID_BAR();
    }
    if (IN(8)) {
        pg8::Gemm g{ACT, Wdn_t, MROWS, DM, FF}; pg8::SplitTailOrder S; S.init(TP, NSB * NST, DM, FF, F.G, (int)blockIdx.x);
        pg8::EpiBfSlab E{FFNO, DM, SLAB, TP / 256, FF / 64, (size_t)NSB * NST * DM};
        pg8::gemm_phase<pg8::EpiBfSlab, pg8::SplitTailOrder, true, true>(F.lds + RING_OFF, g, S, E);
        if (BOTH(8)) GRID_BAR();
    }
    if (IN(9)) ph_final(F, FFNO, SLAB, p.in[17], out);
#undef IN
#undef BOTH
#undef GRID_BAR
}
#ifndef MK_N_LAUNCHES
#define MK_N_LAUNCHES 1
#endif
extern "C" void kernel_launch(void* const* d_in, const int* in_sizes, int n_in, void* d_out, int out_size, void* d_ws, size_t ws_size, hipStream_t stream) {
    static int grid = 0;
    if (grid == 0) {
        if (n_in != 21 || out_size != (int)O_TOTAL || ws_size < WS_END) { fprintf(stderr, "kernel_launch: unexpected shapes (n_in %d, out %d, ws %zu < %zu)\n", n_in, out_size, ws_size, (size_t)WS_END); grid = -1; return; }
        int dev = 0, cus = 0;
        if (hipGetDevice(&dev) != hipSuccess || hipDeviceGetAttribute(&cus, hipDeviceAttributeMultiprocessorCount, dev) != hipSuccess) { grid = -1; return; }
        if (hipFuncSetAttribute((const void*)mega_fwd, hipFuncAttributeMaxDynamicSharedMemorySize, LDS_BYTES) != hipSuccess) { fprintf(stderr, "kernel_launch: hipFuncSetAttribute failed\n"); grid = -1; return; }
        int per_cu = 0; (void)hipOccupancyMaxActiveBlocksPerMultiprocessor(&per_cu, (const void*)mega_fwd, NWAVES * 64, LDS_BYTES); (void)hipGetLastError();
        grid = cus;
    }
    if (grid < 0) return;
    (void)hipMemsetAsync((char*)d_ws + WS_CTL, 0, CTL_ZERO_BYTES, stream);
    Params p{};
    for (int i = 0; i < 21; ++i) p.in[i] = (const float*)d_in[i];
    p.out = (float*)d_out; p.ws = (unsigned char*)d_ws;
#ifdef MK_PLAN
    const int plan[][3] = {MK_PLAN};
#else
    const int plan[][3] = {{0, N_PHASES, 7}};
#endif
    for (int li = 0; li < (int)(sizeof(plan) / sizeof(plan[0])); ++li) { p.ph_lo = plan[li][0]; p.ph_hi = plan[li][1]; p.li = li; p.pad = plan[li][2];
        hipLaunchKernelGGL(mega_fwd, dim3(grid), dim3(NWAVES * 64), LDS_BYTES, stream, p); }
}
```

```cpp
#include <hip/hip_runtime.h>
#include <cstdio>
#include <cstdint>
namespace pg8 {
#define PG8_LAS __attribute__((address_space(3)))
typedef unsigned short bf16_t;
typedef short bf16x8 __attribute__((ext_vector_type(8)));
typedef float f32x4 __attribute__((ext_vector_type(4)));
typedef unsigned u32x4 __attribute__((ext_vector_type(4)));
constexpr int BM = 256, BK = 64, HALF = 128, HTB = HALF * BK * 2  , STAGE_BYTES = 8 * HTB, NXCD = 8, WGM = 8;

__host__ __device__ __forceinline__ int lds_byte(int r, int c) { const int st = (r >> 4) * 2 + (c >> 5), rr = r & 15, cc = c & 31, ob = rr * 64 + cc * 2; return st * 1024 + (ob ^ (((ob >> 9) & 1) << 5)); }
__host__ __device__ __forceinline__ void stage_rc(int b, int& R, int& C) { const int st = b / 1024, sb = b % 1024, swz = sb ^ (((sb >> 9) & 1) << 5); R = (st >> 1) * 16 + swz / 64; C = (st & 1) * 32 + (swz % 64) / 2; }
__host__ __device__ __forceinline__ int perm32(int rho) { const int n = rho >> 4, i = rho & 15; return 8 * (i >> 2) + 4 * n + (i & 3); }

struct Unit { int pm, pn, k0, nk; };
struct Gemm { const bf16_t* A; const bf16_t* Bt; int M, N, K; };

struct StaticOrder {
    int nM, nN, nwg, G, c, ntf;
    __host__ __device__ void init(int M, int N, int K, int G_, int c_) { nM = M / BM; nN = N / BM; nwg = nM * nN; G = G_; c = c_; ntf = K / BK; }
    __host__ __device__ bool next(int i, Unit& u) const {
        const long L = (long)i * G + c; if (L >= nwg) return false;
        int wgid = (int)L; { const int q = nwg / NXCD, r = nwg % NXCD, xcd = wgid % NXCD, off = wgid / NXCD; wgid = (xcd < r ? xcd * (q + 1) : r * (q + 1) + (xcd - r) * q) + off; }
        const int nig = WGM * nN, gid = wgid / nig, fm = gid * WGM, gsz = (nM - fm) < WGM ? (nM - fm) : WGM;
        u.pm = fm + ((wgid % nig) % gsz); u.pn = (wgid % nig) / gsz; u.k0 = 0; u.nk = ntf; return true;
    }
    __device__ __forceinline__ void a_ready(const Unit&) const {}
    __device__ __forceinline__ void done(const Unit&) const {}
};
struct SplitTailOrder {
    StaticOrder base; int mp, ntail_items;
    __host__ __device__ void init(int Mprompt, int Msample, int N, int K, int G_, int c_) { base.init(Mprompt, N, K, G_, c_); mp = Mprompt / BM; ntail_items = (Msample / BM) * (N / BM) * 8; }
    __host__ __device__ bool next(int i, Unit& u) const {
        Unit t; t.pm = 0; t.pn = 0; t.k0 = 0; t.nk = base.ntf; const bool full = base.next(i, t);
        const int nb = (base.nwg - base.c + base.G - 1) / base.G;
        const int item = (i - nb) * base.G + base.c; const bool tail = !full && i >= nb && item < ntail_items;
        const int tt = item >> 3, sp = item & 7, per = (base.ntf / 16) * 2, rem = (base.ntf - 8 * per) / 2;
        u.pm = full ? t.pm : mp + tt / base.nN; u.pn = full ? t.pn : tt % base.nN; u.nk = full ? t.nk : per + (sp < rem ? 2 : 0); u.k0 = full ? 0 : sp * per + 2 * (sp < rem ? sp : rem);
        return full || tail;
    }
    __device__ __forceinline__ void a_ready(const Unit&) const {}
    __device__ __forceinline__ void done(const Unit&) const {}
};
__device__ __forceinline__ unsigned cvt_pk_bf16(float lo, float hi) { unsigned r; asm volatile("v_cvt_pk_bf16_f32 %0, %1, %2" : "=v"(r) : "v"(lo), "v"(hi)); return r; }
typedef float f32x2 __attribute__((ext_vector_type(2)));
__device__ __forceinline__ float silu_f(float x) { return x * __builtin_amdgcn_rcpf(1.0f + __expf(-x)); }
struct EpiProj {
    static constexpr bool PERM = true, AFTER_DRAIN = false;
    bf16_t* P; float* AB; int ldp;
    __device__ __forceinline__ void operator()(const f32x4 (&acc)[2][2][4][2], const Unit& u, int wr, int wc, int fr, int fq) const {
        const int row0 = u.pm * BM + wr * 64 + fr;
        if (u.pn < 44) {
            const int col0 = u.pn * BM + wc * 32 + 8 * fq;
#pragma unroll
            for (int ai = 0; ai < 2; ++ai)
#pragma unroll
                for (int m = 0; m < 4; ++m) { bf16_t* rowp = P + (size_t)(row0 + ai * HALF + m * 16) * ldp + col0;
#pragma unroll
                    for (int bj = 0; bj < 2; ++bj) { const f32x4 v0 = acc[ai][bj][m][0], v1 = acc[ai][bj][m][1];
                        u32x4 w; w.x = cvt_pk_bf16(v0[0], v0[1]); w.y = cvt_pk_bf16(v0[2], v0[3]); w.z = cvt_pk_bf16(v1[0], v1[1]); w.w = cvt_pk_bf16(v1[2], v1[3]);
                        *(u32x4*)(rowp + bj * HALF) = w; } }
        } else if (wc == 0) {
#pragma unroll
            for (int ai = 0; ai < 2; ++ai)
#pragma unroll
                for (int m = 0; m < 4; ++m) { float* rp = AB + (size_t)(row0 + ai * HALF + m * 16) * 32 + 8 * fq;
                    *(f32x4*)(rp) = acc[ai][0][m][0]; *(f32x4*)(rp + 4) = acc[ai][0][m][1]; }
        }
    }
};
struct EpiBfSlab {
    static constexpr bool PERM = true, AFTER_DRAIN = false;
    bf16_t* C; int ldc; bf16_t* slab; int mp, ntf; size_t slab_stride;
    __device__ __forceinline__ void operator()(const f32x4 (&acc)[2][2][4][2], const Unit& u, int wr, int wc, int fr, int fq) const {
        const int col0 = u.pn * BM + wc * 32 + 8 * fq, row0 = u.pm * BM + wr * 64 + fr;
        if (u.nk == ntf) {
#pragma unroll
            for (int ai = 0; ai < 2; ++ai)
#pragma unroll
                for (int m = 0; m < 4; ++m) { bf16_t* rowp = C + (size_t)(row0 + ai * HALF + m * 16) * ldc + col0;
#pragma unroll
                    for (int bj = 0; bj < 2; ++bj) { const f32x4 v0 = acc[ai][bj][m][0], v1 = acc[ai][bj][m][1];
                        u32x4 w; w.x = cvt_pk_bf16(v0[0], v0[1]); w.y = cvt_pk_bf16(v0[2], v0[3]); w.z = cvt_pk_bf16(v1[0], v1[1]); w.w = cvt_pk_bf16(v1[2], v1[3]);
                        *(u32x4*)(rowp + bj * HALF) = w; } }
        } else {
            const int per = (ntf / 16) * 2, rem = (ntf - 8 * per) / 2; const int sp = u.k0 < rem * (per + 2) ? u.k0 / (per + 2) : rem + (u.k0 - rem * (per + 2)) / per;
            bf16_t* Cb = slab + (size_t)sp * slab_stride; const int r0 = row0 - mp * BM;
#pragma unroll
            for (int ai = 0; ai < 2; ++ai)
#pragma unroll
                for (int m = 0; m < 4; ++m) { bf16_t* rowp = Cb + (size_t)(r0 + ai * HALF + m * 16) * ldc + col0;
#pragma unroll
                    for (int bj = 0; bj < 2; ++bj) { const f32x4 v0 = acc[ai][bj][m][0], v1 = acc[ai][bj][m][1];
                        u32x4 w; w.x = cvt_pk_bf16(v0[0], v0[1]); w.y = cvt_pk_bf16(v0[2], v0[3]); w.z = cvt_pk_bf16(v1[0], v1[1]); w.w = cvt_pk_bf16(v1[2], v1[3]);
                        *(u32x4*)(rowp + bj * HALF) = w; } }
        }
    }
};
struct EpiSwiGLU {
    static constexpr bool PERM = true, AFTER_DRAIN = false;
    bf16_t* O; int ldc;
    __device__ __forceinline__ void operator()(const f32x4 (&acc)[2][2][4][2], const Unit& u, int wr, int wc, int fr, int fq) const {
        const int row0 = u.pm * BM + wr * 64 + fr, col0 = u.pn * HALF + wc * 32 + 8 * fq;
#pragma unroll
        for (int ai = 0; ai < 2; ++ai)
#pragma unroll
            for (int m = 0; m < 4; ++m) { bf16_t* rowp = O + (size_t)(row0 + ai * HALF + m * 16) * ldc + col0;
                const f32x4 g0 = acc[ai][0][m][0], g1 = acc[ai][0][m][1], u0 = acc[ai][1][m][0], u1 = acc[ai][1][m][1];
                u32x4 w; w.x = cvt_pk_bf16(silu_f(g0[0]) * u0[0], silu_f(g0[1]) * u0[1]); w.y = cvt_pk_bf16(silu_f(g0[2]) * u0[2], silu_f(g0[3]) * u0[3]);
                w.z = cvt_pk_bf16(silu_f(g1[0]) * u1[0], silu_f(g1[1]) * u1[1]); w.w = cvt_pk_bf16(silu_f(g1[2]) * u1[2], silu_f(g1[3]) * u1[3]);
                *(u32x4*)rowp = w; }
    }
};
template <class Epi, class Sched, bool ALIGN_EPI = false, bool SP2 = false>
__device__ __forceinline__ void gemm_phase(PG8_LAS unsigned char* lds, const Gemm g, const Sched& S, const Epi& E) {
    const int tid = threadIdx.x, wid = __builtin_amdgcn_readfirstlane(tid >> 6), lane = tid & 63, wr = wid >> 2, wc = wid & 3, fr = lane & 15, fq = lane >> 4;
    const int K = g.K;
    unsigned voffA[2], voffB[2];
#pragma unroll
    for (int i = 0; i < 2; ++i) { int R, C; stage_rc(tid * 16 + i * 8192, R, C); const int Rb = Epi::PERM ? ((R & ~31) + perm32(R & 31)) : R;
        voffA[i] = (unsigned)(R * K + C) * 2u; voffB[i] = (unsigned)(Rb * K + C) * 2u; }
    const size_t kstep = (size_t)(BK * 2);
    const size_t hstep = (size_t)HALF * K * 2;
    const size_t tstep = 2 * hstep;
    const unsigned ldsw = (unsigned)wid * 1024u;
    const int aoff = lds_byte(wr * 64 + fr, fq * 8), boff = lds_byte(wc * 32 + fr, fq * 8);
#define PG8_SA(b, h) (((b) * 2 + (h)) * HTB)
#define PG8_SB(b, h) ((4 + (b) * 2 + (h)) * HTB)
#define PG8_STAGE(bufoff, gbase, voff) do { _Pragma("unroll") for (int _i = 0; _i < 2; ++_i) \
        __builtin_amdgcn_global_load_lds((const unsigned*)((const char*)(gbase) + (voff)[_i]), (PG8_LAS unsigned*)(lds + (bufoff) + ldsw + _i * 8192), 16, 0, 0); } while (0)
#define PG8_LDA(dst, b, h) do { _Pragma("unroll") for (int m = 0; m < 4; ++m) _Pragma("unroll") for (int k = 0; k < 2; ++k) dst[m][k] = *(const PG8_LAS bf16x8*)(lds + PG8_SA(b, h) + aoff + m * 2048 + k * 1024); } while (0)
#define PG8_LDB(dst, b, h) do { _Pragma("unroll") for (int n = 0; n < 2; ++n) _Pragma("unroll") for (int k = 0; k < 2; ++k) dst[n][k] = *(const PG8_LAS bf16x8*)(lds + PG8_SB(b, h) + boff + n * 2048 + k * 1024); } while (0)
#define PG8_MMA(ai, bj, At, Bt) do { __builtin_amdgcn_s_setprio(1); _Pragma("unroll") for (int m = 0; m < 4; ++m) _Pragma("unroll") for (int n = 0; n < 2; ++n) _Pragma("unroll") for (int k = 0; k < 2; ++k) \
        acc[ai][bj][m][n] = __builtin_amdgcn_mfma_f32_16x16x32_bf16(Bt[n][k], At[m][k], acc[ai][bj][m][n], 0, 0, 0); __builtin_amdgcn_s_setprio(0); } while (0)
#define PG8_WAIT_V(n) asm volatile("s_waitcnt vmcnt(" #n ")" ::: "memory")
#define PG8_WAIT_L(n) asm volatile("s_waitcnt lgkmcnt(" #n ")" ::: "memory")
#define PG8_BAR __builtin_amdgcn_s_barrier()
#define PG8_SCHED __builtin_amdgcn_sched_barrier(0)
    Unit cur, nxt; int ui = 0;
    if (!S.next(0, cur)) return;
    f32x4 acc[2][2][4][2];
#pragma unroll
    for (int a = 0; a < 2; ++a)
#pragma unroll
        for (int b = 0; b < 2; ++b)
#pragma unroll
            for (int m = 0; m < 4; ++m)
#pragma unroll
                for (int n = 0; n < 2; ++n) acc[a][b][m][n] = (f32x4){0.f, 0.f, 0.f, 0.f};
    bf16x8 At[4][2], B0[2][2], B1[2][2];
    const char* cA = (const char*)g.A + (size_t)cur.pm * tstep + (size_t)cur.k0 * (BK * 2); const char* cB = (const char*)g.Bt + (size_t)cur.pn * tstep + (size_t)cur.k0 * (BK * 2);
    S.a_ready(cur);
    if constexpr (SP2) {
        PG8_STAGE(PG8_SB(0, 0), cB, voffB); PG8_STAGE(PG8_SB(0, 1), cB + hstep, voffB); PG8_STAGE(PG8_SA(0, 0), cA, voffA); PG8_STAGE(PG8_SA(0, 1), cA + hstep, voffA);
        if (wr == 1) PG8_BAR;
        PG8_WAIT_V(2); PG8_BAR;
        PG8_STAGE(PG8_SB(1, 0), cB + kstep, voffB); PG8_STAGE(PG8_SA(1, 0), cA + kstep, voffA); PG8_STAGE(PG8_SB(1, 1), cB + hstep + kstep, voffB);
        PG8_WAIT_V(6); PG8_BAR;
    } else {
        PG8_STAGE(PG8_SB(0, 0), cB, voffB); PG8_STAGE(PG8_SA(0, 0), cA, voffA); PG8_STAGE(PG8_SB(0, 1), cB + hstep, voffB); PG8_STAGE(PG8_SA(0, 1), cA + hstep, voffA);
        if (wr == 1) PG8_BAR;
        PG8_WAIT_V(4); PG8_BAR;
        PG8_STAGE(PG8_SB(1, 0), cB + kstep, voffB); PG8_STAGE(PG8_SA(1, 0), cA + kstep, voffA); PG8_STAGE(PG8_SB(1, 1), cB + hstep + kstep, voffB);
        PG8_WAIT_V(6); PG8_BAR;
    }
    for (;;) {
        const bool has_next = S.next(ui + 1, nxt);
        const char* nA = has_next ? (const char*)g.A + (size_t)nxt.pm * tstep + (size_t)nxt.k0 * (BK * 2) : cA; const char* nB = has_next ? (const char*)g.Bt + (size_t)nxt.pn * tstep + (size_t)nxt.k0 * (BK * 2) : cB;
        const int nt = cur.nk;
        for (int t = 0; t < nt; t += 2) {
            const bool last = (t == nt - 2);
            const char* a1 = cA + (size_t)(t + 1) * kstep;
            const char* a2 = last ? nA : cA + (size_t)(t + 2) * kstep; const char* b2 = last ? nB : cB + (size_t)(t + 2) * kstep;
            const char* a3 = a2 + kstep; const char* b3 = b2 + kstep;
            if (last && has_next) S.a_ready(nxt);
            if constexpr (SP2) {
            PG8_LDB(B0, 0, 0); PG8_LDB(B1, 0, 1); PG8_SCHED; PG8_LDA(At, 0, 0); PG8_STAGE(PG8_SA(1, 1), a1 + hstep, voffA);
            PG8_WAIT_V(8); PG8_WAIT_L(0); PG8_BAR; PG8_MMA(0, 0, At, B0); PG8_MMA(0, 1, At, B1); PG8_BAR; PG8_SCHED;
            PG8_LDA(At, 0, 1); PG8_STAGE(PG8_SB(0, 0), b2, voffB); PG8_STAGE(PG8_SB(0, 1), b2 + hstep, voffB); PG8_STAGE(PG8_SA(0, 0), a2, voffA);
            PG8_WAIT_V(8); PG8_WAIT_L(0); PG8_BAR; PG8_MMA(1, 0, At, B0); PG8_MMA(1, 1, At, B1); PG8_BAR; PG8_SCHED;
            PG8_LDB(B0, 1, 0); PG8_LDB(B1, 1, 1); PG8_SCHED; PG8_LDA(At, 1, 0); PG8_STAGE(PG8_SA(0, 1), a2 + hstep, voffA);
            PG8_WAIT_V(8); PG8_WAIT_L(0); PG8_BAR; PG8_MMA(0, 0, At, B0); PG8_MMA(0, 1, At, B1); PG8_BAR; PG8_SCHED;
            PG8_LDA(At, 1, 1); PG8_STAGE(PG8_SB(1, 0), b3, voffB); PG8_STAGE(PG8_SB(1, 1), b3 + hstep, voffB); PG8_STAGE(PG8_SA(1, 0), a3, voffA);
            PG8_WAIT_V(8); PG8_WAIT_L(0); PG8_BAR; PG8_MMA(1, 0, At, B0); PG8_MMA(1, 1, At, B1); PG8_BAR; PG8_SCHED;
            } else {
            PG8_LDB(B0, 0, 0); PG8_SCHED; PG8_LDA(At, 0, 0); PG8_STAGE(PG8_SA(1, 1), a1 + hstep, voffA);
            PG8_WAIT_L(8); PG8_BAR; PG8_WAIT_L(0); PG8_MMA(0, 0, At, B0); PG8_BAR; PG8_SCHED;
            PG8_LDB(B1, 0, 1); PG8_STAGE(PG8_SB(0, 0), b2, voffB);
            PG8_BAR; PG8_WAIT_L(0); PG8_MMA(0, 1, At, B1); PG8_BAR;
            PG8_LDA(At, 0, 1); PG8_STAGE(PG8_SA(0, 0), a2, voffA);
            PG8_BAR; PG8_WAIT_L(0); PG8_MMA(1, 0, At, B0); PG8_BAR; PG8_SCHED;
            PG8_STAGE(PG8_SB(0, 1), b2 + hstep, voffB);
            PG8_WAIT_V(6); PG8_BAR; PG8_MMA(1, 1, At, B1); PG8_BAR;
            PG8_LDB(B0, 1, 0); PG8_SCHED; PG8_LDA(At, 1, 0); PG8_STAGE(PG8_SA(0, 1), a2 + hstep, voffA);
            PG8_WAIT_L(8); PG8_BAR; PG8_WAIT_L(0); PG8_MMA(0, 0, At, B0); PG8_BAR; PG8_SCHED;
            PG8_LDB(B1, 1, 1); PG8_STAGE(PG8_SB(1, 0), b3, voffB);
            PG8_BAR; PG8_WAIT_L(0); PG8_MMA(0, 1, At, B1); PG8_BAR;
            PG8_LDA(At, 1, 1); PG8_STAGE(PG8_SA(1, 0), a3, voffA);
            PG8_BAR; PG8_WAIT_L(0); PG8_MMA(1, 0, At, B0); PG8_BAR; PG8_SCHED;
            PG8_STAGE(PG8_SB(1, 1), b3 + hstep, voffB);
            PG8_WAIT_V(6); PG8_BAR; PG8_MMA(1, 1, At, B1); PG8_BAR;
            }
        }
        if constexpr (ALIGN_EPI) { if (wr == 0) PG8_BAR; }
        if constexpr (!Epi::AFTER_DRAIN) { E(acc, cur, wr, wc, fr, fq); S.done(cur); }
        if (!has_next) break;
#pragma unroll
        for (int a = 0; a < 2; ++a)
#pragma unroll
            for (int b = 0; b < 2; ++b)
#pragma unroll
                for (int m = 0; m < 4; ++m)
#pragma unroll
                    for (int n = 0; n < 2; ++n) acc[a][b][m][n] = (f32x4){0.f, 0.f, 0.f, 0.f};
        cur = nxt; cA = nA; cB = nB; ++ui;
        if constexpr (ALIGN_EPI) { if (wr == 1) PG8_BAR; }
    }
    PG8_WAIT_V(0);
    if constexpr (!ALIGN_EPI) { if (wr == 0) PG8_BAR; }
    PG8_BAR;
    if constexpr (Epi::AFTER_DRAIN) { E.fused(acc, cur, wr, wc, fr, fq, lds, wid, lane); S.done(cur); }
#undef PG8_SA
#undef PG8_SB
#undef PG8_STAGE
#undef PG8_LDA
#undef PG8_LDB
#undef PG8_MMA
#undef PG8_WAIT_V
#undef PG8_WAIT_L
#undef PG8_BAR
#undef PG8_SCHED
}
}
constexpr int NWAVES = 8;
constexpr int DM = 4096, TP = 8192, NSB = 128, NST = 4, MROWS = TP + NSB * NST;
constexpr int PROJ_W = 11296, PROJ_PAD = 11520, PW = 11264;
constexpr int C_QA = 0, C_KA = 2048, C_VA = 2560, C_QKVG = 3072, C_ZG = 9216;
constexpr int FF = 11008, NGU = 2 * FF;
constexpr float NORM_EPS = 1e-6f;
constexpr size_t O_YP = 0, O_YS = 33554432, O_PWK = 35651584, O_PWV = 35717120, O_PCONV = 35782656, O_PGDN = 35801088,
                 O_SWK = 36063232, O_SWV = 44451840, O_SCONV = 52840448, O_SGDN = 55199744, O_TOTAL = 88754176;
constexpr size_t WS_CTL = 0, CTL_ZERO_BYTES = 1u << 20;
constexpr size_t WS_WIN = CTL_ZERO_BYTES;
constexpr size_t WS_WOUT = WS_WIN + (size_t)PROJ_PAD * DM * 2;
constexpr size_t WS_WGU = WS_WOUT + (size_t)DM * DM * 2;
constexpr size_t WS_WDN = WS_WGU + (size_t)NGU * DM * 2;
constexpr size_t WS_H = WS_WDN + (size_t)DM * FF * 2;
constexpr size_t WS_MIX = WS_H + (size_t)MROWS * DM * 2;
constexpr size_t WS_FFNO = WS_H;
constexpr size_t WS_P = WS_MIX + (size_t)MROWS * DM * 2;
constexpr size_t WS_MIXO = WS_P;
constexpr size_t WS_ACT = WS_P;
constexpr size_t WS_AB = WS_P + (size_t)MROWS * PW * 2;
constexpr size_t WS_QN = WS_AB + (size_t)MROWS * 32 * 4;
constexpr size_t WS_KN = WS_QN + (size_t)NSB * NST * 2048 * 4;
constexpr size_t WS_VN = WS_KN + (size_t)NSB * NST * 2048 * 4;
constexpr size_t WS_GB = WS_VN + (size_t)NSB * NST * 2048 * 4;
constexpr size_t WS_ORAW = WS_GB + (size_t)MROWS * 32 * 4;
constexpr int NUNIT = 16 * 128;
constexpr size_t WS_WF = WS_ORAW + (size_t)MROWS * 2048 * 4;
constexpr size_t WS_KDF = WS_WF + (size_t)NUNIT * 16384;
constexpr size_t WS_QEF = WS_KDF + (size_t)NUNIT * 16384;
constexpr size_t WS_QKF = WS_QEF + (size_t)NUNIT * 16384;
constexpr size_t WS_UF = WS_QKF + (size_t)NUNIT * 8192;
constexpr size_t WS_EGL = WS_UF + (size_t)NUNIT * 32768;
constexpr size_t WS_VBG = WS_EGL + (size_t)NUNIT * 4;
constexpr size_t WS_VNF = WS_VBG + (size_t)NUNIT * 32768;
constexpr size_t WS_END = WS_VNF + (size_t)NUNIT * 16384;
constexpr size_t WS_SNF = WS_ORAW;
static_assert((size_t)MROWS * DM * 4 <= 2 * (size_t)MROWS * DM * 2 && (size_t)MROWS * FF * 2 <= (size_t)MROWS * PW * 2, "overlays");
constexpr int CW_TMO = 0, CW_CODE = 1, CW_BAR = 4096;
constexpr int RING_OFF = 0, RING_BYTES = 139264;
constexpr int LDSCTL_OFF = RING_BYTES, MISC_OFF = LDSCTL_OFF + 320;
constexpr int LDS_BYTES = 147456;
#define GAS __attribute__((address_space(1)))
#define LAS __attribute__((address_space(3)))
typedef unsigned short bf16;
typedef unsigned v4u __attribute__((ext_vector_type(4)));
typedef unsigned v2u __attribute__((ext_vector_type(2)));
typedef float f32x4 __attribute__((ext_vector_type(4)));
typedef short bf16x8 __attribute__((ext_vector_type(8)));
typedef GAS unsigned gu32;
#define RLX_AGENT __ATOMIC_RELAXED, __HIP_MEMORY_SCOPE_AGENT
#define LDS_WAIT() asm volatile("s_waitcnt lgkmcnt(0)" ::: "memory")
#define VM_WAIT() asm volatile("s_waitcnt vmcnt(0)" ::: "memory")
#define LDS_BAR() do { asm volatile("s_waitcnt lgkmcnt(0)" ::: "memory"); __builtin_amdgcn_s_barrier(); asm volatile("" ::: "memory"); } while (0)
__device__ __forceinline__ unsigned f2bf(float f) { unsigned u = __builtin_bit_cast(unsigned, f); return (u + 0x7fffu + ((u >> 16) & 1u)) >> 16; }
__device__ __forceinline__ unsigned pk2(float lo, float hi) { return f2bf(lo) | (f2bf(hi) << 16); }
__device__ __forceinline__ float bf2f(unsigned short b) { return __builtin_bit_cast(float, ((unsigned)b) << 16); }
__device__ __forceinline__ float bflo(unsigned w) { return __builtin_bit_cast(float, w << 16); }
__device__ __forceinline__ float bfhi(unsigned w) { return __builtin_bit_cast(float, w & 0xffff0000u); }
__device__ __forceinline__ float wave_sum(float v) {
#pragma unroll
    for (int o = 1; o < 64; o <<= 1) v += __shfl_xor(v, o);
    return v;
}
__device__ __forceinline__ float wave_max(float v) {
#pragma unroll
    for (int o = 1; o < 64; o <<= 1) v = fmaxf(v, __shfl_xor(v, o));
    return v;
}
__device__ __forceinline__ float sigmoid_f(float x) { return __builtin_amdgcn_rcpf(1.0f + __expf(-x)); }
__device__ __forceinline__ float silu_f(float x) { return x * __builtin_amdgcn_rcpf(1.0f + __expf(-x)); }
__device__ __forceinline__ float softplus_f(float x) { return fmaxf(x, 0.f) + log1pf(__expf(-fabsf(x))); }
template <int CTRL> __device__ __forceinline__ float dpp_mov(float v) { return __builtin_bit_cast(float, __builtin_amdgcn_update_dpp(0, __builtin_bit_cast(int, v), CTRL, 0xf, 0xf, true)); }
__device__ __forceinline__ float sum16(float v) { v += dpp_mov<0xB1>(v); v += dpp_mov<0x4E>(v); v += dpp_mov<0x141>(v); v += dpp_mov<0x140>(v); return v; }
#define XB_TMO      128
#define XB_XCNT(j)  (256  + 64 * (j))
#define XB_XSUB(j)  (1280 + 64 * (j))
#define XB_XGEN(j)  (2304 + 64 * (j))
#define XB_TOP      3328
#define XB_TOPGEN   3392
#define XCD_BAR_WORDS 3456
#define XB_SPIN_CAP (1u << 18)

__device__ __forceinline__ unsigned xb_ld(unsigned* p)              { return __hip_atomic_load(p, __ATOMIC_RELAXED, __HIP_MEMORY_SCOPE_AGENT); }
__device__ __forceinline__ unsigned xb_add(unsigned* p, unsigned v) { return __hip_atomic_fetch_add(p, v, __ATOMIC_RELAXED, __HIP_MEMORY_SCOPE_AGENT); }
__device__ __forceinline__ unsigned xb_xcc_id() { return (unsigned)__builtin_amdgcn_s_getreg((3 << 11) | 20) & 0xFu; }
#define XB_SPIN(cond, bar) do { unsigned _sp = 0; while (cond) { __builtin_amdgcn_s_sleep(1); \
    if ((++_sp & 255u) == 0u) { if (xb_ld(&(bar)[XB_TMO])) break; if (_sp > XB_SPIN_CAP) { atomicAdd(&(bar)[XB_TMO], 1u); break; } } } } while (0)

struct XcdBarrier {
    unsigned* bar; unsigned x;
    volatile LAS unsigned* st;
};

__device__ __forceinline__ XcdBarrier xcd_barrier_post(unsigned* bar, volatile LAS unsigned* st) {
    XcdBarrier b; b.bar = bar; b.x = xb_xcc_id(); b.st = st;
    if (threadIdx.x == 0) (void)xb_add(&bar[XB_XCNT(b.x)], 1u);
    return b;
}
__device__ __forceinline__ void xcd_barrier_complete(unsigned* bar, unsigned x, unsigned& nloc, unsigned& nx) {
    const unsigned G = gridDim.x * gridDim.y * gridDim.z;
    unsigned sum, cnt, mine, sp = 0u;
    for (;;) {
        sum = 0u; cnt = 0u; mine = 0u;
#pragma unroll
        for (unsigned j = 0; j < 16; ++j) { const unsigned c = xb_ld(&bar[XB_XCNT(j)]); sum += c; cnt += (c > 0u) ? 1u : 0u; mine = (j == x) ? c : mine; }
        if (sum == G) break;
        __builtin_amdgcn_s_sleep(1);
        if ((++sp & 255u) == 0u) { if (xb_ld(&bar[XB_TMO])) break; if (sp > XB_SPIN_CAP) { atomicAdd(&bar[XB_TMO], 1u); break; } }
    }
    nloc = mine > 0u ? mine : 1u; nx = cnt > 0u ? cnt : 1u;
}

__device__ __forceinline__ void xcd_barrier(const XcdBarrier& b) {
    asm volatile("s_waitcnt vmcnt(0)" ::: "memory");
    __syncthreads();
    if (threadIdx.x == 0) {
        unsigned* bar = b.bar;
        __builtin_amdgcn_s_waitcnt(0);
        unsigned nloc = b.st[0], nx = b.st[1];
        if (nloc == 0u) { xcd_barrier_complete(bar, b.x, nloc, nx); b.st[0] = nloc; b.st[1] = nx; }
        const unsigned old = xb_add(&bar[XB_XSUB(b.x)], 1u);
        const unsigned gen = old / nloc;
        if (old + 1u == (gen + 1u) * nloc) {
            __builtin_amdgcn_fence(__ATOMIC_RELEASE, "agent");
            asm volatile("s_waitcnt vmcnt(0)" ::: "memory");
            const unsigned og = xb_add(&bar[XB_TOP], 1u);
            const unsigned tg = og / nx;
            if (og + 1u == (tg + 1u) * nx) xb_add(&bar[XB_TOPGEN], 1u);
            else XB_SPIN(xb_ld(&bar[XB_TOPGEN]) == tg, bar);
            __builtin_amdgcn_fence(__ATOMIC_ACQUIRE, "agent");
            xb_add(&bar[XB_XGEN(b.x)], 1u);
            asm volatile("s_waitcnt vmcnt(0)" ::: "memory");
        } else {
            XB_SPIN(xb_ld(&bar[XB_XGEN(b.x)]) == gen, bar);
            __builtin_amdgcn_fence(__ATOMIC_ACQUIRE, "agent");
            asm volatile("s_waitcnt vmcnt(0)" ::: "memory");
        }
    }
    __syncthreads();
}
struct Params {
    const float* in[21]; float* out; unsigned char* ws; int ph_lo, ph_hi, li, pad;
};
struct Frame {
    LAS unsigned char* lds;
    volatile LAS unsigned* MISC;
    gu32* ctl;
    int tid, lane, wave, vcu, G;
};
__device__ __forceinline__ void p0_transpose_item(const float* W, int K, int N, bf16* WT, int k0, int n0, int dst_row0, LAS float* scr, int lane) {
#pragma unroll 8
    for (int i = 0; i < 32; ++i) { const int kk = 2 * i + (lane >> 5); scr[kk * 33 + (lane & 31)] = W[(size_t)(k0 + kk) * N + n0 + (lane & 31)]; }
    LDS_WAIT(); asm volatile("" ::: "memory");
    const int c = lane & 7;
#pragma unroll
    for (int j = 0; j < 4; ++j) { const int n = (lane >> 3) + 8 * j; const LAS float* s = scr + (8 * c) * 33 + n;
        v4u o; o.x = pk2(s[0 * 33], s[1 * 33]); o.y = pk2(s[2 * 33], s[3 * 33]); o.z = pk2(s[4 * 33], s[5 * 33]); o.w = pk2(s[6 * 33], s[7 * 33]);
        *(GAS v4u*)(WT + (size_t)(dst_row0 + n) * K + k0 + 8 * c) = o; }
    LDS_WAIT(); asm volatile("" ::: "memory");
}
__device__ __forceinline__ const float* x_row(const Params& p, int m) { return m < TP ? p.in[0] + (size_t)m * DM : p.in[1] + (size_t)(m - TP) * DM; }
__device__ __forceinline__ void rms_row_to_bf16(const float* xrow, const float* w, bf16* orow, int lane) {
    const GAS f32x4* xr = (const GAS f32x4*)xrow + lane; const GAS f32x4* wr = (const GAS f32x4*)w + lane;
    f32x4 v[16]; float s = 0.f;
#pragma unroll
    for (int j = 0; j < 16; ++j) { v[j] = xr[64 * j]; s += (v[j].x * v[j].x + v[j].y * v[j].y) + (v[j].z * v[j].z + v[j].w * v[j].w); }
    const float r = rsqrtf(wave_sum(s) * (1.f / DM) + NORM_EPS);
    GAS v2u* o8 = (GAS v2u*)orow + lane;
#pragma unroll
    for (int j = 0; j < 16; ++j) { const f32x4 ww = wr[64 * j]; v2u o; o.x = pk2(v[j].x * r * ww.x, v[j].y * r * ww.y); o.y = pk2(v[j].z * r * ww.z, v[j].w * r * ww.w); o8[64 * j] = o; }
}
__device__ __forceinline__ void p0_prologue(Frame& F, const Params& p) {
    LAS float* scr = (LAS float*)(F.lds + RING_OFF + F.wave * 16384);
    const int gw = F.vcu * NWAVES + F.wave, NGW = F.G * NWAVES;
    unsigned char* ws = p.ws;
    bf16* Win_t = (bf16*)(ws + WS_WIN); bf16* Wout_t = (bf16*)(ws + WS_WOUT); bf16* Wgu_t = (bf16*)(ws + WS_WGU);
    constexpr int I_IN = (DM / 64) * (PROJ_W / 32), I_OUT = (DM / 64) * (DM / 32), I_G = (DM / 64) * (FF / 32);
    constexpr int NITEMS = I_IN + I_OUT + I_G;
    for (int it = gw; it < NITEMS; it += NGW) {
        int r = it;
        if (r < I_IN) { const int nb = r % (PROJ_W / 32), kb = r / (PROJ_W / 32); p0_transpose_item(p.in[7], DM, PROJ_W, Win_t, 64 * kb, 32 * nb, 32 * nb, scr, F.lane); continue; } r -= I_IN;
        if (r < I_OUT) { const int nb = r % (DM / 32), kb = r / (DM / 32); p0_transpose_item(p.in[13], DM, DM, Wout_t, 64 * kb, 32 * nb, 32 * nb, scr, F.lane); continue; } r -= I_OUT;
        { const int nb = r % (FF / 32), kb = r / (FF / 32), n0 = 32 * nb; p0_transpose_item(p.in[18], DM, FF, Wgu_t, 64 * kb, n0, 256 * (n0 >> 7) + (n0 & 127), scr, F.lane); }
    }
    { GAS v4u* z = (GAS v4u*)(Win_t + (size_t)PROJ_W * DM); const size_t n16 = (size_t)(PROJ_PAD - PROJ_W) * DM * 2 / 16;
      for (size_t i = (size_t)gw * 64 + F.lane; i < n16; i += (size_t)NGW * 64) z[i] = (v4u){0u, 0u, 0u, 0u}; }
    bf16* H = (bf16*)(ws + WS_H);
    for (int m = gw; m < MROWS; m += NGW) rms_row_to_bf16(x_row(p, m), p.in[14], H + (size_t)m * DM, F.lane);
}
__device__ __forceinline__ void w_down_convert(const Frame& F, const Params& p, int wi, int nw) {
    LAS float* scr = (LAS float*)(F.lds + RING_OFF + F.wave * 16384);
    bf16* Wdn_t = (bf16*)(p.ws + WS_WDN);
    constexpr int I_D = (FF / 64) * (DM / 32);
    for (int r = wi * NWAVES + F.wave; r < I_D; r += nw * NWAVES) { const int nb = r % (DM / 32), kb = r / (DM / 32); p0_transpose_item(p.in[20], FF, DM, Wdn_t, 64 * kb, 32 * nb, 32 * nb, scr, F.lane); }
}
__device__ __forceinline__ void w_up_convert(const Frame& F, const Params& p, int wi, int nw) {
    LAS float* scr = (LAS float*)(F.lds + RING_OFF + F.wave * 16384);
    bf16* Wgu_t = (bf16*)(p.ws + WS_WGU);
    constexpr int I_G = (DM / 64) * (FF / 32);
    for (int r = wi * NWAVES + F.wave; r < I_G; r += nw * NWAVES) { const int nb = r % (FF / 32), kb = r / (FF / 32), n0 = 32 * nb; p0_transpose_item(p.in[19], DM, FF, Wgu_t, 64 * kb, n0, 256 * (n0 >> 7) + 128 + (n0 & 127), scr, F.lane); }
}
__device__ __forceinline__ int rel_bucket_dev(int n) {
    if (n < 16) return n;
    int large = 16 + (int)(logf((float)n * 0.0625f) / 2.0794415416798357f * 16.0f);
    return large < 31 ? large : 31;
}
__device__ __forceinline__ f32x4 bf4_to_f32(v2u w) { return (f32x4){bflo(w.x), bfhi(w.x), bflo(w.y), bfhi(w.y)}; }
__device__ __forceinline__ void ph_copy_states(const Frame& F, const bf16* P, const float* ck, const float* cv, float* out) {
    const int gid = F.vcu * 512 + F.tid, gs = F.G * 512;
    for (int id = gid; id < NSB * 2 * 4 * 128; id += gs) { const int b = id >> 10, kv = (id >> 9) & 1, j = 124 + ((id >> 7) & 3), c4 = id & 127;
        ((f32x4*)(out + (kv ? O_SWV : O_SWK) + ((size_t)b * 128 + j) * 512))[c4] = bf4_to_f32(((const v2u*)(P + (size_t)(TP + 4 * b + (j - 124)) * PW + (kv ? C_VA : C_KA)))[c4]); }
    for (int id = gid; id < 2 * 128 * 128; id += gs) { const int kv = id >> 14, j = (id >> 7) & 127, c4 = id & 127;
        ((f32x4*)(out + (kv ? O_PWV : O_PWK) + (size_t)j * 512))[c4] = bf4_to_f32(((const v2u*)(P + (size_t)(TP - 128 + j) * PW + (kv ? C_VA : C_KA)))[c4]); }
    for (int id = gid; id < 3 * 1536; id += gs) { const int r = id / 1536, c4 = id - r * 1536;
        ((f32x4*)(out + O_PCONV + (size_t)r * 6144))[c4] = bf4_to_f32(((const v2u*)(P + (size_t)(TP - 3 + r) * PW + C_QKVG))[c4]); }
    for (int id = gid; id < NSB * 3 * 1536; id += gs) { const int br = id / 1536, c4 = id - br * 1536, b = br / 3, r = br - 3 * b;
        ((f32x4*)(out + O_SCONV + (size_t)br * 6144))[c4] = bf4_to_f32(((const v2u*)(P + (size_t)(TP + 4 * b + r + 1) * PW + C_QKVG))[c4]); }
}
__device__ __forceinline__ void copy_cache_rows(const Frame& F, const float* ck, const float* cv, float* out, int wi, int nw) {
    for (int id = wi * 512 + F.tid; id < NSB * 2 * 128 * 128; id += nw * 512) { const int b = id >> 15, kv = (id >> 14) & 1, j = (id >> 7) & 127, c4 = id & 127;
        if (j < 124) ((f32x4*)(out + (kv ? O_SWV : O_SWK) + ((size_t)b * 128 + j) * 512))[c4] = ((const f32x4*)((kv ? cv : ck) + ((size_t)b * 128 + j + 4) * 512))[c4]; }
}
__device__ __forceinline__ void ph_gated_norm(const Frame& F, const float* ORAW, const bf16* P, const float* gw, bf16* MIX, int row_lo, int row_hi) {
    const int lane = F.lane;
    const f32x4 g4 = ((const f32x4*)gw)[lane & 31];
    for (int row = row_lo + F.vcu * NWAVES + F.wave; row < row_hi; row += F.G * NWAVES) {
        f32x4 o[8]; v2u z[8];
#pragma unroll
        for (int i = 0; i < 8; ++i) { o[i] = ((const f32x4*)(ORAW + (size_t)row * 2048))[64 * i + lane]; z[i] = ((const v2u*)(P + (size_t)row * PW + C_ZG))[64 * i + lane]; }
#pragma unroll
        for (int i = 0; i < 8; ++i) {
            float ss = (o[i].x * o[i].x + o[i].y * o[i].y) + (o[i].z * o[i].z + o[i].w * o[i].w);
#pragma unroll
            for (int sh = 1; sh < 32; sh <<= 1) ss += __shfl_xor(ss, sh);
            const float r = rsqrtf(ss * (1.f / 128.f) + NORM_EPS); const f32x4 zz = bf4_to_f32(z[i]);
            v2u w; w.x = pk2(o[i].x * r * g4.x * silu_f(zz.x), o[i].y * r * g4.y * silu_f(zz.y)); w.y = pk2(o[i].z * r * g4.z * silu_f(zz.z), o[i].w * r * g4.w * silu_f(zz.w));
            ((v2u*)(MIX + (size_t)row * DM + 2048))[64 * i + lane] = w;
        }
    }
}
__device__ __forceinline__ void row_gemm_out(const bf16* C, const bf16* slab, int row, int lane, f32x4 (&v)[16]) {
    if (row < TP) { const v2u* cr = (const v2u*)(C + (size_t)row * DM) + lane; v2u w[16];
#pragma unroll
        for (int j = 0; j < 16; ++j) w[j] = cr[64 * j];
#pragma unroll
        for (int j = 0; j < 16; ++j) v[j] = bf4_to_f32(w[j]);
    } else { const v2u* s = (const v2u*)(slab + (size_t)(row - TP) * DM) + lane; constexpr size_t st = (size_t)NSB * NST * DM / 4;
#pragma unroll
        for (int j = 0; j < 16; ++j) { const v2u* q = s + 64 * j; v[j] = ((bf4_to_f32(q[0]) + bf4_to_f32(q[st])) + (bf4_to_f32(q[2 * st]) + bf4_to_f32(q[3 * st]))) + ((bf4_to_f32(q[4 * st]) + bf4_to_f32(q[5 * st])) + (bf4_to_f32(q[6 * st]) + bf4_to_f32(q[7 * st]))); }
    }
}
__device__ __forceinline__ void slab_rows_to_lds(const Frame& F, const bf16* slab) {
    LAS f32x4* srow = (LAS f32x4*)(F.lds + RING_OFF); constexpr size_t st = (size_t)NSB * NST * DM / 4;
    for (int idx = F.tid; idx < NWAVES * 1024; idx += NWAVES * 64) { const int w = idx >> 10, c = idx & 1023, sr = w * F.G + F.vcu;
        if (sr < NSB * NST) { const v2u* q = (const v2u*)(slab + (size_t)sr * DM) + c; v2u t[8];
#pragma unroll
            for (int k = 0; k < 8; ++k) t[k] = q[k * st];
            srow[idx] = ((bf4_to_f32(t[0]) + bf4_to_f32(t[1])) + (bf4_to_f32(t[2]) + bf4_to_f32(t[3]))) + ((bf4_to_f32(t[4]) + bf4_to_f32(t[5])) + (bf4_to_f32(t[6]) + bf4_to_f32(t[7]))); } }
    __syncthreads();
}
__device__ __forceinline__ void ph_postmix(const Frame& F, const Params& p, const bf16* MIXO, const bf16* SLAB, float* out, bf16* H) {
    const int lane = F.lane; const f32x4* w_post = (const f32x4*)p.in[15] + lane; const f32x4* w_pre = (const f32x4*)p.in[16] + lane;
    const int NGW = F.G * NWAVES, np = (TP + NGW - 1) / NGW, ns = (NSB * NST + NGW - 1) / NGW;
    const bool lds_rows = ns == 1; if (lds_rows) slab_rows_to_lds(F, SLAB);
    for (int it = 0; it < np + ns; ++it) {
        const int row = it < np ? F.vcu * NWAVES + F.wave + it * NGW : TP + F.wave * F.G + F.vcu + (it - np) * NGW;
        if (it < np ? row >= TP : row >= MROWS) continue;
        const f32x4* xr = (const f32x4*)x_row(p, row) + lane;
        f32x4 v[16], x[16];
#pragma unroll
        for (int j = 0; j < 16; ++j) x[j] = xr[64 * j];
        if (it >= np && lds_rows) {
#pragma unroll
            for (int j = 0; j < 16; ++j) v[j] = ((const LAS f32x4*)(F.lds + RING_OFF))[F.wave * 1024 + lane + 64 * j];
        } else row_gemm_out(MIXO, SLAB, row, lane, v);
        float s = 0.f;
#pragma unroll
        for (int j = 0; j < 16; ++j) s += (v[j].x * v[j].x + v[j].y * v[j].y) + (v[j].z * v[j].z + v[j].w * v[j].w);
        const float r = rsqrtf(wave_sum(s) * (1.f / DM) + NORM_EPS); float s2 = 0.f;
        f32x4* orow = (f32x4*)(out + (size_t)row * DM) + lane;
#pragma unroll
        for (int j = 0; j < 16; ++j) { const f32x4 w = w_post[64 * j];
            v[j].x = x[j].x + v[j].x * r * w.x; v[j].y = x[j].y + v[j].y * r * w.y; v[j].z = x[j].z + v[j].z * r * w.z; v[j].w = x[j].w + v[j].w * r * w.w;
            orow[64 * j] = v[j]; s2 += (v[j].x * v[j].x + v[j].y * v[j].y) + (v[j].z * v[j].z + v[j].w * v[j].w); }
        const float r2 = rsqrtf(wave_sum(s2) * (1.f / DM) + NORM_EPS);
        v2u* hrow = (v2u*)(H + (size_t)row * DM) + lane;
#pragma unroll
        for (int j = 0; j < 16; ++j) { const f32x4 w = w_pre[64 * j]; v2u o; o.x = pk2(v[j].x * r2 * w.x, v[j].y * r2 * w.y); o.y = pk2(v[j].z * r2 * w.z, v[j].w * r2 * w.w); hrow[64 * j] = o; }
    }
}
__device__ __forceinline__ void ph_final(const Frame& F, const bf16* FFNO, const bf16* SLAB, const float* w_post_, float* out) {
    const int lane = F.lane; const f32x4* w_post = (const f32x4*)w_post_ + lane;
    const int NGW = F.G * NWAVES, np = (TP + NGW - 1) / NGW, ns = (NSB * NST + NGW - 1) / NGW;
    const bool lds_rows = ns == 1; if (lds_rows) slab_rows_to_lds(F, SLAB);
    for (int it = 0; it < np + ns; ++it) {
        const int row = it < np ? F.vcu * NWAVES + F.wave + it * NGW : TP + F.wave * F.G + F.vcu + (it - np) * NGW;
        if (it < np ? row >= TP : row >= MROWS) continue;
        f32x4* orow = (f32x4*)(out + (size_t)row * DM) + lane;
        f32x4 v[16], x[16];
#pragma unroll
        for (int j = 0; j < 16; ++j) x[j] = orow[64 * j];
        if (it >= np && lds_rows) {
#pragma unroll
            for (int j = 0; j < 16; ++j) v[j] = ((const LAS f32x4*)(F.lds + RING_OFF))[F.wave * 1024 + lane + 64 * j];
        } else row_gemm_out(FFNO, SLAB, row, lane, v);
        float s = 0.f;
#pragma unroll
        for (int j = 0; j < 16; ++j) s += (v[j].x * v[j].x + v[j].y * v[j].y) + (v[j].z * v[j].z + v[j].w * v[j].w);
        const float r = rsqrtf(wave_sum(s) * (1.f / DM) + NORM_EPS);
#pragma unroll
        for (int j = 0; j < 16; ++j) { const f32x4 w = w_post[64 * j];
            orow[64 * j] = (f32x4){x[j].x + v[j].x * r * w.x, x[j].y + v[j].y * r * w.y, x[j].z + v[j].z * r * w.z, x[j].w + v[j].w * r * w.w}; }
    }
}
__device__ __forceinline__ unsigned off_b(unsigned row, unsigned ch) { return 256u * row + 16u * (ch ^ (((row & 3) << 2) | ((row >> 2) & 3))); }
__device__ __forceinline__ unsigned row_read_addr_16(unsigned lane, unsigned rb, unsigned s) { return off_b((lane & 15) + 16 * rb, 4 * s + (lane >> 4)); }
__device__ __forceinline__ unsigned tr_read_addr_16(unsigned lane, unsigned c, unsigned ks, unsigned t) {
    const unsigned g = lane >> 4, q = (lane & 15) >> 2, p = lane & 3;
    return off_b(32 * ks + 8 * g + 4 * t + q, 2 * c + (p >> 1)) + 8 * (p & 1);
}
typedef short s16x4 __attribute__((ext_vector_type(4)));
__device__ __forceinline__ unsigned lds_addr(const LAS unsigned char* p) { return (unsigned)(__UINTPTR_TYPE__)p; }
__device__ __forceinline__ s16x4 tr_read_wait(unsigned a) { s16x4 r; asm volatile("ds_read_b64_tr_b16 %0, %1\n\ts_waitcnt lgkmcnt(0)" : "=&v"(r) : "v"(a) : "memory"); return r; }
__device__ __forceinline__ bf16x8 tr_frag(unsigned base, unsigned lane, unsigned c, unsigned ks) {
    const s16x4 lo = tr_read_wait(base + tr_read_addr_16(lane, c, ks, 0)), hi = tr_read_wait(base + tr_read_addr_16(lane, c, ks, 1));
    return (bf16x8){lo[0], lo[1], lo[2], lo[3], hi[0], hi[1], hi[2], hi[3]};
}
__device__ __forceinline__ v4u pack8(const float* y) { v4u o; o.x = pk2(y[0], y[1]); o.y = pk2(y[2], y[3]); o.z = pk2(y[4], y[5]); o.w = pk2(y[6], y[7]); return o; }
struct ScanBufs { bf16* wF; bf16* kdF; bf16* qeF; bf16* qkF; float* uF; float* egl; unsigned char* vbg; bf16* snF; bf16* vnF; };
constexpr int PREP_B = 4;
constexpr int PA_SLOT = 17408;
constexpr int PA_IMG = PREP_B * PA_SLOT;
constexpr int PA_MSC = PA_IMG + 65536;
struct PrepIn { v4u xw[11]; f32x4 w0[4], w1[4]; float ga, gb; };
__device__ __forceinline__ void gdn_prep_issue(PrepIn& I, int un, int tid, const bf16* P, const float* AB, const float* conv_w) {
    const int h = un >> 7, n = un & 127, row0 = 64 * n, lane = tid & 63;
    const int part = (tid >> 7) < 3 ? (tid >> 7) : 2, tok0 = ((tid >> 4) & 7) * 8, cl = tid & 15, ch = part * 2048 + h * 128 + cl * 8;
#pragma unroll
    for (int k = 0; k < 11; ++k) { const int r = row0 + tok0 - 3 + k, rc = r < 0 ? 0 : r; I.xw[k] = *(const v4u*)(P + (size_t)rc * PW + C_QKVG + ch); }
#pragma unroll
    for (int i = 0; i < 4; ++i) { const float* wp = conv_w + (size_t)i * 6144 + ch; I.w0[i] = *(const f32x4*)wp; I.w1[i] = *(const f32x4*)(wp + 4); }
    I.ga = AB[(size_t)(row0 + lane) * 32 + h]; I.gb = AB[(size_t)(row0 + lane) * 32 + 16 + h];
}
__device__ __forceinline__ void gdn_prep_a(const Frame& F, int un, int slot, PrepIn& I, int un_next, const bf16* P, const float* AB, const float* conv_w, const float* a_log, const float* dt_bias, const ScanBufs sb) {
    constexpr int KIMG = PA_IMG, QIMG = PA_IMG + 16384, QEIMG = PA_IMG + 32768, KDIMG = PA_IMG + 49152, QKB = QIMG;
    LAS unsigned char* L = F.lds + RING_OFF;
    LAS float* gcs = (LAS float*)(L + PA_MSC); LAS float* bts = gcs + 64; LAS float* Af = (LAS float*)(L + slot * PA_SLOT);
    int zv = 0; asm volatile("" : "+v"(zv));
    const int tid = F.tid + zv, lane = tid & 63, wave = F.wave, quad = lane >> 4, l15 = lane & 15;
    const int h = un >> 7, n = un & 127, row0 = 64 * n;
    const int part = tid >> 7, tok0 = ((tid >> 4) & 7) * 8, cl = tid & 15, ch = part * 2048 + h * 128 + cl * 8;
    v4u xw[11]; f32x4 w0[4], w1[4];
    unsigned char* vbg = sb.vbg + (size_t)un * 32768;
    if (tid < 384) {
#pragma unroll
        for (int k = 0; k < 11; ++k) { const int r = row0 + tok0 - 3 + k; xw[k] = r < 0 ? (v4u){0u, 0u, 0u, 0u} : I.xw[k]; }
#pragma unroll
        for (int i = 0; i < 4; ++i) { w0[i] = I.w0[i]; w1[i] = I.w1[i]; }
    } else if (wave == 6) {
        const float a = I.ga, bb = I.gb;
        float g = -__expf(a_log[h]) * softplus_f(a + dt_bias[h]);
#pragma unroll
        for (int o = 1; o < 64; o <<= 1) { const float t = __shfl_up(g, o); if (lane >= o) g += t; }
        gcs[lane] = g; bts[lane] = sigmoid_f(bb);
    }
    LDS_BAR();
    const float glast = gcs[63];
    if (tid < 384) {
#pragma unroll
        for (int t = 0; t < 8; ++t) {
            const int tok = tok0 + t; float y[8];
#pragma unroll
            for (int e = 0; e < 8; ++e) y[e] = 0.f;
#pragma unroll
            for (int i = 0; i < 4; ++i) { const v4u w = xw[t + i];
                y[0] += bflo(w.x) * w0[i].x; y[1] += bfhi(w.x) * w0[i].y; y[2] += bflo(w.y) * w0[i].z; y[3] += bfhi(w.y) * w0[i].w;
                y[4] += bflo(w.z) * w1[i].x; y[5] += bfhi(w.z) * w1[i].y; y[6] += bflo(w.w) * w1[i].z; y[7] += bfhi(w.w) * w1[i].w; }
            float ss = 0.f;
#pragma unroll
            for (int e = 0; e < 8; ++e) { y[e] = silu_f(y[e]); ss += y[e] * y[e]; }
            const float gc = gcs[tok], be = bts[tok], egc = __expf(gc), ekd = __expf(glast - gc);
            const unsigned o = off_b(tok, cl); float t8[8];
            if (part < 2) {
                ss = sum16(ss);
                const float rn = rsqrtf(ss + NORM_EPS) * (part == 0 ? 0.08838834764831845f : 1.0f);
#pragma unroll
                for (int e = 0; e < 8; ++e) y[e] *= rn;
            }
            if (part == 0) {
                *(LAS v4u*)(L + QIMG + o) = pack8(y);
#pragma unroll
                for (int e = 0; e < 8; ++e) t8[e] = y[e] * egc;
                *(LAS v4u*)(L + QEIMG + o) = pack8(t8);
            } else if (part == 1) {
                *(LAS v4u*)(L + KIMG + o) = pack8(y);
#pragma unroll
                for (int e = 0; e < 8; ++e) t8[e] = y[e] * (be * egc);
                *(v4u*)(vbg + 16384 + o) = pack8(t8);
#pragma unroll
                for (int e = 0; e < 8; ++e) t8[e] = y[e] * ekd;
                *(LAS v4u*)(L + KDIMG + o) = pack8(t8);
            } else {
#pragma unroll
                for (int e = 0; e < 8; ++e) t8[e] = y[e] * be;
                *(v4u*)(vbg + o) = pack8(t8);
            }
        }
    }
    gdn_prep_issue(I, un_next, tid, P, AB, conv_w);
    LDS_BAR();
    f32x4 accj[3];
#pragma unroll
    for (int r = 0; r < 3; ++r) {
        const int job = wave + 8 * r; accj[r] = (f32x4){0.f, 0.f, 0.f, 0.f};
        if (job < 20) {
            const int idx = job < 10 ? job : job - 10, ti = idx >= 6 ? 3 : idx >= 3 ? 2 : idx >= 1 ? 1 : 0, tj = idx - ti * (ti + 1) / 2;
            const int aimg = job < 10 ? KIMG : QIMG;
            bf16x8 fa[4], fb[4];
#pragma unroll
            for (int s = 0; s < 4; ++s) { fa[s] = *(const LAS bf16x8*)(L + aimg + row_read_addr_16(lane, ti, s)); fb[s] = *(const LAS bf16x8*)(L + KIMG + row_read_addr_16(lane, tj, s)); }
            __builtin_amdgcn_sched_barrier(0);
#pragma unroll
            for (int s = 0; s < 4; ++s) accj[r] = __builtin_amdgcn_mfma_f32_16x16x32_bf16(fa[s], fb[s], accj[r], 0, 0, 0);
        }
    }
    LDS_BAR();
#pragma unroll
    for (int r = 0; r < 3; ++r) {
        const int job = wave + 8 * r;
        if (job < 20) {
            const int idx = job < 10 ? job : job - 10, ti = idx >= 6 ? 3 : idx >= 3 ? 2 : idx >= 1 ? 1 : 0, tj = idx - ti * (ti + 1) / 2;
            const int j = 16 * tj + l15; const float gj = gcs[j];
#pragma unroll
            for (int e = 0; e < 4; ++e) { const int i = 16 * ti + 4 * quad + e; const float dec = __expf(fminf(gcs[i] - gj, 0.f));
                if (job < 10) Af[i * 68 + j] = (i > j) ? bts[i] * accj[r][e] * dec : 0.f;
                else ((LAS bf16*)(L + QKB))[i * 72 + j] = (bf16)f2bf(accj[r][e] * dec); }
        }
    }
    LDS_BAR();
    {
        const unsigned base = lds_addr(L);
#pragma unroll 1
        for (int job = wave; job < 40; job += 8) {
            if (job < 16) { const int ti = job >> 2, s = job & 3;
                *(v4u*)(sb.qeF + ((size_t)(un * 16 + job) * 64 + lane) * 8) = *(const LAS v4u*)(L + QEIMG + row_read_addr_16(lane, ti, s)); }
            else if (job < 32) { const int f = job - 16, di = f >> 1, s2 = f & 1;
                const bf16x8 fr = tr_frag(base + KDIMG, lane, di, s2);
                *(bf16x8*)(sb.kdF + ((size_t)(un * 16 + f) * 64 + lane) * 8) = fr; }
            else { const int f = job - 32, ti = f >> 1, s2 = f & 1, i = 16 * ti + l15, j0 = 32 * s2 + 8 * quad;
                v4u w = *(const LAS v4u*)(L + QKB + i * 144 + j0 * 2);
                w.x = (j0 + 0 <= i ? w.x & 0xffffu : 0u) | (j0 + 1 <= i ? w.x & 0xffff0000u : 0u); w.y = (j0 + 2 <= i ? w.y & 0xffffu : 0u) | (j0 + 3 <= i ? w.y & 0xffff0000u : 0u);
                w.z = (j0 + 4 <= i ? w.z & 0xffffu : 0u) | (j0 + 5 <= i ? w.z & 0xffff0000u : 0u); w.w = (j0 + 6 <= i ? w.w & 0xffffu : 0u) | (j0 + 7 <= i ? w.w & 0xffff0000u : 0u);
                *(v4u*)(sb.qkF + ((size_t)(un * 8 + f) * 64 + lane) * 8) = w; }
        }
    }
    if (tid == 0) sb.egl[un] = __expf(glast);
    LDS_BAR();
}
__device__ __forceinline__ void gdn_prep_c(const Frame& F, int un, int slot, const ScanBufs sb) {
    constexpr int VBIMG = PA_IMG, KGIMG = PA_IMG + 16384, WT = PA_IMG + 32768;
    LAS unsigned char* L = F.lds + RING_OFF;
    int zv = 0; asm volatile("" : "+v"(zv));
    const int tid = F.tid + zv, lane = tid & 63, wave = F.wave, quad = lane >> 4, l15 = lane & 15;
    const unsigned char* vbg = sb.vbg + (size_t)un * 32768;
#pragma unroll
    for (int it = 0; it < 4; ++it) { const int o = (tid + 512 * it) * 16; *(LAS v4u*)(L + VBIMG + o) = *(const v4u*)(vbg + o); }
    LDS_BAR();
    {
        const int ti = wave & 3, which = wave >> 2; const unsigned base = lds_addr(L) + (which ? KGIMG : VBIMG);
        bf16x8 ta[2];
#pragma unroll
        for (int s2 = 0; s2 < 2; ++s2) ta[s2] = *(const LAS bf16x8*)(L + slot * PA_SLOT + (16 * ti + l15) * 144 + (32 * s2 + 8 * quad) * 2);
#pragma unroll 2
        for (int ct = 0; ct < 8; ++ct) {
            f32x4 acc = (f32x4){0.f, 0.f, 0.f, 0.f};
            { const unsigned a0 = base + tr_read_addr_16(lane, ct, 0, 0), a1 = base + tr_read_addr_16(lane, ct, 0, 1), a2 = base + tr_read_addr_16(lane, ct, 1, 0), a3 = base + tr_read_addr_16(lane, ct, 1, 1);
              s16x4 t0, t1, t2, t3;
              asm volatile("ds_read_b64_tr_b16 %0, %4\n\tds_read_b64_tr_b16 %1, %5\n\tds_read_b64_tr_b16 %2, %6\n\tds_read_b64_tr_b16 %3, %7\n\ts_waitcnt lgkmcnt(0)"
                           : "=&v"(t0), "=&v"(t1), "=&v"(t2), "=&v"(t3) : "v"(a0), "v"(a1), "v"(a2), "v"(a3) : "memory");
              acc = __builtin_amdgcn_mfma_f32_16x16x32_bf16(ta[0], (bf16x8){t0[0], t0[1], t0[2], t0[3], t1[0], t1[1], t1[2], t1[3]}, acc, 0, 0, 0);
              acc = __builtin_amdgcn_mfma_f32_16x16x32_bf16(ta[1], (bf16x8){t2[0], t2[1], t2[2], t2[3], t3[0], t3[1], t3[2], t3[3]}, acc, 0, 0, 0); }
            if (which == 0) *(f32x4*)(sb.uF + ((size_t)((un * 4 + ti) * 8 + ct) * 64 + lane) * 4) = acc;
            else {
#pragma unroll
                for (int e = 0; e < 4; ++e) ((LAS bf16*)(L + WT))[(16 * ti + 4 * quad + e) * 136 + 16 * ct + l15] = (bf16)f2bf(acc[e]); }
        }
    }
    LDS_BAR();
#pragma unroll
    for (int it = 0; it < 2; ++it) { const int idx = tid + 512 * it, fr = idx >> 6, ln = idx & 63, ti = fr >> 2, s = fr & 3;
        *(v4u*)(sb.wF + ((size_t)(un * 16 + fr) * 64 + ln) * 8) = *(const LAS v4u*)(L + WT + (16 * ti + (ln & 15)) * 272 + (32 * s + 8 * (ln >> 4)) * 2); }
    LDS_BAR();
}
__device__ __forceinline__ void gdn_prep_invert_blocked(const Frame& F, int nslots) {
    LAS unsigned char* L = F.lds + RING_OFF;
    int zv = 0; asm volatile("" : "+v"(zv));
    const int tid = F.tid + zv, lane = tid & 63, wave = F.wave, q = lane >> 4, l15 = lane & 15;
    if (wave < nslots) {
        const LAS float* Af = (const LAS float*)(L + wave * PA_SLOT); LAS float* Tf = (LAS float*)(L + PA_IMG + wave * 16384);
        float t[16];
#pragma unroll
        for (int i = 0; i < 16; ++i) {
            const LAS float* rp = Af + (16 * q + i) * 68 + 16 * q; f32x4 ar[4];
#pragma unroll
            for (int jb = 0; jb < 4; ++jb) if (4 * jb < i) ar[jb] = *(const LAS f32x4*)(rp + 4 * jb);
            float acc = (l15 == i) ? 1.f : 0.f;
#pragma unroll
            for (int j = 0; j < i; ++j) acc -= ar[j >> 2][j & 3] * t[j];
            t[i] = acc;
        }
#pragma unroll
        for (int i = 0; i < 16; ++i) Tf[(16 * q + i) * 64 + 16 * q + l15] = t[i];
    }
    LDS_BAR();
#pragma unroll
    for (int d = 1; d < 4; ++d) {
        const int per = 4 - d, total = nslots * per;
#pragma unroll 1
        for (int job = wave; job < total; job += NWAVES) {
            const int slot = job / per, b = job - slot * per, a = b + d;
            const LAS float* Af = (const LAS float*)(L + slot * PA_SLOT); LAS float* Tf = (LAS float*)(L + PA_IMG + slot * 16384);
            f32x4 acc = (f32x4){0.f, 0.f, 0.f, 0.f};
            float ta[4];
#pragma unroll
            for (int s4 = 0; s4 < 4; ++s4) ta[s4] = Tf[(16 * a + l15) * 64 + 16 * a + 4 * q + s4];
#pragma unroll
            for (int cc = 0; cc < 3; ++cc) if (cc < d) {
                const int c = b + cc; float la[4], tb[4];
#pragma unroll
                for (int s4 = 0; s4 < 4; ++s4) { la[s4] = Af[(16 * a + l15) * 68 + 16 * c + 4 * s4 + q]; tb[s4] = Tf[(16 * c + 4 * s4 + q) * 64 + 16 * b + l15]; }
                __builtin_amdgcn_sched_barrier(0);
#pragma unroll
                for (int s4 = 0; s4 < 4; ++s4) acc = __builtin_amdgcn_mfma_f32_16x16x4f32(la[s4], tb[s4], acc, 0, 0, 0); }
            f32x4 res = (f32x4){0.f, 0.f, 0.f, 0.f};
#pragma unroll
            for (int s4 = 0; s4 < 4; ++s4) res = __builtin_amdgcn_mfma_f32_16x16x4f32(-ta[s4], acc[s4], res, 0, 0, 0);
#pragma unroll
            for (int r = 0; r < 4; ++r) Tf[(16 * a + 4 * q + r) * 64 + 16 * b + l15] = res[r];
        }
        LDS_BAR();
    }
    for (int idx = tid; idx < nslots * 4096; idx += NWAVES * 64) { const int slot = idx >> 12, e = idx & 4095, i = e >> 6, c = e & 63;
        const float v = ((c >> 4) <= (i >> 4)) ? ((const LAS float*)(L + PA_IMG + slot * 16384))[e] : 0.f;
        ((LAS bf16*)(L + slot * PA_SLOT))[i * 72 + c] = (bf16)f2bf(v); }
    VM_WAIT();
    LDS_BAR();
}
__device__ __forceinline__ void gdn_prep_all(const Frame& F, const bf16* P, const float* AB, const float* conv_w, const float* a_log, const float* dt_bias, const ScanBufs sb) {
    PrepIn I{};
    if (F.vcu < NUNIT) gdn_prep_issue(I, F.vcu, F.tid, P, AB, conv_w);
#pragma unroll 1
    for (int u0 = F.vcu; u0 < NUNIT; u0 += F.G * PREP_B) {
#pragma unroll 1
        for (int s = 0; s < PREP_B; ++s) { const int un = u0 + s * F.G; const int nx = un + F.G < NUNIT ? un + F.G : un;
            if (un < NUNIT) gdn_prep_a(F, un, s, I, nx, P, AB, conv_w, a_log, dt_bias, sb); }
        { int ns = 0;
#pragma unroll
          for (int k = 0; k < PREP_B; ++k) ns += (u0 + k * F.G < NUNIT) ? 1 : 0;
          gdn_prep_invert_blocked(F, ns); }
#pragma unroll 1
        for (int s = 0; s < PREP_B; ++s) { const int un = u0 + s * F.G; if (un < NUNIT) gdn_prep_c(F, un, s, sb); }
    }
}
constexpr int SCAN_D = 4;
__device__ __forceinline__ void gdn_scan_unit(const Frame& F, int h, int sl, const ScanBufs sb, float* Sout) {
    constexpr int SB_PITCH = 272, VN_PITCH = 144, SB_OFF = 0, VN_OFF = 16 * SB_PITCH;
    LAS unsigned char* L = F.lds + RING_OFF;
    const int lane = F.lane, wave = F.wave, quad = lane >> 4, l15 = lane & 15;
    for (int i = F.tid; i < (16 * SB_PITCH) / 4; i += NWAVES * 64) ((LAS unsigned*)(L + SB_OFF))[i] = 0u;
    __syncthreads();
    const LAS unsigned char* sfp = L + SB_OFF + l15 * SB_PITCH + quad * 16;
    const LAS unsigned char* vfp = L + VN_OFF + l15 * VN_PITCH + quad * 16;
    if (wave < 4) {
        const int ti = wave;
        f32x4 S0 = (f32x4){0.f, 0.f, 0.f, 0.f}, S1 = S0;
        bf16x8 wf[SCAN_D][4], kdf[SCAN_D][2][2]; f32x4 uf[SCAN_D]; float gl[SCAN_D];
#define LOAD_C(un_, W, KD, U, G) do { \
        _Pragma("unroll") for (int s = 0; s < 4; ++s) W[s] = *(const bf16x8*)(sb.wF + ((size_t)((un_) * 16 + ti * 4 + s) * 64 + lane) * 8); \
        _Pragma("unroll") for (int d = 0; d < 2; ++d) _Pragma("unroll") for (int s2 = 0; s2 < 2; ++s2) KD[d][s2] = *(const bf16x8*)(sb.kdF + ((size_t)((un_) * 16 + (2 * ti + d) * 2 + s2) * 64 + lane) * 8); \
        U = *(const f32x4*)(sb.uF + ((size_t)(((un_) * 4 + ti) * 8 + sl) * 64 + lane) * 4); G = sb.egl[un_]; } while (0)
#pragma unroll
        for (int k = 0; k < SCAN_D; ++k) LOAD_C(h * 128 + k, wf[k], kdf[k], uf[k], gl[k]);
#pragma unroll 1
        for (int n0 = 0; n0 < 128; n0 += SCAN_D) {
#pragma unroll
            for (int k = 0; k < SCAN_D; ++k) {
                bf16x8 sf[4];
#pragma unroll
                for (int s = 0; s < 4; ++s) sf[s] = *(const LAS bf16x8*)(sfp + s * 64);
                __builtin_amdgcn_sched_barrier(0);
                f32x4 acc = __builtin_amdgcn_mfma_f32_16x16x32_bf16(wf[k][0], sf[0], (f32x4){0.f, 0.f, 0.f, 0.f}, 0, 0, 0), acc2 = __builtin_amdgcn_mfma_f32_16x16x32_bf16(wf[k][1], sf[1], (f32x4){0.f, 0.f, 0.f, 0.f}, 0, 0, 0);
                acc = __builtin_amdgcn_mfma_f32_16x16x32_bf16(wf[k][2], sf[2], acc, 0, 0, 0); acc2 = __builtin_amdgcn_mfma_f32_16x16x32_bf16(wf[k][3], sf[3], acc2, 0, 0, 0);
                const f32x4 vn = uf[k] - (acc + acc2);
                { v2u w; w.x = pk2(vn[0], vn[1]); w.y = pk2(vn[2], vn[3]); *(LAS v2u*)(L + VN_OFF + l15 * VN_PITCH + (16 * ti + 4 * quad) * 2) = w; }
                LDS_BAR();
                S0 = S0 * gl[k]; S1 = S1 * gl[k];
                { const bf16x8 vf0 = *(const LAS bf16x8*)(vfp), vf1 = *(const LAS bf16x8*)(vfp + 64);
                  __builtin_amdgcn_sched_barrier(0);
                  S0 = __builtin_amdgcn_mfma_f32_16x16x32_bf16(kdf[k][0][0], vf0, S0, 0, 0, 0); S1 = __builtin_amdgcn_mfma_f32_16x16x32_bf16(kdf[k][1][0], vf0, S1, 0, 0, 0);
                  S0 = __builtin_amdgcn_mfma_f32_16x16x32_bf16(kdf[k][0][1], vf1, S0, 0, 0, 0); S1 = __builtin_amdgcn_mfma_f32_16x16x32_bf16(kdf[k][1][1], vf1, S1, 0, 0, 0); }
                { v2u w; w.x = pk2(S0[0], S0[1]); w.y = pk2(S0[2], S0[3]); *(LAS v2u*)(L + SB_OFF + l15 * SB_PITCH + (16 * (2 * ti) + 4 * quad) * 2) = w;
                  w.x = pk2(S1[0], S1[1]); w.y = pk2(S1[2], S1[3]); *(LAS v2u*)(L + SB_OFF + l15 * SB_PITCH + (16 * (2 * ti + 1) + 4 * quad) * 2) = w; }
                { const int nn = n0 + k + SCAN_D < 128 ? n0 + k + SCAN_D : 127; LOAD_C(h * 128 + nn, wf[k], kdf[k], uf[k], gl[k]); }
                LDS_BAR();
            }
        }
#undef LOAD_C
#pragma unroll
        for (int e = 0; e < 4; ++e) { Sout[((size_t)h * 128 + 16 * (2 * ti) + 4 * quad + e) * 128 + 16 * sl + l15] = S0[e]; Sout[((size_t)h * 128 + 16 * (2 * ti + 1) + 4 * quad + e) * 128 + 16 * sl + l15] = S1[e]; }
    } else {
        bf16* snp = sb.snF + ((size_t)(h * 128) * 8 + sl) * 2048 + lane * 8;
        bf16* vnp = sb.vnF + ((size_t)(h * 128) * 8 + sl) * 1024 + lane * 8;
#pragma unroll 1
        for (int n = 0; n < 128; ++n) {
            if (wave == 4) {
                bf16x8 sf[4];
#pragma unroll
                for (int s = 0; s < 4; ++s) sf[s] = *(const LAS bf16x8*)(sfp + s * 64);
#pragma unroll
                for (int s = 0; s < 4; ++s) *(bf16x8*)(snp + (size_t)n * 8 * 2048 + s * 512) = sf[s];
            }
            LDS_BAR();
            if (wave == 5) {
                const bf16x8 vf0 = *(const LAS bf16x8*)(vfp), vf1 = *(const LAS bf16x8*)(vfp + 64);
                *(bf16x8*)(vnp + (size_t)n * 8 * 1024) = vf0; *(bf16x8*)(vnp + (size_t)n * 8 * 1024 + 512) = vf1;
            }
            LDS_BAR();
        }
    }
    __syncthreads();
}
struct OIn { bf16x8 snf[4], vnf[2]; v4u qe[2], qk, z[2]; };
__device__ __forceinline__ void opass_load(OIn& I, int un, int tid, int lane, int sl, const ScanBufs sb, const bf16* P) {
    const int h = un >> 7, n = un & 127;
#pragma unroll
    for (int s = 0; s < 4; ++s) I.snf[s] = *(const bf16x8*)(sb.snF + ((size_t)(un * 8 + sl) * 4 + s) * 512 + lane * 8);
#pragma unroll
    for (int s2 = 0; s2 < 2; ++s2) I.vnf[s2] = *(const bf16x8*)(sb.vnF + ((size_t)(un * 8 + sl) * 2 + s2) * 512 + lane * 8);
#pragma unroll
    for (int it = 0; it < 2; ++it) { const int idx = tid + 512 * it, tok = idx >> 4, c = idx & 15;
        I.qe[it] = *(const v4u*)(sb.qeF + (size_t)un * 8192 + idx * 8);
        I.z[it] = *(const v4u*)(P + (size_t)(64 * n + tok) * PW + C_ZG + h * 128 + c * 8); }
    I.qk = *(const v4u*)(sb.qkF + (size_t)un * 4096 + tid * 8);
}
__device__ __forceinline__ void gdn_opass_units(const Frame& F, int u0, int ustride, const ScanBufs sb, const bf16* P, const float* gnw, bf16* MIX) {
    constexpr int QE_OFF = 0, QK_OFF = 16384, Z_OFF = 24576, SS_OFF = 40960, Y_OFF = 43264, Y_PITCH = 272;
    LAS unsigned char* L = F.lds + RING_OFF;
    const int tid = F.tid, lane = F.lane, sl = F.wave, quad = lane >> 4, l15 = lane & 15;
    const float gw = gnw[16 * sl + l15];
    LAS float* ssq = (LAS float*)(L + SS_OFF);
    OIn C{}, N{}, N2{};
    if (u0 < NUNIT) { opass_load(C, u0, tid, lane, sl, sb, P); opass_load(N, u0 + ustride < NUNIT ? u0 + ustride : u0, tid, lane, sl, sb, P); }
#pragma unroll 1
    for (int un = u0; un < NUNIT; un += ustride) {
        const int h = un >> 7, n = un & 127, nx = un + 2 * ustride < NUNIT ? un + 2 * ustride : un;
#pragma unroll
        for (int it = 0; it < 2; ++it) { const int idx = tid + 512 * it, tok = idx >> 4, c = idx & 15;
            *(LAS v4u*)(L + QE_OFF + idx * 16) = C.qe[it]; *(LAS v4u*)(L + Z_OFF + tok * 256 + c * 16) = C.z[it]; }
        *(LAS v4u*)(L + QK_OFF + tid * 16) = C.qk;
        LDS_BAR();
        opass_load(N2, nx, tid, lane, sl, sb, P);
        f32x4 acc[4];
#pragma unroll
        for (int ti = 0; ti < 4; ++ti) {
            bf16x8 a[6];
#pragma unroll
            for (int s = 0; s < 4; ++s) a[s] = *(const LAS bf16x8*)(L + QE_OFF + ((ti * 4 + s) * 64 + lane) * 16);
#pragma unroll
            for (int s2 = 0; s2 < 2; ++s2) a[4 + s2] = *(const LAS bf16x8*)(L + QK_OFF + ((ti * 2 + s2) * 64 + lane) * 16);
            __builtin_amdgcn_sched_barrier(0);
            f32x4 x = __builtin_amdgcn_mfma_f32_16x16x32_bf16(a[0], C.snf[0], (f32x4){0.f, 0.f, 0.f, 0.f}, 0, 0, 0), y = __builtin_amdgcn_mfma_f32_16x16x32_bf16(a[1], C.snf[1], (f32x4){0.f, 0.f, 0.f, 0.f}, 0, 0, 0);
            x = __builtin_amdgcn_mfma_f32_16x16x32_bf16(a[2], C.snf[2], x, 0, 0, 0); y = __builtin_amdgcn_mfma_f32_16x16x32_bf16(a[3], C.snf[3], y, 0, 0, 0);
            x = __builtin_amdgcn_mfma_f32_16x16x32_bf16(a[4], C.vnf[0], x, 0, 0, 0); y = __builtin_amdgcn_mfma_f32_16x16x32_bf16(a[5], C.vnf[1], y, 0, 0, 0);
            acc[ti] = x + y;
        }
#pragma unroll
        for (int ti = 0; ti < 4; ++ti)
#pragma unroll
            for (int r = 0; r < 4; ++r) { const float v = sum16(acc[ti][r] * acc[ti][r]); if (l15 == 0) ssq[(16 * ti + 4 * quad + r) * 8 + sl] = v; }
        LDS_BAR();
        if (tid < 64) {
            const f32x4 p0 = *(const LAS f32x4*)(ssq + tid * 8), p1 = *(const LAS f32x4*)(ssq + tid * 8 + 4);
            ssq[512 + tid] = rsqrtf((((p0.x + p0.y) + (p0.z + p0.w)) + ((p1.x + p1.y) + (p1.z + p1.w))) * (1.f / 128.f) + NORM_EPS); }
        LDS_BAR();
#pragma unroll
        for (int ti = 0; ti < 4; ++ti)
#pragma unroll
            for (int r = 0; r < 4; ++r) { const int tok = 16 * ti + 4 * quad + r;
                const float rs = ssq[512 + tok];
                const float z = bf2f(*(const LAS bf16*)(L + Z_OFF + tok * 256 + (16 * sl + l15) * 2));
                const float yv = acc[ti][r] * rs * gw * silu_f(z);
                *(LAS bf16*)(L + Y_OFF + tok * Y_PITCH + (16 * sl + l15) * 2) = (bf16)pg8::cvt_pk_bf16(yv, yv); }
        LDS_BAR();
#pragma unroll
        for (int it = 0; it < 2; ++it) { const int idx = tid + 512 * it, tok = idx >> 4, c = idx & 15;
            *(v4u*)(MIX + (size_t)(64 * n + tok) * DM + 2048 + h * 128 + c * 8) = *(const LAS v4u*)(L + Y_OFF + tok * Y_PITCH + c * 16); }
        LDS_BAR();
        C = N; N = N2;
    }
}
struct SampIn { f32x4 S[8]; float in[11]; float z0, z1; };
__device__ __forceinline__ void samp_load(SampIn& I, int u, int tid, int lane, int wave, const bf16* P, const float* AB, const float* state_conv, const float* conv_w, const float* a_log, const float* dt_bias, const float* S0p) {
    const int b = u >> 4, h = u & 15, rg = tid >> 5, jv = tid & 31;
#pragma unroll
    for (int i = 0; i < 8; ++i) I.S[i] = *(const f32x4*)(S0p + ((size_t)u * 128 + 8 * rg + i) * 128 + 4 * jv);
    const bool cv = tid < 384, gt = !cv && tid < 388;
    const int part = cv ? tid >> 7 : 0, ch = tid & 127, c = part * 2048 + h * 128 + ch;
    const size_t grow = (size_t)TP + 4 * b + (gt ? tid - 384 : 0);
    const float* f[7];
#pragma unroll
    for (int r = 0; r < 3; ++r) f[r] = state_conv + ((size_t)b * 3 + r) * 6144 + c;
#pragma unroll
    for (int i = 0; i < 4; ++i) f[3 + i] = conv_w + (size_t)i * 6144 + c;
    if (gt) { f[0] = AB + grow * 32 + h; f[1] = AB + grow * 32 + 16 + h; f[2] = a_log + h; f[3] = dt_bias + h; }
    I.in[0] = *f[0]; I.in[1] = *f[1]; I.in[2] = *f[2];
#pragma unroll
    for (int t = 0; t < 4; ++t) I.in[3 + t] = bf2f(P[(size_t)(TP + 4 * b + t) * PW + C_QKVG + c]);
    I.in[7] = *f[3]; I.in[8] = *f[4]; I.in[9] = *f[5]; I.in[10] = *f[6];
    const size_t zrow = (size_t)TP + 4 * b + (wave & 3); I.z0 = bf2f(P[zrow * PW + C_ZG + h * 128 + lane]); I.z1 = bf2f(P[zrow * PW + C_ZG + h * 128 + lane + 64]);
}
__device__ __forceinline__ void gdn_sample_units(const Frame& F, int u0, int ustride, const bf16* P, const float* AB, const float* state_conv, const float* conv_w, const float* a_log, const float* dt_bias,
                                                 const float* gnw, const float* S0p, float* Sout, bf16* MIX) {
    LAS float* xs = (LAS float*)(F.lds + RING_OFF);
    LAS float* gs = xs + 1536; LAS float* bs = gs + 4;
    LAS float* red = xs + 2048;
    LAS float* opart = red + 2048;
    const int tid = F.tid, lane = F.lane, wave = F.wave, rg = tid >> 5, jv = tid & 31;
    const float gn0 = gnw[lane], gn1 = gnw[lane + 64];
    SampIn C{}, N{};
    if (u0 < NSB * 16) samp_load(C, u0, tid, lane, wave, P, AB, state_conv, conv_w, a_log, dt_bias, S0p);
#pragma unroll 1
    for (int u = u0; u < NSB * 16; u += ustride) {
        const int b = u >> 4, h = u & 15, un = u + ustride < NSB * 16 ? u + ustride : u;
        if (tid < 384) {
            const int part = tid >> 7, ch = tid & 127;
#pragma unroll
            for (int t = 0; t < 4; ++t) xs[(part * 4 + t) * 128 + ch] = silu_f(C.in[t] * C.in[7] + C.in[t + 1] * C.in[8] + C.in[t + 2] * C.in[9] + C.in[t + 3] * C.in[10]);
        } else if (tid < 388) {
            const int t = tid - 384;
            gs[t] = __expf(-__expf(C.in[2]) * softplus_f(C.in[0] + C.in[7])); bs[t] = sigmoid_f(C.in[1]);
        }
        LDS_BAR();
        samp_load(N, un, tid, lane, wave, P, AB, state_conv, conv_w, a_log, dt_bias, S0p);
        { const int part = wave >> 2, t = wave & 3; LAS float* xv = xs + (part * 4 + t) * 128;
          const float v0 = xv[lane], v1 = xv[lane + 64];
          const float r = rsqrtf(wave_sum(v0 * v0 + v1 * v1) + NORM_EPS) * (part == 0 ? 0.08838834764831845f : 1.0f);
          xv[lane] = v0 * r; xv[lane + 64] = v1 * r; }
        LDS_BAR();
#pragma unroll
        for (int t = 0; t < 4; ++t) {
            const float a = gs[t], be = bs[t];
            const f32x4 k0 = *(const LAS f32x4*)(xs + (4 + t) * 128 + 8 * rg), k1 = *(const LAS f32x4*)(xs + (4 + t) * 128 + 8 * rg + 4);
            const f32x4 q0 = *(const LAS f32x4*)(xs + t * 128 + 8 * rg), q1 = *(const LAS f32x4*)(xs + t * 128 + 8 * rg + 4);
            const f32x4 v4 = *(const LAS f32x4*)(xs + (8 + t) * 128 + 4 * jv);
            f32x4 r4 = ((C.S[0] * k0.x + C.S[1] * k0.y) + (C.S[2] * k0.z + C.S[3] * k0.w)) + ((C.S[4] * k1.x + C.S[5] * k1.y) + (C.S[6] * k1.z + C.S[7] * k1.w));
            r4.x += __shfl_xor(r4.x, 32); r4.y += __shfl_xor(r4.y, 32); r4.z += __shfl_xor(r4.z, 32); r4.w += __shfl_xor(r4.w, 32);
            LAS f32x4* rb = (LAS f32x4*)(red + (t & 1) * 1024);
            if (lane < 32) rb[wave * 32 + jv] = r4;
            LDS_BAR();
            f32x4 rs = (rb[jv] + rb[32 + jv]) + (rb[64 + jv] + rb[96 + jv]); rs = rs + ((rb[128 + jv] + rb[160 + jv]) + (rb[192 + jv] + rb[224 + jv]));
            const f32x4 cvv = (v4 - rs * a) * be;
            const float kk[8] = {k0.x, k0.y, k0.z, k0.w, k1.x, k1.y, k1.z, k1.w}, qq[8] = {q0.x, q0.y, q0.z, q0.w, q1.x, q1.y, q1.z, q1.w};
            f32x4 o4 = (f32x4){0.f, 0.f, 0.f, 0.f};
#pragma unroll
            for (int i = 0; i < 8; ++i) { C.S[i] = C.S[i] * a + cvv * kk[i]; o4 = o4 + C.S[i] * qq[i]; }
            o4.x += __shfl_xor(o4.x, 32); o4.y += __shfl_xor(o4.y, 32); o4.z += __shfl_xor(o4.z, 32); o4.w += __shfl_xor(o4.w, 32);
            if (lane < 32) ((LAS f32x4*)(opart + (t * 8 + wave) * 128))[jv] = o4;
        }
#pragma unroll
        for (int i = 0; i < 8; ++i) *(f32x4*)(Sout + ((size_t)u * 128 + 8 * rg + i) * 128 + 4 * jv) = C.S[i];
        LDS_BAR();
        if (wave < 4) { const int t = wave; const size_t row = (size_t)TP + 4 * b + t;
            float o0 = 0.f, o1 = 0.f;
#pragma unroll
            for (int w = 0; w < 8; ++w) { o0 += opart[(t * 8 + w) * 128 + lane]; o1 += opart[(t * 8 + w) * 128 + lane + 64]; }
            const float r = rsqrtf(wave_sum(o0 * o0 + o1 * o1) * (1.f / 128.f) + NORM_EPS);
            MIX[row * DM + 2048 + h * 128 + lane] = (bf16)f2bf(o0 * r * gn0 * silu_f(C.z0));
            MIX[row * DM + 2048 + h * 128 + lane + 64] = (bf16)f2bf(o1 * r * gn1 * silu_f(C.z1)); }
        LDS_BAR();
        C = N;
    }
}
constexpr int ATT_KIMG = 0, ATT_VIMG = 69632, ATT_IMG_ROWS = 272;
constexpr int ATT_BTAB_OFF = MISC_OFF + 128;
__device__ __forceinline__ void attn_load_q(bf16x8 (&qf)[4], const bf16* qptr, int lane) {
#pragma unroll
    for (int s = 0; s < 4; ++s) qf[s] = *(const bf16x8*)(qptr + 32 * s + 8 * (lane >> 4));
}
__device__ __forceinline__ void attn_tile(LAS unsigned char* L, const LAS float* btab, const bf16x8 (&qf)[4], int kt0, int dist0, int jlo, int jhi, float sink, int g, bf16* optr, int lane) {
    const int quad = lane >> 4, l15 = lane & 15;
    f32x4 sc[9];
    bf16x8 kf[2][4];
#pragma unroll
    for (int s = 0; s < 4; ++s) kf[0][s] = *(const LAS bf16x8*)(L + ATT_KIMG + row_read_addr_16(lane, kt0, s));
#pragma unroll
    for (int i = 0; i < 9; ++i) {
        if (i + 1 < 9) {
#pragma unroll
            for (int s = 0; s < 4; ++s) kf[(i + 1) & 1][s] = *(const LAS bf16x8*)(L + ATT_KIMG + row_read_addr_16(lane, kt0 + i + 1, s)); }
        __builtin_amdgcn_sched_barrier(0);
        f32x4 a0 = __builtin_amdgcn_mfma_f32_16x16x32_bf16(kf[i & 1][0], qf[0], (f32x4){0.f, 0.f, 0.f, 0.f}, 0, 0, 0), a1 = __builtin_amdgcn_mfma_f32_16x16x32_bf16(kf[i & 1][1], qf[1], (f32x4){0.f, 0.f, 0.f, 0.f}, 0, 0, 0);
        a0 = __builtin_amdgcn_mfma_f32_16x16x32_bf16(kf[i & 1][2], qf[2], a0, 0, 0, 0); a1 = __builtin_amdgcn_mfma_f32_16x16x32_bf16(kf[i & 1][3], qf[3], a1, 0, 0, 0);
        sc[i] = a0 + a1;
        __builtin_amdgcn_sched_barrier(0);
    }
    float m = sink;
    const bool interior_free = (jlo <= 16 * (kt0 + 1)) && (jhi >= 16 * (kt0 + 8));
#pragma unroll
    for (int i = 0; i < 9; ++i) {
        if (i >= 1 && i <= 7 && interior_free) {
#pragma unroll
            for (int r = 0; r < 4; ++r) { const float v = sc[i][r] * 0.08838834764831845f + btab[g * 132 + dist0 - 16 * i - r]; sc[i][r] = v; m = fmaxf(m, v); }
        } else {
#pragma unroll
            for (int r = 0; r < 4; ++r) { const int dist = dist0 - 16 * i - r, j = 16 * (kt0 + i) + 4 * quad + r; const bool ok = dist >= 0 && dist <= 128 && j >= jlo && j < jhi;
                const float b = btab[g * 132 + (ok ? dist : 0)]; const float v = ok ? sc[i][r] * 0.08838834764831845f + b : -3.0e38f; sc[i][r] = v; m = fmaxf(m, v); }
        }
    }
    m = fmaxf(m, __shfl_xor(m, 16)); m = fmaxf(m, __shfl_xor(m, 32));
    float sum = 0.f;
#pragma unroll
    for (int i = 0; i < 9; ++i)
#pragma unroll
        for (int r = 0; r < 4; ++r) { const float pv = sc[i][r] > -1.0e38f ? __expf(sc[i][r] - m) : 0.f; sc[i][r] = pv; sum += pv; }
    sum += __shfl_xor(sum, 16); sum += __shfl_xor(sum, 32);
    const float inv = __builtin_amdgcn_rcpf(sum + __expf(sink - m));
    bf16x8 pf[5];
#pragma unroll
    for (int p = 0; p < 5; ++p) {
        const f32x4 a = sc[2 * p] * inv; const f32x4 b = (p < 4) ? sc[2 * p + 1 < 9 ? 2 * p + 1 : 8] * inv : (f32x4){0.f, 0.f, 0.f, 0.f};
        pf[p] = __builtin_bit_cast(bf16x8, (v4u){pg8::cvt_pk_bf16(a[0], a[1]), pg8::cvt_pk_bf16(a[2], a[3]), pg8::cvt_pk_bf16(b[0], b[1]), pg8::cvt_pk_bf16(b[2], b[3])});
    }
    const unsigned vbase = lds_addr(L) + ATT_VIMG; const unsigned q4 = (unsigned)l15 >> 2, p2 = (unsigned)lane & 3;
    const unsigned vrow = 16u * (unsigned)kt0 + 4u * (unsigned)quad + q4;
#pragma unroll
    for (int c = 0; c < 8; ++c) {
        const unsigned va = vbase + off_b(vrow, 2 * c + (p2 >> 1)) + 8 * (p2 & 1);
        s16x4 t0, t1, t2, t3, t4, t5, t6, t7, t8, t9;
        asm volatile("ds_read_b64_tr_b16 %0, %10\n\tds_read_b64_tr_b16 %1, %10 offset:4096\n\tds_read_b64_tr_b16 %2, %10 offset:8192\n\tds_read_b64_tr_b16 %3, %10 offset:12288\n\t"
                     "ds_read_b64_tr_b16 %4, %10 offset:16384\n\tds_read_b64_tr_b16 %5, %10 offset:20480\n\tds_read_b64_tr_b16 %6, %10 offset:24576\n\tds_read_b64_tr_b16 %7, %10 offset:28672\n\t"
                     "ds_read_b64_tr_b16 %8, %10 offset:32768\n\tds_read_b64_tr_b16 %9, %10 offset:36864\n\ts_waitcnt lgkmcnt(0)"
                     : "=&v"(t0), "=&v"(t1), "=&v"(t2), "=&v"(t3), "=&v"(t4), "=&v"(t5), "=&v"(t6), "=&v"(t7), "=&v"(t8), "=&v"(t9) : "v"(va) : "memory");
        f32x4 o = (f32x4){0.f, 0.f, 0.f, 0.f};
        o = __builtin_amdgcn_mfma_f32_16x16x32_bf16((bf16x8){t0[0], t0[1], t0[2], t0[3], t1[0], t1[1], t1[2], t1[3]}, pf[0], o, 0, 0, 0);
        o = __builtin_amdgcn_mfma_f32_16x16x32_bf16((bf16x8){t2[0], t2[1], t2[2], t2[3], t3[0], t3[1], t3[2], t3[3]}, pf[1], o, 0, 0, 0);
        o = __builtin_amdgcn_mfma_f32_16x16x32_bf16((bf16x8){t4[0], t4[1], t4[2], t4[3], t5[0], t5[1], t5[2], t5[3]}, pf[2], o, 0, 0, 0);
        o = __builtin_amdgcn_mfma_f32_16x16x32_bf16((bf16x8){t6[0], t6[1], t6[2], t6[3], t7[0], t7[1], t7[2], t7[3]}, pf[3], o, 0, 0, 0);
        o = __builtin_amdgcn_mfma_f32_16x16x32_bf16((bf16x8){t8[0], t8[1], t8[2], t8[3], t9[0], t9[1], t9[2], t9[3]}, pf[4], o, 0, 0, 0);
        v2u w; w.x = pk2(o[0], o[1]); w.y = pk2(o[2], o[3]);
        *(v2u*)(optr + 16 * c + 4 * quad) = w;
    }
}
__device__ __forceinline__ void attn_btab(const Frame& F, const float* rel_bias, int kvh) {
    LAS float* btab = (LAS float*)(F.lds + ATT_BTAB_OFF);
    for (int t = F.tid; t < 4 * 129; t += NWAVES * 64) { const int g = t / 129, d = t - g * 129; btab[g * 132 + d] = rel_bias[rel_bucket_dev(d) * 16 + kvh * 4 + g]; }
}
__device__ __forceinline__ void attn_prompt_unit(const Frame& F, int qb, int kvh, const bf16* P, const float* rel_bias, const float* sinks, bf16* MIX) {
    LAS unsigned char* L = F.lds + RING_OFF;
    const int tid = F.tid, lane = F.lane, wave = F.wave;
    attn_btab(F, rel_bias, kvh);
    const int krow0 = 128 * (qb - 1);
    {
        v4u kv[8], vv[8];
#pragma unroll
        for (int it = 0; it < 8; ++it) { const int cid = tid + 512 * it, row = cid >> 4, ch = cid & 15, gr = krow0 + row, gc = gr < 0 ? 0 : gr;
            kv[it] = *(const v4u*)(P + (size_t)gc * PW + C_KA + kvh * 128 + ch * 8); vv[it] = *(const v4u*)(P + (size_t)gc * PW + C_VA + kvh * 128 + ch * 8); }
#pragma unroll
        for (int it = 0; it < 8; ++it) { const int cid = tid + 512 * it, row = cid >> 4, ch = cid & 15; const bool ok = krow0 + row >= 0;
            *(LAS v4u*)(L + ATT_KIMG + off_b(row, ch)) = ok ? kv[it] : (v4u){0u, 0u, 0u, 0u}; *(LAS v4u*)(L + ATT_VIMG + off_b(row, ch)) = ok ? vv[it] : (v4u){0u, 0u, 0u, 0u}; }
    }
    if (tid < 256) { const int row = 256 + (tid >> 4), ch = tid & 15; *(LAS v4u*)(L + ATT_VIMG + off_b(row, ch)) = (v4u){0u, 0u, 0u, 0u}; *(LAS v4u*)(L + ATT_KIMG + off_b(row, ch)) = (v4u){0u, 0u, 0u, 0u}; }
    __syncthreads();
    const LAS float* btab = (const LAS float*)(F.lds + ATT_BTAB_OFF);
    const int quad = lane >> 4, l15 = lane & 15, g = wave >> 1, h = kvh * 4 + g; const float sink = sinks[h];
    bf16x8 qf[4], qn[4];
    attn_load_q(qf, P + (size_t)(128 * qb + 16 * ((wave & 1) * 4) + l15) * PW + C_QA + h * 128, lane);
#pragma unroll 1
    for (int k = 0; k < 4; ++k) { const int qt = (wave & 1) * 4 + k, row = 128 * qb + 16 * qt + l15;
        attn_load_q(qn, P + (size_t)(row + (k < 3 ? 16 : 0)) * PW + C_QA + h * 128, lane);
        attn_tile(L, btab, qf, qt, 128 + l15 - 4 * quad, qb == 0 ? 128 : 0, 256, sink, g, MIX + (size_t)row * DM + h * 128, lane);
#pragma unroll
        for (int s = 0; s < 4; ++s) qf[s] = qn[s]; }
    __syncthreads();
}
__device__ __forceinline__ void attn_sample_unit(const Frame& F, int b, int kvh, const bf16* P, const float* ck, const float* cv, const float* rel_bias, const float* sinks, bf16* MIX) {
    LAS unsigned char* L = F.lds + RING_OFF;
    const int tid = F.tid, lane = F.lane, wave = F.wave;
    attn_btab(F, rel_bias, kvh);
    {
        f32x4 c0[4], c1[4];
#pragma unroll
        for (int kv = 0; kv < 2; ++kv) {
            const float* src = kv ? cv : ck; const int img = kv ? ATT_VIMG : ATT_KIMG;
#pragma unroll
            for (int it = 0; it < 4; ++it) { const int cid = tid + 512 * it, row = cid >> 4, ch = cid & 15; const float* kp = src + ((size_t)(b * 128 + row) * 4 + kvh) * 128 + ch * 8;
                c0[it] = *(const f32x4*)kp; c1[it] = *(const f32x4*)(kp + 4); }
#pragma unroll
            for (int it = 0; it < 4; ++it) { const int cid = tid + 512 * it, row = cid >> 4, ch = cid & 15;
                *(LAS v4u*)(L + img + off_b(row, ch)) = (v4u){pk2(c0[it].x, c0[it].y), pk2(c0[it].z, c0[it].w), pk2(c1[it].x, c1[it].y), pk2(c1[it].z, c1[it].w)}; }
        }
        { const int cid = tid + 2048, row = cid >> 4, ch = cid & 15;
          v4u kv = (v4u){0u, 0u, 0u, 0u}, vv = kv;
          if (row < 132) { const size_t gr = (size_t)TP + 4 * b + (row - 128); kv = *(const v4u*)(P + gr * PW + C_KA + kvh * 128 + ch * 8); vv = *(const v4u*)(P + gr * PW + C_VA + kvh * 128 + ch * 8); }
          *(LAS v4u*)(L + ATT_KIMG + off_b(row, ch)) = kv; *(LAS v4u*)(L + ATT_VIMG + off_b(row, ch)) = vv; }
    }
    __syncthreads();
    if (wave == 0) {
        const LAS float* btab = (const LAS float*)(F.lds + ATT_BTAB_OFF);
        const int quad = lane >> 4, l15 = lane & 15, g = l15 >> 2, t = l15 & 3, h = kvh * 4 + g, row = TP + 4 * b + t;
        bf16x8 qf[4]; attn_load_q(qf, P + (size_t)row * PW + C_QA + h * 128, lane);
        attn_tile(L, btab, qf, 0, 128 + t - 4 * quad, 0, 132, sinks[h], g, MIX + (size_t)row * DM + h * 128, lane);
    }
    __syncthreads();
}
constexpr int N_PHASES = 10;
__global__ void __launch_bounds__(NWAVES * 64, 2) mega_fwd(Params p) {
    extern __shared__ __attribute__((aligned(16))) unsigned char lds[];
    Frame F;
    F.lds = (LAS unsigned char*)lds;
    F.MISC = (volatile LAS unsigned*)(F.lds + MISC_OFF);
    F.tid = threadIdx.x; F.lane = F.tid & 63; F.wave = __builtin_amdgcn_readfirstlane(F.tid >> 6);
    F.G = gridDim.x; { const int bx = blockIdx.x; F.vcu = (F.G % 8 == 0) ? (bx % 8) * (F.G / 8) + bx / 8 : bx; }
    unsigned char* ws = p.ws;
    F.ctl = (gu32*)(ws + WS_CTL);
    for (int u = F.tid; u < (LDS_BYTES - LDSCTL_OFF) / 4; u += NWAVES * 64) ((LAS unsigned*)(F.lds + LDSCTL_OFF))[u] = 0u;
    __syncthreads();
    XcdBarrier bar = xcd_barrier_post((unsigned*)(F.ctl + CW_BAR) + p.li * XCD_BAR_WORDS, F.MISC + 8);
    const int lo = p.ph_lo, hi = p.ph_hi;
#define IN(k) (lo <= (k) && (k) < hi)
#define BOTH(k) (IN(k) && IN((k) + 1))
#define GRID_BAR() xcd_barrier(bar)
#ifdef PROBE_A
    unsigned long long* stamps = (unsigned long long*)(p.ws + WS_QN);
#define STAMP(id) do { if (F.tid == 0) stamps[(size_t)blockIdx.x * 64 + (id)] = wall_clock64(); } while (0)
#else
#define STAMP(id) do {} while (0)
#endif
    STAMP(0);
    bf16* Win_t = (bf16*)(ws + WS_WIN); bf16* Wout_t = (bf16*)(ws + WS_WOUT); bf16* Wgu_t = (bf16*)(ws + WS_WGU); bf16* Wdn_t = (bf16*)(ws + WS_WDN);
    bf16* H = (bf16*)(ws + WS_H); bf16* MIX = (bf16*)(ws + WS_MIX); bf16* P = (bf16*)(ws + WS_P); bf16* ACT = (bf16*)(ws + WS_ACT);
    float* AB = (float*)(ws + WS_AB); bf16* MIXO = (bf16*)(ws + WS_MIXO); bf16* FFNO = (bf16*)(ws + WS_FFNO);
    bf16* SLAB = (bf16*)(ws + WS_VBG);
    const ScanBufs sb{(bf16*)(ws + WS_WF), (bf16*)(ws + WS_KDF), (bf16*)(ws + WS_QEF), (bf16*)(ws + WS_QKF), (float*)(ws + WS_UF), (float*)(ws + WS_EGL), ws + WS_VBG, (bf16*)(ws + WS_SNF), (bf16*)(ws + WS_VNF)};
    float* out = p.out;

    if (IN(0)) { p0_prologue(F, p); STAMP(1); if (BOTH(0)) GRID_BAR(); STAMP(2); }
    if (IN(1)) {
        pg8::Gemm g{H, Win_t, MROWS, PROJ_PAD, DM}; pg8::StaticOrder S; S.init(MROWS, PROJ_PAD, DM, F.G, (int)blockIdx.x);
        pg8::EpiProj E{P, AB, PW};
        pg8::gemm_phase<pg8::EpiProj, pg8::StaticOrder, true, true>(F.lds + RING_OFF, g, S, E);
        STAMP(3); if (BOTH(1)) GRID_BAR(); STAMP(4);
    }
    if (IN(2)) {
        if (p.pad & 1) ph_copy_states(F, P, p.in[2], p.in[3], out);
        STAMP(5);
        if (p.pad & 2) gdn_sample_units(F, F.vcu, F.G, P, AB, p.in[4], p.in[9], p.in[10], p.in[11], p.in[12], p.in[5], out + O_SGDN, MIX);
        STAMP(6);
        if (p.pad & 4) gdn_prep_all(F, P, AB, p.in[9], p.in[10], p.in[11], sb);
        STAMP(7); if (BOTH(2)) GRID_BAR(); STAMP(8);
    }
    if (IN(3)) {
        if (F.G == 256) {
            const int xcd = F.vcu >> 5, r = F.vcu & 31;
            if (r < 16) gdn_scan_unit(F, xcd * 2 + (r >> 3), r & 7, sb, out + O_PGDN);
            else { const int aw = xcd * 16 + (r - 16);
                for (int u = aw; u < 256; u += 128) attn_prompt_unit(F, u >> 2, u & 3, P, p.in[6], p.in[8], MIX);
                for (int u = aw; u < 512; u += 128) attn_sample_unit(F, u >> 2, u & 3, P, p.in[2], p.in[3], p.in[6], p.in[8], MIX);
                STAMP(24);
                w_up_convert(F, p, aw, 128); }
        } else {
            for (int su = F.vcu; su < 128; su += F.G) gdn_scan_unit(F, su >> 3, su & 7, sb, out + O_PGDN);
            for (int u = F.vcu; u < 256; u += F.G) attn_prompt_unit(F, u >> 2, u & 3, P, p.in[6], p.in[8], MIX);
            for (int u = F.vcu; u < 512; u += F.G) attn_sample_unit(F, u >> 2, u & 3, P, p.in[2], p.in[3], p.in[6], p.in[8], MIX);
            w_up_convert(F, p, F.vcu, F.G);
        }
        STAMP(9); if (BOTH(3)) GRID_BAR(); STAMP(10);
    }
    if (IN(4)) { gdn_opass_units(F, F.vcu, F.G, sb, P, p.in[12], MIX); STAMP(11); if (BOTH(4)) GRID_BAR(); STAMP(12); }
    if (IN(5)) {
        pg8::Gemm g{MIX, Wout_t, MROWS, DM, DM}; pg8::SplitTailOrder S; S.init(TP, NSB * NST, DM, DM, F.G, (int)blockIdx.x);
        pg8::EpiBfSlab E{MIXO, DM, SLAB, TP / 256, DM / 64, (size_t)NSB * NST * DM};
        pg8::gemm_phase<pg8::EpiBfSlab, pg8::SplitTailOrder, true, true>(F.lds + RING_OFF, g, S, E);
        STAMP(13); if (BOTH(5)) GRID_BAR(); STAMP(14);
    }
    if (IN(6)) { ph_postmix(F, p, MIXO, SLAB, out, H); STAMP(15); if (BOTH(6)) GRID_BAR(); STAMP(16); }
    if (IN(7)) {
        pg8::Gemm g{H, Wgu_t, MROWS, NGU, DM}; pg8::StaticOrder S; S.init(MROWS, NGU, DM, F.G, (int)blockIdx.x);
        pg8::EpiSwiGLU E{ACT, FF};
        pg8::gemm_phase<pg8::EpiSwiGLU, pg8::StaticOrder, true, true>(F.lds + RING_OFF, g, S, E);
        STAMP(17);
        { const int n12 = S.nwg % F.G, c = (int)blockIdx.x;
          if (n12 == 0) { w_down_convert(F, p, c, F.G); copy_cache_rows(F, p.in[2], p.in[3], out, c, F.G); }
          else if (c >= n12) { w_down_convert(F, p, c - n12, F.G - n12); copy_cache_rows(F, p.in[2], p.in[3], out, c - n12, F.G - n12); } }
        STAMP(18); if (BOTH(7)) GRID_BAR(); STAMP(19);
    }
    if (IN(8)) {
        pg8::Gemm g{ACT, Wdn_t, MROWS, DM, FF}; pg8::SplitTailOrder S; S.init(TP, NSB * NST, DM, FF, F.G, (int)blockIdx.x);
        pg8::EpiBfSlab E{FFNO, DM, SLAB, TP / 256, FF / 64, (size_t)NSB * NST * DM};
        pg8::gemm_phase<pg8::EpiBfSlab, pg8::SplitTailOrder, true, true>(F.lds + RING_OFF, g, S, E);
        STAMP(20); if (BOTH(8)) GRID_BAR(); STAMP(21);
    }
    if (IN(9)) ph_final(F, FFNO, SLAB, p.in[17], out);
#ifdef PROBE_A
    STAMP(22); GRID_BAR(); STAMP(23);
    if (blockIdx.x == 0 && F.tid == 0) {
        double acc = (PROBE_MODE == 2) ? 1e30 : 0.0; int cnt = 0;
        for (int b = 0; b < (int)gridDim.x; ++b) {
            const int vb = (gridDim.x % 8 == 0) ? (b % 8) * ((int)gridDim.x / 8) + b / 8 : b; const bool scanb = (vb & 31) < 16;
            if (PROBE_MODE == 0 && b != 0) continue; if (PROBE_MODE == 3 && !scanb) continue; if (PROBE_MODE == 4 && scanb) continue;
            const double d = (double)(long long)(stamps[(size_t)b * 64 + PROBE_B] - stamps[(size_t)b * 64 + PROBE_A]) * 0.01;
            if (PROBE_MODE == 2) acc = d < acc ? d : acc; else if (PROBE_MODE == 5) acc += d; else acc = d > acc ? d : acc; ++cnt; }
        if (PROBE_MODE == 5) acc /= cnt;
        out[O_SWK] = p.in[2][4 * 512] + (float)(acc / PROBE_DIV); }
#endif
#undef IN
#undef BOTH
#undef GRID_BAR
}
#ifndef MK_N_LAUNCHES
#define MK_N_LAUNCHES 1
#endif
extern "C" void kernel_launch(void* const* d_in, const int* in_sizes, int n_in, void* d_out, int out_size, void* d_ws, size_t ws_size, hipStream_t stream) {
    static int grid = 0;
    if (grid == 0) {
        if (n_in != 21 || out_size != (int)O_TOTAL || ws_size < WS_END) { fprintf(stderr, "kernel_launch: unexpected shapes (n_in %d, out %d, ws %zu < %zu)\n", n_in, out_size, ws_size, (size_t)WS_END); grid = -1; return; }
        int dev = 0, cus = 0;
        if (hipGetDevice(&dev) != hipSuccess || hipDeviceGetAttribute(&cus, hipDeviceAttributeMultiprocessorCount, dev) != hipSuccess) { grid = -1; return; }
        if (hipFuncSetAttribute((const void*)mega_fwd, hipFuncAttributeMaxDynamicSharedMemorySize, LDS_BYTES) != hipSuccess) { fprintf(stderr, "kernel_launch: hipFuncSetAttribute failed\n"); grid = -1; return; }
        int per_cu = 0; (void)hipOccupancyMaxActiveBlocksPerMultiprocessor(&per_cu, (const void*)mega_fwd, NWAVES * 64, LDS_BYTES); (void)hipGetLastError();
        grid = cus;
    }
    if (grid < 0) return;
    Params p{};
    for (int i = 0; i < 21; ++i) p.in[i] = (const float*)d_in[i];
    p.out = (float*)d_out; p.ws = (unsigned char*)d_ws;
#ifdef MK_PLAN
    const int plan[][3] = {MK_PLAN};
#else
    const int plan[][3] = {{0, N_PHASES, 7}};
#endif
    constexpr int nplan = (int)(sizeof(plan) / sizeof(plan[0]));
    static_assert((size_t)(CW_BAR + nplan * XCD_BAR_WORDS) * 4 <= CTL_ZERO_BYTES, "barrier words inside the control region");
    (void)hipMemsetAsync((char*)d_ws + WS_CTL, 0, (size_t)(CW_BAR + nplan * XCD_BAR_WORDS) * 4, stream);
    for (int li = 0; li < (int)(sizeof(plan) / sizeof(plan[0])); ++li) { p.ph_lo = plan[li][0]; p.ph_hi = plan[li][1]; p.li = li; p.pad = plan[li][2];
        hipLaunchKernelGGL(mega_fwd, dim3(grid), dim3(NWAVES * 64), LDS_BYTES, stream, p); }
}
```

```cpp
#include <hip/hip_runtime.h>
#include <cstdio>
#include <cstdint>
namespace pg8 {
#define PG8_LAS __attribute__((address_space(3)))
typedef unsigned short bf16_t;
typedef short bf16x8 __attribute__((ext_vector_type(8)));
typedef float f32x4 __attribute__((ext_vector_type(4)));
typedef unsigned u32x4 __attribute__((ext_vector_type(4)));
constexpr int BM = 256, BK = 64, HALF = 128, HTB = HALF * BK * 2  , STAGE_BYTES = 8 * HTB, NXCD = 8, WGM = 8;

__host__ __device__ __forceinline__ int lds_byte(int r, int c) { const int st = (r >> 4) * 2 + (c >> 5), rr = r & 15, cc = c & 31, ob = rr * 64 + cc * 2; return st * 1024 + (ob ^ (((ob >> 9) & 1) << 5)); }
__host__ __device__ __forceinline__ void stage_rc(int b, int& R, int& C) { const int st = b / 1024, sb = b % 1024, swz = sb ^ (((sb >> 9) & 1) << 5); R = (st >> 1) * 16 + swz / 64; C = (st & 1) * 32 + (swz % 64) / 2; }
__host__ __device__ __forceinline__ int perm32(int rho) { const int n = rho >> 4, i = rho & 15; return 8 * (i >> 2) + 4 * n + (i & 3); }

struct Unit { int pm, pn, k0, nk; };
struct Gemm { const bf16_t* A; const bf16_t* Bt; int M, N, K; };

struct StaticOrder {
    int nM, nN, nwg, G, c, ntf;
    __host__ __device__ void init(int M, int N, int K, int G_, int c_) { nM = M / BM; nN = N / BM; nwg = nM * nN; G = G_; c = c_; ntf = K / BK; }
    __host__ __device__ bool next(int i, Unit& u) const {
        const long L = (long)i * G + c; if (L >= nwg) return false;
        int wgid = (int)L; { const int q = nwg / NXCD, r = nwg % NXCD, xcd = wgid % NXCD, off = wgid / NXCD; wgid = (xcd < r ? xcd * (q + 1) : r * (q + 1) + (xcd - r) * q) + off; }
        const int nig = WGM * nN, gid = wgid / nig, fm = gid * WGM, gsz = (nM - fm) < WGM ? (nM - fm) : WGM;
        u.pm = fm + ((wgid % nig) % gsz); u.pn = (wgid % nig) / gsz; u.k0 = 0; u.nk = ntf; return true;
    }
    __device__ __forceinline__ void a_ready(const Unit&) const {}
    __device__ __forceinline__ void done(const Unit&) const {}
};
struct SplitTailOrder {
    StaticOrder base; int mp, ntail_items;
    __host__ __device__ void init(int Mprompt, int Msample, int N, int K, int G_, int c_) { base.init(Mprompt, N, K, G_, c_); mp = Mprompt / BM; ntail_items = (Msample / BM) * (N / BM) * 8; }
    __host__ __device__ bool next(int i, Unit& u) const {
        Unit t; t.pm = 0; t.pn = 0; t.k0 = 0; t.nk = base.ntf; const bool full = base.next(i, t);
        const int nb = (base.nwg - base.c + base.G - 1) / base.G;
        const int item = (i - nb) * base.G + base.c; const bool tail = !full && i >= nb && item < ntail_items;
        const int tt = item >> 3, sp = item & 7, per = (base.ntf / 16) * 2, rem = (base.ntf - 8 * per) / 2;
        u.pm = full ? t.pm : mp + tt / base.nN; u.pn = full ? t.pn : tt % base.nN; u.nk = full ? t.nk : per + (sp < rem ? 2 : 0); u.k0 = full ? 0 : sp * per + 2 * (sp < rem ? sp : rem);
        return full || tail;
    }
    __device__ __forceinline__ void a_ready(const Unit&) const {}
    __device__ __forceinline__ void done(const Unit&) const {}
};
__device__ __forceinline__ unsigned cvt_pk_bf16(float lo, float hi) { unsigned r; asm volatile("v_cvt_pk_bf16_f32 %0, %1, %2" : "=v"(r) : "v"(lo), "v"(hi)); return r; }
typedef float f32x2 __attribute__((ext_vector_type(2)));
__device__ __forceinline__ float silu_f(float x) { return x * __builtin_amdgcn_rcpf(1.0f + __expf(-x)); }
struct EpiProj {
    static constexpr bool PERM = true, AFTER_DRAIN = false;
    bf16_t* P; float* AB; int ldp;
    __device__ __forceinline__ void operator()(const f32x4 (&acc)[2][2][4][2], const Unit& u, int wr, int wc, int fr, int fq) const {
        const int row0 = u.pm * BM + wr * 64 + fr;
        if (u.pn < 44) {
            const int col0 = u.pn * BM + wc * 32 + 8 * fq;
#pragma unroll
            for (int ai = 0; ai < 2; ++ai)
#pragma unroll
                for (int m = 0; m < 4; ++m) { bf16_t* rowp = P + (size_t)(row0 + ai * HALF + m * 16) * ldp + col0;
#pragma unroll
                    for (int bj = 0; bj < 2; ++bj) { const f32x4 v0 = acc[ai][bj][m][0], v1 = acc[ai][bj][m][1];
                        u32x4 w; w.x = cvt_pk_bf16(v0[0], v0[1]); w.y = cvt_pk_bf16(v0[2], v0[3]); w.z = cvt_pk_bf16(v1[0], v1[1]); w.w = cvt_pk_bf16(v1[2], v1[3]);
                        *(u32x4*)(rowp + bj * HALF) = w; } }
        } else if (wc == 0) {
#pragma unroll
            for (int ai = 0; ai < 2; ++ai)
#pragma unroll
                for (int m = 0; m < 4; ++m) { float* rp = AB + (size_t)(row0 + ai * HALF + m * 16) * 32 + 8 * fq;
                    *(f32x4*)(rp) = acc[ai][0][m][0]; *(f32x4*)(rp + 4) = acc[ai][0][m][1]; }
        }
    }
};
struct EpiBfSlab {
    static constexpr bool PERM = true, AFTER_DRAIN = false;
    bf16_t* C; int ldc; bf16_t* slab; int mp, ntf; size_t slab_stride;
    __device__ __forceinline__ void operator()(const f32x4 (&acc)[2][2][4][2], const Unit& u, int wr, int wc, int fr, int fq) const {
        const int col0 = u.pn * BM + wc * 32 + 8 * fq, row0 = u.pm * BM + wr * 64 + fr;
        if (u.nk == ntf) {
#pragma unroll
            for (int ai = 0; ai < 2; ++ai)
#pragma unroll
                for (int m = 0; m < 4; ++m) { bf16_t* rowp = C + (size_t)(row0 + ai * HALF + m * 16) * ldc + col0;
#pragma unroll
                    for (int bj = 0; bj < 2; ++bj) { const f32x4 v0 = acc[ai][bj][m][0], v1 = acc[ai][bj][m][1];
                        u32x4 w; w.x = cvt_pk_bf16(v0[0], v0[1]); w.y = cvt_pk_bf16(v0[2], v0[3]); w.z = cvt_pk_bf16(v1[0], v1[1]); w.w = cvt_pk_bf16(v1[2], v1[3]);
                        *(u32x4*)(rowp + bj * HALF) = w; } }
        } else {
            const int per = (ntf / 16) * 2, rem = (ntf - 8 * per) / 2; const int sp = u.k0 < rem * (per + 2) ? u.k0 / (per + 2) : rem + (u.k0 - rem * (per + 2)) / per;
            bf16_t* Cb = slab + (size_t)sp * slab_stride; const int r0 = row0 - mp * BM;
#pragma unroll
            for (int ai = 0; ai < 2; ++ai)
#pragma unroll
                for (int m = 0; m < 4; ++m) { bf16_t* rowp = Cb + (size_t)(r0 + ai * HALF + m * 16) * ldc + col0;
#pragma unroll
                    for (int bj = 0; bj < 2; ++bj) { const f32x4 v0 = acc[ai][bj][m][0], v1 = acc[ai][bj][m][1];
                        u32x4 w; w.x = cvt_pk_bf16(v0[0], v0[1]); w.y = cvt_pk_bf16(v0[2], v0[3]); w.z = cvt_pk_bf16(v1[0], v1[1]); w.w = cvt_pk_bf16(v1[2], v1[3]);
                        *(u32x4*)(rowp + bj * HALF) = w; } }
        }
    }
};
struct EpiSwiGLU {
    static constexpr bool PERM = true, AFTER_DRAIN = false;
    bf16_t* O; int ldc;
    __device__ __forceinline__ void operator()(const f32x4 (&acc)[2][2][4][2], const Unit& u, int wr, int wc, int fr, int fq) const {
        const int row0 = u.pm * BM + wr * 64 + fr, col0 = u.pn * HALF + wc * 32 + 8 * fq;
#pragma unroll
        for (int ai = 0; ai < 2; ++ai)
#pragma unroll
            for (int m = 0; m < 4; ++m) { bf16_t* rowp = O + (size_t)(row0 + ai * HALF + m * 16) * ldc + col0;
                const f32x4 g0 = acc[ai][0][m][0], g1 = acc[ai][0][m][1], u0 = acc[ai][1][m][0], u1 = acc[ai][1][m][1];
                u32x4 w; w.x = cvt_pk_bf16(silu_f(g0[0]) * u0[0], silu_f(g0[1]) * u0[1]); w.y = cvt_pk_bf16(silu_f(g0[2]) * u0[2], silu_f(g0[3]) * u0[3]);
                w.z = cvt_pk_bf16(silu_f(g1[0]) * u1[0], silu_f(g1[1]) * u1[1]); w.w = cvt_pk_bf16(silu_f(g1[2]) * u1[2], silu_f(g1[3]) * u1[3]);
                *(u32x4*)rowp = w; }
    }
};
template <class Epi, class Sched, bool ALIGN_EPI = false, bool SP2 = false>
__device__ __forceinline__ void gemm_phase(PG8_LAS unsigned char* lds, const Gemm g, const Sched& S, const Epi& E) {
    const int tid = threadIdx.x, wid = __builtin_amdgcn_readfirstlane(tid >> 6), lane = tid & 63, wr = wid >> 2, wc = wid & 3, fr = lane & 15, fq = lane >> 4;
    const int K = g.K;
    unsigned voffA[2], voffB[2];
#pragma unroll
    for (int i = 0; i < 2; ++i) { int R, C; stage_rc(tid * 16 + i * 8192, R, C); const int Rb = Epi::PERM ? ((R & ~31) + perm32(R & 31)) : R;
        voffA[i] = (unsigned)(R * K + C) * 2u; voffB[i] = (unsigned)(Rb * K + C) * 2u; }
    const size_t kstep = (size_t)(BK * 2);
    const size_t hstep = (size_t)HALF * K * 2;
    const size_t tstep = 2 * hstep;
    const unsigned ldsw = (unsigned)wid * 1024u;
    const int aoff = lds_byte(wr * 64 + fr, fq * 8), boff = lds_byte(wc * 32 + fr, fq * 8);
#define PG8_SA(b, h) (((b) * 2 + (h)) * HTB)
#define PG8_SB(b, h) ((4 + (b) * 2 + (h)) * HTB)
#define PG8_STAGE(bufoff, gbase, voff) do { _Pragma("unroll") for (int _i = 0; _i < 2; ++_i) \
        __builtin_amdgcn_global_load_lds((const unsigned*)((const char*)(gbase) + (voff)[_i]), (PG8_LAS unsigned*)(lds + (bufoff) + ldsw + _i * 8192), 16, 0, 0); } while (0)
#define PG8_LDA(dst, b, h) do { _Pragma("unroll") for (int m = 0; m < 4; ++m) _Pragma("unroll") for (int k = 0; k < 2; ++k) dst[m][k] = *(const PG8_LAS bf16x8*)(lds + PG8_SA(b, h) + aoff + m * 2048 + k * 1024); } while (0)
#define PG8_LDB(dst, b, h) do { _Pragma("unroll") for (int n = 0; n < 2; ++n) _Pragma("unroll") for (int k = 0; k < 2; ++k) dst[n][k] = *(const PG8_LAS bf16x8*)(lds + PG8_SB(b, h) + boff + n * 2048 + k * 1024); } while (0)
#define PG8_MMA(ai, bj, At, Bt) do { __builtin_amdgcn_s_setprio(1); _Pragma("unroll") for (int m = 0; m < 4; ++m) _Pragma("unroll") for (int n = 0; n < 2; ++n) _Pragma("unroll") for (int k = 0; k < 2; ++k) \
        acc[ai][bj][m][n] = __builtin_amdgcn_mfma_f32_16x16x32_bf16(Bt[n][k], At[m][k], acc[ai][bj][m][n], 0, 0, 0); __builtin_amdgcn_s_setprio(0); } while (0)
#define PG8_WAIT_V(n) asm volatile("s_waitcnt vmcnt(" #n ")" ::: "memory")
#define PG8_WAIT_L(n) asm volatile("s_waitcnt lgkmcnt(" #n ")" ::: "memory")
#define PG8_BAR __builtin_amdgcn_s_barrier()
#define PG8_SCHED __builtin_amdgcn_sched_barrier(0)
    Unit cur, nxt; int ui = 0;
    if (!S.next(0, cur)) return;
    f32x4 acc[2][2][4][2];
#pragma unroll
    for (int a = 0; a < 2; ++a)
#pragma unroll
        for (int b = 0; b < 2; ++b)
#pragma unroll
            for (int m = 0; m < 4; ++m)
#pragma unroll
                for (int n = 0; n < 2; ++n) acc[a][b][m][n] = (f32x4){0.f, 0.f, 0.f, 0.f};
    bf16x8 At[4][2], B0[2][2], B1[2][2];
    const char* cA = (const char*)g.A + (size_t)cur.pm * tstep + (size_t)cur.k0 * (BK * 2); const char* cB = (const char*)g.Bt + (size_t)cur.pn * tstep + (size_t)cur.k0 * (BK * 2);
    S.a_ready(cur);
    if constexpr (SP2) {
        PG8_STAGE(PG8_SB(0, 0), cB, voffB); PG8_STAGE(PG8_SB(0, 1), cB + hstep, voffB); PG8_STAGE(PG8_SA(0, 0), cA, voffA); PG8_STAGE(PG8_SA(0, 1), cA + hstep, voffA);
        if (wr == 1) PG8_BAR;
        PG8_WAIT_V(2); PG8_BAR;
        PG8_STAGE(PG8_SB(1, 0), cB + kstep, voffB); PG8_STAGE(PG8_SA(1, 0), cA + kstep, voffA); PG8_STAGE(PG8_SB(1, 1), cB + hstep + kstep, voffB);
        PG8_WAIT_V(6); PG8_BAR;
    } else {
        PG8_STAGE(PG8_SB(0, 0), cB, voffB); PG8_STAGE(PG8_SA(0, 0), cA, voffA); PG8_STAGE(PG8_SB(0, 1), cB + hstep, voffB); PG8_STAGE(PG8_SA(0, 1), cA + hstep, voffA);
        if (wr == 1) PG8_BAR;
        PG8_WAIT_V(4); PG8_BAR;
        PG8_STAGE(PG8_SB(1, 0), cB + kstep, voffB); PG8_STAGE(PG8_SA(1, 0), cA + kstep, voffA); PG8_STAGE(PG8_SB(1, 1), cB + hstep + kstep, voffB);
        PG8_WAIT_V(6); PG8_BAR;
    }
    for (;;) {
        const bool has_next = S.next(ui + 1, nxt);
        const char* nA = has_next ? (const char*)g.A + (size_t)nxt.pm * tstep + (size_t)nxt.k0 * (BK * 2) : cA; const char* nB = has_next ? (const char*)g.Bt + (size_t)nxt.pn * tstep + (size_t)nxt.k0 * (BK * 2) : cB;
        const int nt = cur.nk;
        for (int t = 0; t < nt; t += 2) {
            const bool last = (t == nt - 2);
            const char* a1 = cA + (size_t)(t + 1) * kstep;
            const char* a2 = last ? nA : cA + (size_t)(t + 2) * kstep; const char* b2 = last ? nB : cB + (size_t)(t + 2) * kstep;
            const char* a3 = a2 + kstep; const char* b3 = b2 + kstep;
            if (last && has_next) S.a_ready(nxt);
            if constexpr (SP2) {
            PG8_LDB(B0, 0, 0); PG8_LDB(B1, 0, 1); PG8_SCHED; PG8_LDA(At, 0, 0); PG8_STAGE(PG8_SA(1, 1), a1 + hstep, voffA);
            PG8_WAIT_V(8); PG8_WAIT_L(0); PG8_BAR; PG8_MMA(0, 0, At, B0); PG8_MMA(0, 1, At, B1); PG8_BAR; PG8_SCHED;
            PG8_LDA(At, 0, 1); PG8_STAGE(PG8_SB(0, 0), b2, voffB); PG8_STAGE(PG8_SB(0, 1), b2 + hstep, voffB); PG8_STAGE(PG8_SA(0, 0), a2, voffA);
            PG8_WAIT_V(8); PG8_WAIT_L(0); PG8_BAR; PG8_MMA(1, 0, At, B0); PG8_MMA(1, 1, At, B1); PG8_BAR; PG8_SCHED;
            PG8_LDB(B0, 1, 0); PG8_LDB(B1, 1, 1); PG8_SCHED; PG8_LDA(At, 1, 0); PG8_STAGE(PG8_SA(0, 1), a2 + hstep, voffA);
            PG8_WAIT_V(8); PG8_WAIT_L(0); PG8_BAR; PG8_MMA(0, 0, At, B0); PG8_MMA(0, 1, At, B1); PG8_BAR; PG8_SCHED;
            PG8_LDA(At, 1, 1); PG8_STAGE(PG8_SB(1, 0), b3, voffB); PG8_STAGE(PG8_SB(1, 1), b3 + hstep, voffB); PG8_STAGE(PG8_SA(1, 0), a3, voffA);
            PG8_WAIT_V(8); PG8_WAIT_L(0); PG8_BAR; PG8_MMA(1, 0, At, B0); PG8_MMA(1, 1, At, B1); PG8_BAR; PG8_SCHED;
            } else {
            PG8_LDB(B0, 0, 0); PG8_SCHED; PG8_LDA(At, 0, 0); PG8_STAGE(PG8_SA(1, 1), a1 + hstep, voffA);
            PG8_WAIT_L(8); PG8_BAR; PG8_WAIT_L(0); PG8_MMA(0, 0, At, B0); PG8_BAR; PG8_SCHED;
            PG8_LDB(B1, 0, 1); PG8_STAGE(PG8_SB(0, 0), b2, voffB);
            PG8_BAR; PG8_WAIT_L(0); PG8_MMA(0, 1, At, B1); PG8_BAR;
            PG8_LDA(At, 0, 1); PG8_STAGE(PG8_SA(0, 0), a2, voffA);
            PG8_BAR; PG8_WAIT_L(0); PG8_MMA(1, 0, At, B0); PG8_BAR; PG8_SCHED;
            PG8_STAGE(PG8_SB(0, 1), b2 + hstep, voffB);
            PG8_WAIT_V(6); PG8_BAR; PG8_MMA(1, 1, At, B1); PG8_BAR;
            PG8_LDB(B0, 1, 0); PG8_SCHED; PG8_LDA(At, 1, 0); PG8_STAGE(PG8_SA(0, 1), a2 + hstep, voffA);
            PG8_WAIT_L(8); PG8_BAR; PG8_WAIT_L(0); PG8_MMA(0, 0, At, B0); PG8_BAR; PG8_SCHED;
            PG8_LDB(B1, 1, 1); PG8_STAGE(PG8_SB(1, 0), b3, voffB);
            PG8_BAR; PG8_WAIT_L(0); PG8_MMA(0, 1, At, B1); PG8_BAR;
            PG8_LDA(At, 1, 1); PG8_STAGE(PG8_SA(1, 0), a3, voffA);
            PG8_BAR; PG8_WAIT_L(0); PG8_MMA(1, 0, At, B0); PG8_BAR; PG8_SCHED;
            PG8_STAGE(PG8_SB(1, 1), b3 + hstep, voffB);
            PG8_WAIT_V(6); PG8_BAR; PG8_MMA(1, 1, At, B1); PG8_BAR;
            }
        }
        if constexpr (ALIGN_EPI) { if (wr == 0) PG8_BAR; }
        if constexpr (!Epi::AFTER_DRAIN) { E(acc, cur, wr, wc, fr, fq); S.done(cur); }
        if (!has_next) break;
#pragma unroll
        for (int a = 0; a < 2; ++a)
#pragma unroll
            for (int b = 0; b < 2; ++b)
#pragma unroll
                for (int m = 0; m < 4; ++m)
#pragma unroll
                    for (int n = 0; n < 2; ++n) acc[a][b][m][n] = (f32x4){0.f, 0.f, 0.f, 0.f};
        cur = nxt; cA = nA; cB = nB; ++ui;
        if constexpr (ALIGN_EPI) { if (wr == 1) PG8_BAR; }
    }
    PG8_WAIT_V(0);
    if constexpr (!ALIGN_EPI) { if (wr == 0) PG8_BAR; }
    PG8_BAR;
    if constexpr (Epi::AFTER_DRAIN) { E.fused(acc, cur, wr, wc, fr, fq, lds, wid, lane); S.done(cur); }
#undef PG8_SA
#undef PG8_SB
#undef PG8_STAGE
#undef PG8_LDA
#undef PG8_LDB
#undef PG8_MMA
#undef PG8_WAIT_V
#undef PG8_WAIT_L
#undef PG8_BAR
#undef PG8_SCHED
}
}
constexpr int NWAVES = 8;
constexpr int DM = 4096, TP = 8192, NSB = 128, NST = 4, MROWS = TP + NSB * NST;
constexpr int PROJ_W = 11296, PROJ_PAD = 11520, PW = 11264;
constexpr int C_QA = 0, C_KA = 2048, C_VA = 2560, C_QKVG = 3072, C_ZG = 9216;
constexpr int FF = 11008, NGU = 2 * FF;
constexpr float NORM_EPS = 1e-6f;
constexpr size_t O_YP = 0, O_YS = 33554432, O_PWK = 35651584, O_PWV = 35717120, O_PCONV = 35782656, O_PGDN = 35801088,
                 O_SWK = 36063232, O_SWV = 44451840, O_SCONV = 52840448, O_SGDN = 55199744, O_TOTAL = 88754176;
constexpr size_t WS_CTL = 0, CTL_ZERO_BYTES = 1u << 20;
constexpr size_t WS_WIN = CTL_ZERO_BYTES;
constexpr size_t WS_WOUT = WS_WIN + (size_t)PROJ_PAD * DM * 2;
constexpr size_t WS_WGU = WS_WOUT + (size_t)DM * DM * 2;
constexpr size_t WS_WDN = WS_WGU + (size_t)NGU * DM * 2;
constexpr size_t WS_H = WS_WDN + (size_t)DM * FF * 2;
constexpr size_t WS_MIX = WS_H + (size_t)MROWS * DM * 2;
constexpr size_t WS_FFNO = WS_H;
constexpr size_t WS_P = WS_MIX + (size_t)MROWS * DM * 2;
constexpr size_t WS_MIXO = WS_P;
constexpr size_t WS_ACT = WS_P;
constexpr size_t WS_AB = WS_P + (size_t)MROWS * PW * 2;
constexpr size_t WS_QN = WS_AB + (size_t)MROWS * 32 * 4;
constexpr size_t WS_KN = WS_QN + (size_t)NSB * NST * 2048 * 4;
constexpr size_t WS_VN = WS_KN + (size_t)NSB * NST * 2048 * 4;
constexpr size_t WS_GB = WS_VN + (size_t)NSB * NST * 2048 * 4;
constexpr size_t WS_ORAW = WS_GB + (size_t)MROWS * 32 * 4;
constexpr int NUNIT = 16 * 128;
constexpr size_t WS_WF = WS_ORAW + (size_t)MROWS * 2048 * 4;
constexpr size_t WS_KDF = WS_WF + (size_t)NUNIT * 16384;
constexpr size_t WS_QEF = WS_KDF + (size_t)NUNIT * 16384;
constexpr size_t WS_QKF = WS_QEF + (size_t)NUNIT * 16384;
constexpr size_t WS_UF = WS_QKF + (size_t)NUNIT * 8192;
constexpr size_t WS_EGL = WS_UF + (size_t)NUNIT * 32768;
constexpr size_t WS_VBG = WS_EGL + (size_t)NUNIT * 4;
constexpr size_t WS_VNF = WS_VBG + (size_t)NUNIT * 32768;
constexpr size_t WS_END = WS_VNF + (size_t)NUNIT * 16384;
constexpr size_t WS_SNF = WS_ORAW;
static_assert((size_t)MROWS * DM * 4 <= 2 * (size_t)MROWS * DM * 2 && (size_t)MROWS * FF * 2 <= (size_t)MROWS * PW * 2, "overlays");
constexpr int CW_TMO = 0, CW_CODE = 1, CW_BAR = 4096;
constexpr int RING_OFF = 0, RING_BYTES = 139264;
constexpr int LDSCTL_OFF = RING_BYTES, MISC_OFF = LDSCTL_OFF + 320;
constexpr int LDS_BYTES = 147456;
#define GAS __attribute__((address_space(1)))
#define LAS __attribute__((address_space(3)))
typedef unsigned short bf16;
typedef unsigned v4u __attribute__((ext_vector_type(4)));
typedef unsigned v2u __attribute__((ext_vector_type(2)));
typedef float f32x4 __attribute__((ext_vector_type(4)));
typedef short bf16x8 __attribute__((ext_vector_type(8)));
typedef GAS unsigned gu32;
#define RLX_AGENT __ATOMIC_RELAXED, __HIP_MEMORY_SCOPE_AGENT
#define LDS_WAIT() asm volatile("s_waitcnt lgkmcnt(0)" ::: "memory")
#define VM_WAIT() asm volatile("s_waitcnt vmcnt(0)" ::: "memory")
#define LDS_BAR() do { asm volatile("s_waitcnt lgkmcnt(0)" ::: "memory"); __builtin_amdgcn_s_barrier(); asm volatile("" ::: "memory"); } while (0)
__device__ __forceinline__ unsigned f2bf(float f) { unsigned u = __builtin_bit_cast(unsigned, f); return (u + 0x7fffu + ((u >> 16) & 1u)) >> 16; }
__device__ __forceinline__ unsigned pk2(float lo, float hi) { return f2bf(lo) | (f2bf(hi) << 16); }
__device__ __forceinline__ float bf2f(unsigned short b) { return __builtin_bit_cast(float, ((unsigned)b) << 16); }
__device__ __forceinline__ float bflo(unsigned w) { return __builtin_bit_cast(float, w << 16); }
__device__ __forceinline__ float bfhi(unsigned w) { return __builtin_bit_cast(float, w & 0xffff0000u); }
__device__ __forceinline__ float wave_sum(float v) {
#pragma unroll
    for (int o = 1; o < 64; o <<= 1) v += __shfl_xor(v, o);
    return v;
}
__device__ __forceinline__ float wave_max(float v) {
#pragma unroll
    for (int o = 1; o < 64; o <<= 1) v = fmaxf(v, __shfl_xor(v, o));
    return v;
}
__device__ __forceinline__ float sigmoid_f(float x) { return __builtin_amdgcn_rcpf(1.0f + __expf(-x)); }
__device__ __forceinline__ float silu_f(float x) { return x * __builtin_amdgcn_rcpf(1.0f + __expf(-x)); }
__device__ __forceinline__ float softplus_f(float x) { return fmaxf(x, 0.f) + log1pf(__expf(-fabsf(x))); }
template <int CTRL> __device__ __forceinline__ float dpp_mov(float v) { return __builtin_bit_cast(float, __builtin_amdgcn_update_dpp(0, __builtin_bit_cast(int, v), CTRL, 0xf, 0xf, true)); }
__device__ __forceinline__ float sum16(float v) { v += dpp_mov<0xB1>(v); v += dpp_mov<0x4E>(v); v += dpp_mov<0x141>(v); v += dpp_mov<0x140>(v); return v; }
#define XB_TMO      128
#define XB_XCNT(j)  (256  + 64 * (j))
#define XB_XSUB(j)  (1280 + 64 * (j))
#define XB_XGEN(j)  (2304 + 64 * (j))
#define XB_TOP      3328
#define XB_TOPGEN   3392
#define XCD_BAR_WORDS 3456
#define XB_SPIN_CAP (1u << 18)

__device__ __forceinline__ unsigned xb_ld(unsigned* p)              { return __hip_atomic_load(p, __ATOMIC_RELAXED, __HIP_MEMORY_SCOPE_AGENT); }
__device__ __forceinline__ unsigned xb_add(unsigned* p, unsigned v) { return __hip_atomic_fetch_add(p, v, __ATOMIC_RELAXED, __HIP_MEMORY_SCOPE_AGENT); }
__device__ __forceinline__ unsigned xb_xcc_id() { return (unsigned)__builtin_amdgcn_s_getreg((3 << 11) | 20) & 0xFu; }
#define XB_SPIN(cond, bar) do { unsigned _sp = 0; while (cond) { __builtin_amdgcn_s_sleep(1); \
    if ((++_sp & 255u) == 0u) { if (xb_ld(&(bar)[XB_TMO])) break; if (_sp > XB_SPIN_CAP) { atomicAdd(&(bar)[XB_TMO], 1u); break; } } } } while (0)

struct XcdBarrier {
    unsigned* bar; unsigned x;
    volatile LAS unsigned* st;
};

__device__ __forceinline__ XcdBarrier xcd_barrier_post(unsigned* bar, volatile LAS unsigned* st) {
    XcdBarrier b; b.bar = bar; b.x = xb_xcc_id(); b.st = st;
    if (threadIdx.x == 0) (void)xb_add(&bar[XB_XCNT(b.x)], 1u);
    return b;
}
__device__ __forceinline__ void xcd_barrier_complete(unsigned* bar, unsigned x, unsigned& nloc, unsigned& nx) {
    const unsigned G = gridDim.x * gridDim.y * gridDim.z;
    unsigned sum, cnt, mine, sp = 0u;
    for (;;) {
        sum = 0u; cnt = 0u; mine = 0u;
#pragma unroll
        for (unsigned j = 0; j < 16; ++j) { const unsigned c = xb_ld(&bar[XB_XCNT(j)]); sum += c; cnt += (c > 0u) ? 1u : 0u; mine = (j == x) ? c : mine; }
        if (sum == G) break;
        __builtin_amdgcn_s_sleep(1);
        if ((++sp & 255u) == 0u) { if (xb_ld(&bar[XB_TMO])) break; if (sp > XB_SPIN_CAP) { atomicAdd(&bar[XB_TMO], 1u); break; } }
    }
    nloc = mine > 0u ? mine : 1u; nx = cnt > 0u ? cnt : 1u;
}

__device__ __forceinline__ void xcd_barrier(const XcdBarrier& b) {
    asm volatile("s_waitcnt vmcnt(0)" ::: "memory");
    __syncthreads();
    if (threadIdx.x == 0) {
        unsigned* bar = b.bar;
        __builtin_amdgcn_s_waitcnt(0);
        unsigned nloc = b.st[0], nx = b.st[1];
        if (nloc == 0u) { xcd_barrier_complete(bar, b.x, nloc, nx); b.st[0] = nloc; b.st[1] = nx; }
        const unsigned old = xb_add(&bar[XB_XSUB(b.x)], 1u);
        const unsigned gen = old / nloc;
        if (old + 1u == (gen + 1u) * nloc) {
            __builtin_amdgcn_fence(__ATOMIC_RELEASE, "agent");
            asm volatile("s_waitcnt vmcnt(0)" ::: "memory");
            const unsigned og = xb_add(&bar[XB_TOP], 1u);
            const unsigned tg = og / nx;
            if (og + 1u == (tg + 1u) * nx) xb_add(&bar[XB_TOPGEN], 1u);
            else XB_SPIN(xb_ld(&bar[XB_TOPGEN]) == tg, bar);
            __builtin_amdgcn_fence(__ATOMIC_ACQUIRE, "agent");
            xb_add(&bar[XB_XGEN(b.x)], 1u);
            asm volatile("s_waitcnt vmcnt(0)" ::: "memory");
        } else {
            XB_SPIN(xb_ld(&bar[XB_XGEN(b.x)]) == gen, bar);
            __builtin_amdgcn_fence(__ATOMIC_ACQUIRE, "agent");
            asm volatile("s_waitcnt vmcnt(0)" ::: "memory");
        }
    }
    __syncthreads();
}
struct Params {
    const float* in[21]; float* out; unsigned char* ws; int ph_lo, ph_hi, li, pad;
};
struct Frame {
    LAS unsigned char* lds;
    volatile LAS unsigned* MISC;
    gu32* ctl;
    int tid, lane, wave, vcu, G;
};
__device__ __forceinline__ void p0_transpose_item(const float* W, int K, int N, bf16* WT, int k0, int n0, int dst_row0, LAS float* scr, int lane) {
#pragma unroll 8
    for (int i = 0; i < 32; ++i) { const int kk = 2 * i + (lane >> 5); scr[kk * 33 + (lane & 31)] = W[(size_t)(k0 + kk) * N + n0 + (lane & 31)]; }
    LDS_WAIT(); asm volatile("" ::: "memory");
    const int c = lane & 7;
#pragma unroll
    for (int j = 0; j < 4; ++j) { const int n = (lane >> 3) + 8 * j; const LAS float* s = scr + (8 * c) * 33 + n;
        v4u o; o.x = pk2(s[0 * 33], s[1 * 33]); o.y = pk2(s[2 * 33], s[3 * 33]); o.z = pk2(s[4 * 33], s[5 * 33]); o.w = pk2(s[6 * 33], s[7 * 33]);
        *(GAS v4u*)(WT + (size_t)(dst_row0 + n) * K + k0 + 8 * c) = o; }
    LDS_WAIT(); asm volatile("" ::: "memory");
}
__device__ __forceinline__ const float* x_row(const Params& p, int m) { return m < TP ? p.in[0] + (size_t)m * DM : p.in[1] + (size_t)(m - TP) * DM; }
__device__ __forceinline__ void rms_row_to_bf16(const float* xrow, const float* w, bf16* orow, int lane) {
    const GAS f32x4* xr = (const GAS f32x4*)xrow + lane; const GAS f32x4* wr = (const GAS f32x4*)w + lane;
    f32x4 v[16]; float s = 0.f;
#pragma unroll
    for (int j = 0; j < 16; ++j) { v[j] = xr[64 * j]; s += (v[j].x * v[j].x + v[j].y * v[j].y) + (v[j].z * v[j].z + v[j].w * v[j].w); }
    const float r = rsqrtf(wave_sum(s) * (1.f / DM) + NORM_EPS);
    GAS v2u* o8 = (GAS v2u*)orow + lane;
#pragma unroll
    for (int j = 0; j < 16; ++j) { const f32x4 ww = wr[64 * j]; v2u o; o.x = pk2(v[j].x * r * ww.x, v[j].y * r * ww.y); o.y = pk2(v[j].z * r * ww.z, v[j].w * r * ww.w); o8[64 * j] = o; }
}
__device__ __forceinline__ void p0_prologue(Frame& F, const Params& p) {
    LAS float* scr = (LAS float*)(F.lds + RING_OFF + F.wave * 16384);
    const int gw = F.vcu * NWAVES + F.wave, NGW = F.G * NWAVES;
    unsigned char* ws = p.ws;
    bf16* Win_t = (bf16*)(ws + WS_WIN); bf16* Wout_t = (bf16*)(ws + WS_WOUT); bf16* Wgu_t = (bf16*)(ws + WS_WGU);
    constexpr int I_IN = (DM / 64) * (PROJ_W / 32), I_OUT = (DM / 64) * (DM / 32), I_G = (DM / 64) * (FF / 32);
    constexpr int NITEMS = I_IN + I_OUT + I_G;
    for (int it = gw; it < NITEMS; it += NGW) {
        int r = it;
        if (r < I_IN) { const int nb = r % (PROJ_W / 32), kb = r / (PROJ_W / 32); p0_transpose_item(p.in[7], DM, PROJ_W, Win_t, 64 * kb, 32 * nb, 32 * nb, scr, F.lane); continue; } r -= I_IN;
        if (r < I_OUT) { const int nb = r % (DM / 32), kb = r / (DM / 32); p0_transpose_item(p.in[13], DM, DM, Wout_t, 64 * kb, 32 * nb, 32 * nb, scr, F.lane); continue; } r -= I_OUT;
        { const int nb = r % (FF / 32), kb = r / (FF / 32), n0 = 32 * nb; p0_transpose_item(p.in[18], DM, FF, Wgu_t, 64 * kb, n0, 256 * (n0 >> 7) + (n0 & 127), scr, F.lane); }
    }
    { GAS v4u* z = (GAS v4u*)(Win_t + (size_t)PROJ_W * DM); const size_t n16 = (size_t)(PROJ_PAD - PROJ_W) * DM * 2 / 16;
      for (size_t i = (size_t)gw * 64 + F.lane; i < n16; i += (size_t)NGW * 64) z[i] = (v4u){0u, 0u, 0u, 0u}; }
    bf16* H = (bf16*)(ws + WS_H);
    for (int m = gw; m < MROWS; m += NGW) rms_row_to_bf16(x_row(p, m), p.in[14], H + (size_t)m * DM, F.lane);
}
__device__ __forceinline__ void w_down_convert(const Frame& F, const Params& p, int wi, int nw) {
    LAS float* scr = (LAS float*)(F.lds + RING_OFF + F.wave * 16384);
    bf16* Wdn_t = (bf16*)(p.ws + WS_WDN);
    constexpr int I_D = (FF / 64) * (DM / 32);
    for (int r = wi * NWAVES + F.wave; r < I_D; r += nw * NWAVES) { const int nb = r % (DM / 32), kb = r / (DM / 32); p0_transpose_item(p.in[20], FF, DM, Wdn_t, 64 * kb, 32 * nb, 32 * nb, scr, F.lane); }
}
__device__ __forceinline__ void w_up_convert(const Frame& F, const Params& p, int wi, int nw) {
    LAS float* scr = (LAS float*)(F.lds + RING_OFF + F.wave * 16384);
    bf16* Wgu_t = (bf16*)(p.ws + WS_WGU);
    constexpr int I_G = (DM / 64) * (FF / 32);
    for (int r = wi * NWAVES + F.wave; r < I_G; r += nw * NWAVES) { const int nb = r % (FF / 32), kb = r / (FF / 32), n0 = 32 * nb; p0_transpose_item(p.in[19], DM, FF, Wgu_t, 64 * kb, n0, 256 * (n0 >> 7) + 128 + (n0 & 127), scr, F.lane); }
}
__device__ __forceinline__ int rel_bucket_dev(int n) {
    if (n < 16) return n;
    int large = 16 + (int)(logf((float)n * 0.0625f) / 2.0794415416798357f * 16.0f);
    return large < 31 ? large : 31;
}
__device__ __forceinline__ f32x4 bf4_to_f32(v2u w) { return (f32x4){bflo(w.x), bfhi(w.x), bflo(w.y), bfhi(w.y)}; }
__device__ __forceinline__ void ph_copy_states(const Frame& F, const bf16* P, const float* ck, const float* cv, float* out) {
    const int gid = F.vcu * 512 + F.tid, gs = F.G * 512;
    for (int id = gid; id < NSB * 2 * 4 * 128; id += gs) { const int b = id >> 10, kv = (id >> 9) & 1, j = 124 + ((id >> 7) & 3), c4 = id & 127;
        ((f32x4*)(out + (kv ? O_SWV : O_SWK) + ((size_t)b * 128 + j) * 512))[c4] = bf4_to_f32(((const v2u*)(P + (size_t)(TP + 4 * b + (j - 124)) * PW + (kv ? C_VA : C_KA)))[c4]); }
    for (int id = gid; id < 2 * 128 * 128; id += gs) { const int kv = id >> 14, j = (id >> 7) & 127, c4 = id & 127;
        ((f32x4*)(out + (kv ? O_PWV : O_PWK) + (size_t)j * 512))[c4] = bf4_to_f32(((const v2u*)(P + (size_t)(TP - 128 + j) * PW + (kv ? C_VA : C_KA)))[c4]); }
    for (int id = gid; id < 3 * 1536; id += gs) { const int r = id / 1536, c4 = id - r * 1536;
        ((f32x4*)(out + O_PCONV + (size_t)r * 6144))[c4] = bf4_to_f32(((const v2u*)(P + (size_t)(TP - 3 + r) * PW + C_QKVG))[c4]); }
    for (int id = gid; id < NSB * 3 * 1536; id += gs) { const int br = id / 1536, c4 = id - br * 1536, b = br / 3, r = br - 3 * b;
        ((f32x4*)(out + O_SCONV + (size_t)br * 6144))[c4] = bf4_to_f32(((const v2u*)(P + (size_t)(TP + 4 * b + r + 1) * PW + C_QKVG))[c4]); }
}
__device__ __forceinline__ void copy_cache_rows(const Frame& F, const float* ck, const float* cv, float* out, int wi, int nw) {
    for (int id = wi * 512 + F.tid; id < NSB * 2 * 128 * 128; id += nw * 512) { const int b = id >> 15, kv = (id >> 14) & 1, j = (id >> 7) & 127, c4 = id & 127;
        if (j < 124) ((f32x4*)(out + (kv ? O_SWV : O_SWK) + ((size_t)b * 128 + j) * 512))[c4] = ((const f32x4*)((kv ? cv : ck) + ((size_t)b * 128 + j + 4) * 512))[c4]; }
}
__device__ __forceinline__ void ph_gated_norm(const Frame& F, const float* ORAW, const bf16* P, const float* gw, bf16* MIX, int row_lo, int row_hi) {
    const int lane = F.lane;
    const f32x4 g4 = ((const f32x4*)gw)[lane & 31];
    for (int row = row_lo + F.vcu * NWAVES + F.wave; row < row_hi; row += F.G * NWAVES) {
        f32x4 o[8]; v2u z[8];
#pragma unroll
        for (int i = 0; i < 8; ++i) { o[i] = ((const f32x4*)(ORAW + (size_t)row * 2048))[64 * i + lane]; z[i] = ((const v2u*)(P + (size_t)row * PW + C_ZG))[64 * i + lane]; }
#pragma unroll
        for (int i = 0; i < 8; ++i) {
            float ss = (o[i].x * o[i].x + o[i].y * o[i].y) + (o[i].z * o[i].z + o[i].w * o[i].w);
#pragma unroll
            for (int sh = 1; sh < 32; sh <<= 1) ss += __shfl_xor(ss, sh);
            const float r = rsqrtf(ss * (1.f / 128.f) + NORM_EPS); const f32x4 zz = bf4_to_f32(z[i]);
            v2u w; w.x = pk2(o[i].x * r * g4.x * silu_f(zz.x), o[i].y * r * g4.y * silu_f(zz.y)); w.y = pk2(o[i].z * r * g4.z * silu_f(zz.z), o[i].w * r * g4.w * silu_f(zz.w));
            ((v2u*)(MIX + (size_t)row * DM + 2048))[64 * i + lane] = w;
        }
    }
}
__device__ __forceinline__ void row_gemm_out(const bf16* C, const bf16* slab, int row, int lane, f32x4 (&v)[16]) {
    if (row < TP) { const v2u* cr = (const v2u*)(C + (size_t)row * DM) + lane; v2u w[16];
#pragma unroll
        for (int j = 0; j < 16; ++j) w[j] = cr[64 * j];
#pragma unroll
        for (int j = 0; j < 16; ++j) v[j] = bf4_to_f32(w[j]);
    } else { const v2u* s = (const v2u*)(slab + (size_t)(row - TP) * DM) + lane; constexpr size_t st = (size_t)NSB * NST * DM / 4;
#pragma unroll
        for (int j = 0; j < 16; ++j) { const v2u* q = s + 64 * j; v[j] = ((bf4_to_f32(q[0]) + bf4_to_f32(q[st])) + (bf4_to_f32(q[2 * st]) + bf4_to_f32(q[3 * st]))) + ((bf4_to_f32(q[4 * st]) + bf4_to_f32(q[5 * st])) + (bf4_to_f32(q[6 * st]) + bf4_to_f32(q[7 * st]))); }
    }
}
__device__ __forceinline__ void slab_rows_to_lds(const Frame& F, const bf16* slab) {
    LAS f32x4* srow = (LAS f32x4*)(F.lds + RING_OFF); constexpr size_t st = (size_t)NSB * NST * DM / 4;
    for (int idx = F.tid; idx < NWAVES * 1024; idx += NWAVES * 64) { const int w = idx >> 10, c = idx & 1023, sr = w * F.G + F.vcu;
        if (sr < NSB * NST) { const v2u* q = (const v2u*)(slab + (size_t)sr * DM) + c; v2u t[8];
#pragma unroll
            for (int k = 0; k < 8; ++k) t[k] = q[k * st];
            srow[idx] = ((bf4_to_f32(t[0]) + bf4_to_f32(t[1])) + (bf4_to_f32(t[2]) + bf4_to_f32(t[3]))) + ((bf4_to_f32(t[4]) + bf4_to_f32(t[5])) + (bf4_to_f32(t[6]) + bf4_to_f32(t[7]))); } }
    __syncthreads();
}
__device__ __forceinline__ void ph_postmix(const Frame& F, const Params& p, const bf16* MIXO, const bf16* SLAB, float* out, bf16* H) {
    const int lane = F.lane; const f32x4* w_post = (const f32x4*)p.in[15] + lane; const f32x4* w_pre = (const f32x4*)p.in[16] + lane;
    const int NGW = F.G * NWAVES, np = (TP + NGW - 1) / NGW, ns = (NSB * NST + NGW - 1) / NGW;
    const bool lds_rows = ns == 1; if (lds_rows) slab_rows_to_lds(F, SLAB);
    for (int it = 0; it < np + ns; ++it) {
        const int row = it < np ? F.vcu * NWAVES + F.wave + it * NGW : TP + F.wave * F.G + F.vcu + (it - np) * NGW;
        if (it < np ? row >= TP : row >= MROWS) continue;
        const f32x4* xr = (const f32x4*)x_row(p, row) + lane;
        f32x4 v[16], x[16];
#pragma unroll
        for (int j = 0; j < 16; ++j) x[j] = xr[64 * j];
        if (it >= np && lds_rows) {
#pragma unroll
            for (int j = 0; j < 16; ++j) v[j] = ((const LAS f32x4*)(F.lds + RING_OFF))[F.wave * 1024 + lane + 64 * j];
        } else row_gemm_out(MIXO, SLAB, row, lane, v);
        float s = 0.f;
#pragma unroll
        for (int j = 0; j < 16; ++j) s += (v[j].x * v[j].x + v[j].y * v[j].y) + (v[j].z * v[j].z + v[j].w * v[j].w);
        const float r = rsqrtf(wave_sum(s) * (1.f / DM) + NORM_EPS); float s2 = 0.f;
        f32x4* orow = (f32x4*)(out + (size_t)row * DM) + lane;
#pragma unroll
        for (int j = 0; j < 16; ++j) { const f32x4 w = w_post[64 * j];
            v[j].x = x[j].x + v[j].x * r * w.x; v[j].y = x[j].y + v[j].y * r * w.y; v[j].z = x[j].z + v[j].z * r * w.z; v[j].w = x[j].w + v[j].w * r * w.w;
            orow[64 * j] = v[j]; s2 += (v[j].x * v[j].x + v[j].y * v[j].y) + (v[j].z * v[j].z + v[j].w * v[j].w); }
        const float r2 = rsqrtf(wave_sum(s2) * (1.f / DM) + NORM_EPS);
        v2u* hrow = (v2u*)(H + (size_t)row * DM) + lane;
#pragma unroll
        for (int j = 0; j < 16; ++j) { const f32x4 w = w_pre[64 * j]; v2u o; o.x = pk2(v[j].x * r2 * w.x, v[j].y * r2 * w.y); o.y = pk2(v[j].z * r2 * w.z, v[j].w * r2 * w.w); hrow[64 * j] = o; }
    }
}
__device__ __forceinline__ void ph_final(const Frame& F, const bf16* FFNO, const bf16* SLAB, const float* w_post_, float* out) {
    const int lane = F.lane; const f32x4* w_post = (const f32x4*)w_post_ + lane;
    const int NGW = F.G * NWAVES, np = (TP + NGW - 1) / NGW, ns = (NSB * NST + NGW - 1) / NGW;
    const bool lds_rows = ns == 1; if (lds_rows) slab_rows_to_lds(F, SLAB);
    for (int it = 0; it < np + ns; ++it) {
        const int row = it < np ? F.vcu * NWAVES + F.wave + it * NGW : TP + F.wave * F.G + F.vcu + (it - np) * NGW;
        if (it < np ? row >= TP : row >= MROWS) continue;
        f32x4* orow = (f32x4*)(out + (size_t)row * DM) + lane;
        f32x4 v[16], x[16];
#pragma unroll
        for (int j = 0; j < 16; ++j) x[j] = orow[64 * j];
        if (it >= np && lds_rows) {
#pragma unroll
            for (int j = 0; j < 16; ++j) v[j] = ((const LAS f32x4*)(F.lds + RING_OFF))[F.wave * 1024 + lane + 64 * j];
        } else row_gemm_out(FFNO, SLAB, row, lane, v);
        float s = 0.f;
#pragma unroll
        for (int j = 0; j < 16; ++j) s += (v[j].x * v[j].x + v[j].y * v[j].y) + (v[j].z * v[j].z + v[j].w * v[j].w);
        const float r = rsqrtf(wave_sum(s) * (1.f / DM) + NORM_EPS);
#pragma unroll
        for (int j = 0; j < 16; ++j) { const f32x4 w = w_post[64 * j];
            orow[64 * j] = (f32x4){x[j].x + v[j].x * r * w.x, x[j].y + v[j].y * r * w.y, x[j].z + v[j].z * r * w.z, x[j].w + v[j].w * r * w.w}; }
    }
}
__device__ __forceinline__ unsigned off_b(unsigned row, unsigned ch) { return 256u * row + 16u * (ch ^ (((row & 3) << 2) | ((row >> 2) & 3))); }
__device__ __forceinline__ unsigned row_read_addr_16(unsigned lane, unsigned rb, unsigned s) { return off_b((lane & 15) + 16 * rb, 4 * s + (lane >> 4)); }
__device__ __forceinline__ unsigned tr_read_addr_16(unsigned lane, unsigned c, unsigned ks, unsigned t) {
    const unsigned g = lane >> 4, q = (lane & 15) >> 2, p = lane & 3;
    return off_b(32 * ks + 8 * g + 4 * t + q, 2 * c + (p >> 1)) + 8 * (p & 1);
}
typedef short s16x4 __attribute__((ext_vector_type(4)));
__device__ __forceinline__ unsigned lds_addr(const LAS unsigned char* p) { return (unsigned)(__UINTPTR_TYPE__)p; }
__device__ __forceinline__ s16x4 tr_read_wait(unsigned a) { s16x4 r; asm volatile("ds_read_b64_tr_b16 %0, %1\n\ts_waitcnt lgkmcnt(0)" : "=&v"(r) : "v"(a) : "memory"); return r; }
__device__ __forceinline__ bf16x8 tr_frag(unsigned base, unsigned lane, unsigned c, unsigned ks) {
    const s16x4 lo = tr_read_wait(base + tr_read_addr_16(lane, c, ks, 0)), hi = tr_read_wait(base + tr_read_addr_16(lane, c, ks, 1));
    return (bf16x8){lo[0], lo[1], lo[2], lo[3], hi[0], hi[1], hi[2], hi[3]};
}
__device__ __forceinline__ v4u pack8(const float* y) { v4u o; o.x = pg8::cvt_pk_bf16(y[0], y[1]); o.y = pg8::cvt_pk_bf16(y[2], y[3]); o.z = pg8::cvt_pk_bf16(y[4], y[5]); o.w = pg8::cvt_pk_bf16(y[6], y[7]); return o; }
struct ScanBufs { bf16* wF; bf16* kdF; bf16* qeF; bf16* qkF; float* uF; float* egl; unsigned char* vbg; bf16* snF; bf16* vnF; };
constexpr int PREP_B = 4;
constexpr int PA_SLOT = 17408;
constexpr int PA_IMG = PREP_B * PA_SLOT;
constexpr int PA_MSC = PA_IMG + 65536;
struct PrepIn { v4u xw[11]; f32x4 w0[4], w1[4]; float ga, gb; };
__device__ __forceinline__ void gdn_prep_issue(PrepIn& I, int un, int tid, const bf16* P, const float* AB, const float* conv_w) {
    const int h = un >> 7, n = un & 127, row0 = 64 * n, lane = tid & 63;
    const int part = (tid >> 7) < 3 ? (tid >> 7) : 2, tok0 = ((tid >> 4) & 7) * 8, cl = tid & 15, ch = part * 2048 + h * 128 + cl * 8;
#pragma unroll
    for (int k = 0; k < 11; ++k) { const int r = row0 + tok0 - 3 + k, rc = r < 0 ? 0 : r; I.xw[k] = *(const v4u*)(P + (size_t)rc * PW + C_QKVG + ch); }
#pragma unroll
    for (int i = 0; i < 4; ++i) { const float* wp = conv_w + (size_t)i * 6144 + ch; I.w0[i] = *(const f32x4*)wp; I.w1[i] = *(const f32x4*)(wp + 4); }
    I.ga = AB[(size_t)(row0 + lane) * 32 + h]; I.gb = AB[(size_t)(row0 + lane) * 32 + 16 + h];
}
__device__ __forceinline__ void gdn_prep_a(const Frame& F, int un, int slot, PrepIn& I, int un_next, const bf16* P, const float* AB, const float* conv_w, const float* a_log, const float* dt_bias, const ScanBufs sb) {
    constexpr int KIMG = PA_IMG, QIMG = PA_IMG + 16384, QEIMG = PA_IMG + 32768, KDIMG = PA_IMG + 49152, QKB = QIMG;
    LAS unsigned char* L = F.lds + RING_OFF;
    LAS float* gcs = (LAS float*)(L + PA_MSC); LAS float* bts = gcs + 64; LAS float* Af = (LAS float*)(L + slot * PA_SLOT);
    int zv = 0; asm volatile("" : "+v"(zv));
    const int tid = F.tid + zv, lane = tid & 63, wave = F.wave, quad = lane >> 4, l15 = lane & 15;
    const int h = un >> 7, n = un & 127, row0 = 64 * n;
    const int part = tid >> 7, tok0 = ((tid >> 4) & 7) * 8, cl = tid & 15, ch = part * 2048 + h * 128 + cl * 8;
    v4u xw[11]; f32x4 w0[4], w1[4];
    unsigned char* vbg = sb.vbg + (size_t)un * 32768;
    if (tid < 384) {
#pragma unroll
        for (int k = 0; k < 11; ++k) { const int r = row0 + tok0 - 3 + k; xw[k] = r < 0 ? (v4u){0u, 0u, 0u, 0u} : I.xw[k]; }
#pragma unroll
        for (int i = 0; i < 4; ++i) { w0[i] = I.w0[i]; w1[i] = I.w1[i]; }
    } else if (wave == 6) {
        const float a = I.ga, bb = I.gb;
        float g = -__expf(a_log[h]) * softplus_f(a + dt_bias[h]);
#pragma unroll
        for (int o = 1; o < 64; o <<= 1) { const float t = __shfl_up(g, o); if (lane >= o) g += t; }
        gcs[lane] = g; bts[lane] = sigmoid_f(bb);
    }
    LDS_BAR();
    const float glast = gcs[63];
    if (tid < 384) {
#pragma unroll
        for (int t = 0; t < 8; ++t) {
            const int tok = tok0 + t; float y[8];
#pragma unroll
            for (int e = 0; e < 8; ++e) y[e] = 0.f;
#pragma unroll
            for (int i = 0; i < 4; ++i) { const v4u w = xw[t + i];
                y[0] += bflo(w.x) * w0[i].x; y[1] += bfhi(w.x) * w0[i].y; y[2] += bflo(w.y) * w0[i].z; y[3] += bfhi(w.y) * w0[i].w;
                y[4] += bflo(w.z) * w1[i].x; y[5] += bfhi(w.z) * w1[i].y; y[6] += bflo(w.w) * w1[i].z; y[7] += bfhi(w.w) * w1[i].w; }
            float ss = 0.f;
#pragma unroll
            for (int e = 0; e < 8; ++e) { y[e] = silu_f(y[e]); ss += y[e] * y[e]; }
            const float gc = gcs[tok], be = bts[tok], egc = __expf(gc), ekd = __expf(glast - gc);
            const unsigned o = off_b(tok, cl); float t8[8];
            if (part < 2) {
                ss = sum16(ss);
                const float rn = rsqrtf(ss + NORM_EPS) * (part == 0 ? 0.08838834764831845f : 1.0f);
#pragma unroll
                for (int e = 0; e < 8; ++e) y[e] *= rn;
            }
            if (part == 0) {
                *(LAS v4u*)(L + QIMG + o) = pack8(y);
#pragma unroll
                for (int e = 0; e < 8; ++e) t8[e] = y[e] * egc;
                *(LAS v4u*)(L + QEIMG + o) = pack8(t8);
            } else if (part == 1) {
                *(LAS v4u*)(L + KIMG + o) = pack8(y);
#pragma unroll
                for (int e = 0; e < 8; ++e) t8[e] = y[e] * (be * egc);
                *(v4u*)(vbg + 16384 + o) = pack8(t8);
#pragma unroll
                for (int e = 0; e < 8; ++e) t8[e] = y[e] * ekd;
                *(LAS v4u*)(L + KDIMG + o) = pack8(t8);
            } else {
#pragma unroll
                for (int e = 0; e < 8; ++e) t8[e] = y[e] * be;
                *(v4u*)(vbg + o) = pack8(t8);
            }
        }
    }
    gdn_prep_issue(I, un_next, tid, P, AB, conv_w);
    LDS_BAR();
    f32x4 accj[3];
#pragma unroll
    for (int r = 0; r < 3; ++r) {
        const int job = wave + 8 * r; accj[r] = (f32x4){0.f, 0.f, 0.f, 0.f};
        if (job < 20) {
            const int idx = job < 10 ? job : job - 10, ti = idx >= 6 ? 3 : idx >= 3 ? 2 : idx >= 1 ? 1 : 0, tj = idx - ti * (ti + 1) / 2;
            const int aimg = job < 10 ? KIMG : QIMG;
            bf16x8 fa[4], fb[4];
#pragma unroll
            for (int s = 0; s < 4; ++s) { fa[s] = *(const LAS bf16x8*)(L + aimg + row_read_addr_16(lane, ti, s)); fb[s] = *(const LAS bf16x8*)(L + KIMG + row_read_addr_16(lane, tj, s)); }
            __builtin_amdgcn_sched_barrier(0);
#pragma unroll
            for (int s = 0; s < 4; ++s) accj[r] = __builtin_amdgcn_mfma_f32_16x16x32_bf16(fa[s], fb[s], accj[r], 0, 0, 0);
        }
    }
    LDS_BAR();
#pragma unroll
    for (int r = 0; r < 3; ++r) {
        const int job = wave + 8 * r;
        if (job < 20) {
            const int idx = job < 10 ? job : job - 10, ti = idx >= 6 ? 3 : idx >= 3 ? 2 : idx >= 1 ? 1 : 0, tj = idx - ti * (ti + 1) / 2;
            const int j = 16 * tj + l15; const float gj = gcs[j];
#pragma unroll
            for (int e = 0; e < 4; ++e) { const int i = 16 * ti + 4 * quad + e; const float dec = __expf(fminf(gcs[i] - gj, 0.f));
                if (job < 10) Af[i * 68 + j] = (i > j) ? bts[i] * accj[r][e] * dec : 0.f;
                else ((LAS bf16*)(L + QKB))[i * 72 + j] = (bf16)f2bf(accj[r][e] * dec); }
        }
    }
    LDS_BAR();
    {
        const unsigned base = lds_addr(L);
#pragma unroll 1
        for (int job = wave; job < 40; job += 8) {
            if (job < 16) { const int ti = job >> 2, s = job & 3;
                *(v4u*)(sb.qeF + ((size_t)(un * 16 + job) * 64 + lane) * 8) = *(const LAS v4u*)(L + QEIMG + row_read_addr_16(lane, ti, s)); }
            else if (job < 32) { const int f = job - 16, di = f >> 1, s2 = f & 1;
                const bf16x8 fr = tr_frag(base + KDIMG, lane, di, s2);
                *(bf16x8*)(sb.kdF + ((size_t)(un * 16 + f) * 64 + lane) * 8) = fr; }
            else { const int f = job - 32, ti = f >> 1, s2 = f & 1, i = 16 * ti + l15, j0 = 32 * s2 + 8 * quad;
                v4u w = *(const LAS v4u*)(L + QKB + i * 144 + j0 * 2);
                w.x = (j0 + 0 <= i ? w.x & 0xffffu : 0u) | (j0 + 1 <= i ? w.x & 0xffff0000u : 0u); w.y = (j0 + 2 <= i ? w.y & 0xffffu : 0u) | (j0 + 3 <= i ? w.y & 0xffff0000u : 0u);
                w.z = (j0 + 4 <= i ? w.z & 0xffffu : 0u) | (j0 + 5 <= i ? w.z & 0xffff0000u : 0u); w.w = (j0 + 6 <= i ? w.w & 0xffffu : 0u) | (j0 + 7 <= i ? w.w & 0xffff0000u : 0u);
                *(v4u*)(sb.qkF + ((size_t)(un * 8 + f) * 64 + lane) * 8) = w; }
        }
    }
    if (tid == 0) sb.egl[un] = __expf(glast);
    LDS_BAR();
}
__device__ __forceinline__ void gdn_prep_c(const Frame& F, int un, int slot, const ScanBufs sb) {
    constexpr int VBIMG = PA_IMG, KGIMG = PA_IMG + 16384, WT = PA_IMG + 32768;
    LAS unsigned char* L = F.lds + RING_OFF;
    int zv = 0; asm volatile("" : "+v"(zv));
    const int tid = F.tid + zv, lane = tid & 63, wave = F.wave, quad = lane >> 4, l15 = lane & 15;
    const unsigned char* vbg = sb.vbg + (size_t)un * 32768;
#pragma unroll
    for (int it = 0; it < 4; ++it) { const int o = (tid + 512 * it) * 16; *(LAS v4u*)(L + VBIMG + o) = *(const v4u*)(vbg + o); }
    LDS_BAR();
    {
        const int ti = wave & 3, which = wave >> 2; const unsigned base = lds_addr(L) + (which ? KGIMG : VBIMG);
        bf16x8 ta[2];
#pragma unroll
        for (int s2 = 0; s2 < 2; ++s2) ta[s2] = *(const LAS bf16x8*)(L + slot * PA_SLOT + (16 * ti + l15) * 144 + (32 * s2 + 8 * quad) * 2);
#pragma unroll 2
        for (int ct = 0; ct < 8; ++ct) {
            f32x4 acc = (f32x4){0.f, 0.f, 0.f, 0.f};
            { const unsigned a0 = base + tr_read_addr_16(lane, ct, 0, 0), a1 = base + tr_read_addr_16(lane, ct, 0, 1), a2 = base + tr_read_addr_16(lane, ct, 1, 0), a3 = base + tr_read_addr_16(lane, ct, 1, 1);
              s16x4 t0, t1, t2, t3;
              asm volatile("ds_read_b64_tr_b16 %0, %4\n\tds_read_b64_tr_b16 %1, %5\n\tds_read_b64_tr_b16 %2, %6\n\tds_read_b64_tr_b16 %3, %7\n\ts_waitcnt lgkmcnt(0)"
                           : "=&v"(t0), "=&v"(t1), "=&v"(t2), "=&v"(t3) : "v"(a0), "v"(a1), "v"(a2), "v"(a3) : "memory");
              acc = __builtin_amdgcn_mfma_f32_16x16x32_bf16(ta[0], (bf16x8){t0[0], t0[1], t0[2], t0[3], t1[0], t1[1], t1[2], t1[3]}, acc, 0, 0, 0);
              acc = __builtin_amdgcn_mfma_f32_16x16x32_bf16(ta[1], (bf16x8){t2[0], t2[1], t2[2], t2[3], t3[0], t3[1], t3[2], t3[3]}, acc, 0, 0, 0); }
            if (which == 0) *(f32x4*)(sb.uF + ((size_t)((un * 4 + ti) * 8 + ct) * 64 + lane) * 4) = acc;
            else {
#pragma unroll
                for (int e = 0; e < 4; ++e) ((LAS bf16*)(L + WT))[(16 * ti + 4 * quad + e) * 136 + 16 * ct + l15] = (bf16)f2bf(acc[e]); }
        }
    }
    LDS_BAR();
#pragma unroll
    for (int it = 0; it < 2; ++it) { const int idx = tid + 512 * it, fr = idx >> 6, ln = idx & 63, ti = fr >> 2, s = fr & 3;
        *(v4u*)(sb.wF + ((size_t)(un * 16 + fr) * 64 + ln) * 8) = *(const LAS v4u*)(L + WT + (16 * ti + (ln & 15)) * 272 + (32 * s + 8 * (ln >> 4)) * 2); }
    LDS_BAR();
}
__device__ __forceinline__ void gdn_prep_invert_blocked(const Frame& F, int nslots) {
    LAS unsigned char* L = F.lds + RING_OFF;
    int zv = 0; asm volatile("" : "+v"(zv));
    const int tid = F.tid + zv, lane = tid & 63, wave = F.wave, q = lane >> 4, l15 = lane & 15;
    if (wave < nslots) {
        const LAS float* Af = (const LAS float*)(L + wave * PA_SLOT); LAS float* Tf = (LAS float*)(L + PA_IMG + wave * 16384);
        float t[16];
#pragma unroll
        for (int i = 0; i < 16; ++i) {
            const LAS float* rp = Af + (16 * q + i) * 68 + 16 * q; f32x4 ar[4];
#pragma unroll
            for (int jb = 0; jb < 4; ++jb) if (4 * jb < i) ar[jb] = *(const LAS f32x4*)(rp + 4 * jb);
            float acc = (l15 == i) ? 1.f : 0.f;
#pragma unroll
            for (int j = 0; j < i; ++j) acc -= ar[j >> 2][j & 3] * t[j];
            t[i] = acc;
        }
#pragma unroll
        for (int i = 0; i < 16; ++i) Tf[(16 * q + i) * 64 + 16 * q + l15] = t[i];
    }
    LDS_BAR();
#pragma unroll
    for (int d = 1; d < 4; ++d) {
        const int per = 4 - d, total = nslots * per;
#pragma unroll 1
        for (int job = wave; job < total; job += NWAVES) {
            const int slot = job / per, b = job - slot * per, a = b + d;
            const LAS float* Af = (const LAS float*)(L + slot * PA_SLOT); LAS float* Tf = (LAS float*)(L + PA_IMG + slot * 16384);
            f32x4 acc = (f32x4){0.f, 0.f, 0.f, 0.f};
            float ta[4];
#pragma unroll
            for (int s4 = 0; s4 < 4; ++s4) ta[s4] = Tf[(16 * a + l15) * 64 + 16 * a + 4 * q + s4];
#pragma unroll
            for (int cc = 0; cc < 3; ++cc) if (cc < d) {
                const int c = b + cc; float la[4], tb[4];
#pragma unroll
                for (int s4 = 0; s4 < 4; ++s4) { la[s4] = Af[(16 * a + l15) * 68 + 16 * c + 4 * s4 + q]; tb[s4] = Tf[(16 * c + 4 * s4 + q) * 64 + 16 * b + l15]; }
                __builtin_amdgcn_sched_barrier(0);
#pragma unroll
                for (int s4 = 0; s4 < 4; ++s4) acc = __builtin_amdgcn_mfma_f32_16x16x4f32(la[s4], tb[s4], acc, 0, 0, 0); }
            f32x4 res = (f32x4){0.f, 0.f, 0.f, 0.f};
#pragma unroll
            for (int s4 = 0; s4 < 4; ++s4) res = __builtin_amdgcn_mfma_f32_16x16x4f32(-ta[s4], acc[s4], res, 0, 0, 0);
#pragma unroll
            for (int r = 0; r < 4; ++r) Tf[(16 * a + 4 * q + r) * 64 + 16 * b + l15] = res[r];
        }
        LDS_BAR();
    }
    for (int idx = tid; idx < nslots * 4096; idx += NWAVES * 64) { const int slot = idx >> 12, e = idx & 4095, i = e >> 6, c = e & 63;
        const float v = ((c >> 4) <= (i >> 4)) ? ((const LAS float*)(L + PA_IMG + slot * 16384))[e] : 0.f;
        ((LAS bf16*)(L + slot * PA_SLOT))[i * 72 + c] = (bf16)f2bf(v); }
    VM_WAIT();
    LDS_BAR();
}
__device__ __forceinline__ void gdn_prep_all(const Frame& F, const bf16* P, const float* AB, const float* conv_w, const float* a_log, const float* dt_bias, const ScanBufs sb) {
    PrepIn I{};
    if (F.vcu < NUNIT) gdn_prep_issue(I, F.vcu, F.tid, P, AB, conv_w);
#pragma unroll 1
    for (int u0 = F.vcu; u0 < NUNIT; u0 += F.G * PREP_B) {
#pragma unroll 1
        for (int s = 0; s < PREP_B; ++s) { const int un = u0 + s * F.G; const int nx = un + F.G < NUNIT ? un + F.G : un;
            if (un < NUNIT) gdn_prep_a(F, un, s, I, nx, P, AB, conv_w, a_log, dt_bias, sb); }
        { int ns = 0;
#pragma unroll
          for (int k = 0; k < PREP_B; ++k) ns += (u0 + k * F.G < NUNIT) ? 1 : 0;
          gdn_prep_invert_blocked(F, ns); }
#pragma unroll 1
        for (int s = 0; s < PREP_B; ++s) { const int un = u0 + s * F.G; if (un < NUNIT) gdn_prep_c(F, un, s, sb); }
    }
}
__device__ __forceinline__ unsigned cvt_pk_after_mfma(float lo, float hi) { unsigned r; asm volatile("s_nop 7\n\ts_nop 7\n\tv_cvt_pk_bf16_f32 %0, %1, %2" : "=v"(r) : "v"(lo), "v"(hi)); return r; }
constexpr int SCAN_D = 4;
__device__ __forceinline__ void gdn_scan_unit(const Frame& F, int h, int sl, const ScanBufs sb, float* Sout) {
    constexpr int SB_PITCH = 272, VN_PITCH = 144, SB_OFF = 0, VN_OFF = 16 * SB_PITCH;
    LAS unsigned char* L = F.lds + RING_OFF;
    const int lane = F.lane, wave = F.wave, quad = lane >> 4, l15 = lane & 15;
    for (int i = F.tid; i < (16 * SB_PITCH) / 4; i += NWAVES * 64) ((LAS unsigned*)(L + SB_OFF))[i] = 0u;
    __syncthreads();
    const LAS unsigned char* sfp = L + SB_OFF + l15 * SB_PITCH + quad * 16;
    const LAS unsigned char* vfp = L + VN_OFF + l15 * VN_PITCH + quad * 16;
    if (wave < 4) {
        const int ti = wave;
        f32x4 S0 = (f32x4){0.f, 0.f, 0.f, 0.f}, S1 = S0;
        bf16x8 wf[SCAN_D][4], kdf[SCAN_D][2][2]; f32x4 uf[SCAN_D]; float gl[SCAN_D];
#define LOAD_C(un_, W, KD, U, G) do { \
        _Pragma("unroll") for (int s = 0; s < 4; ++s) W[s] = *(const bf16x8*)(sb.wF + ((size_t)((un_) * 16 + ti * 4 + s) * 64 + lane) * 8); \
        _Pragma("unroll") for (int d = 0; d < 2; ++d) _Pragma("unroll") for (int s2 = 0; s2 < 2; ++s2) KD[d][s2] = *(const bf16x8*)(sb.kdF + ((size_t)((un_) * 16 + (2 * ti + d) * 2 + s2) * 64 + lane) * 8); \
        U = *(const f32x4*)(sb.uF + ((size_t)(((un_) * 4 + ti) * 8 + sl) * 64 + lane) * 4); G = sb.egl[un_]; } while (0)
#pragma unroll
        for (int k = 0; k < SCAN_D; ++k) LOAD_C(h * 128 + k, wf[k], kdf[k], uf[k], gl[k]);
#pragma unroll 1
        for (int n0 = 0; n0 < 128; n0 += SCAN_D) {
#pragma unroll
            for (int k = 0; k < SCAN_D; ++k) {
                bf16x8 sf[4];
#pragma unroll
                for (int s = 0; s < 4; ++s) sf[s] = *(const LAS bf16x8*)(sfp + s * 64);
                __builtin_amdgcn_sched_barrier(0);
                f32x4 acc = __builtin_amdgcn_mfma_f32_16x16x32_bf16(wf[k][0], sf[0], (f32x4){0.f, 0.f, 0.f, 0.f}, 0, 0, 0), acc2 = __builtin_amdgcn_mfma_f32_16x16x32_bf16(wf[k][1], sf[1], (f32x4){0.f, 0.f, 0.f, 0.f}, 0, 0, 0);
                acc = __builtin_amdgcn_mfma_f32_16x16x32_bf16(wf[k][2], sf[2], acc, 0, 0, 0); acc2 = __builtin_amdgcn_mfma_f32_16x16x32_bf16(wf[k][3], sf[3], acc2, 0, 0, 0);
                const f32x4 vn = uf[k] - (acc + acc2);
                { v2u w; w.x = pg8::cvt_pk_bf16(vn[0], vn[1]); w.y = pg8::cvt_pk_bf16(vn[2], vn[3]); *(LAS v2u*)(L + VN_OFF + l15 * VN_PITCH + (16 * ti + 4 * quad) * 2) = w; }
                LDS_BAR();
                S0 = S0 * gl[k]; S1 = S1 * gl[k];
                { const bf16x8 vf0 = *(const LAS bf16x8*)(vfp), vf1 = *(const LAS bf16x8*)(vfp + 64);
                  __builtin_amdgcn_sched_barrier(0);
                  S0 = __builtin_amdgcn_mfma_f32_16x16x32_bf16(kdf[k][0][0], vf0, S0, 0, 0, 0); S1 = __builtin_amdgcn_mfma_f32_16x16x32_bf16(kdf[k][1][0], vf0, S1, 0, 0, 0);
                  S0 = __builtin_amdgcn_mfma_f32_16x16x32_bf16(kdf[k][0][1], vf1, S0, 0, 0, 0); S1 = __builtin_amdgcn_mfma_f32_16x16x32_bf16(kdf[k][1][1], vf1, S1, 0, 0, 0); }
                { v2u w; w.x = cvt_pk_after_mfma(S0[0], S0[1]); w.y = pg8::cvt_pk_bf16(S0[2], S0[3]); *(LAS v2u*)(L + SB_OFF + l15 * SB_PITCH + (16 * (2 * ti) + 4 * quad) * 2) = w;
                  w.x = cvt_pk_after_mfma(S1[0], S1[1]); w.y = pg8::cvt_pk_bf16(S1[2], S1[3]); *(LAS v2u*)(L + SB_OFF + l15 * SB_PITCH + (16 * (2 * ti + 1) + 4 * quad) * 2) = w; }
                { const int nn = n0 + k + SCAN_D < 128 ? n0 + k + SCAN_D : 127; LOAD_C(h * 128 + nn, wf[k], kdf[k], uf[k], gl[k]); }
                LDS_BAR();
            }
        }
#undef LOAD_C
#pragma unroll
        for (int e = 0; e < 4; ++e) { Sout[((size_t)h * 128 + 16 * (2 * ti) + 4 * quad + e) * 128 + 16 * sl + l15] = S0[e]; Sout[((size_t)h * 128 + 16 * (2 * ti + 1) + 4 * quad + e) * 128 + 16 * sl + l15] = S1[e]; }
    } else {
        bf16* snp = sb.snF + ((size_t)(h * 128) * 8 + sl) * 2048 + lane * 8;
        bf16* vnp = sb.vnF + ((size_t)(h * 128) * 8 + sl) * 1024 + lane * 8;
#pragma unroll 1
        for (int n = 0; n < 128; ++n) {
            if (wave == 4) {
                bf16x8 sf[4];
#pragma unroll
                for (int s = 0; s < 4; ++s) sf[s] = *(const LAS bf16x8*)(sfp + s * 64);
#pragma unroll
                for (int s = 0; s < 4; ++s) *(bf16x8*)(snp + (size_t)n * 8 * 2048 + s * 512) = sf[s];
            }
            LDS_BAR();
            if (wave == 5) {
                const bf16x8 vf0 = *(const LAS bf16x8*)(vfp), vf1 = *(const LAS bf16x8*)(vfp + 64);
                *(bf16x8*)(vnp + (size_t)n * 8 * 1024) = vf0; *(bf16x8*)(vnp + (size_t)n * 8 * 1024 + 512) = vf1;
            }
            LDS_BAR();
        }
    }
    __syncthreads();
}
struct OIn { bf16x8 snf[4], vnf[2]; v4u qe[2], qk, z[2]; };
__device__ __forceinline__ void opass_load(OIn& I, int un, int tid, int lane, int sl, const ScanBufs sb, const bf16* P) {
    const int h = un >> 7, n = un & 127;
#pragma unroll
    for (int s = 0; s < 4; ++s) I.snf[s] = *(const bf16x8*)(sb.snF + ((size_t)(un * 8 + sl) * 4 + s) * 512 + lane * 8);
#pragma unroll
    for (int s2 = 0; s2 < 2; ++s2) I.vnf[s2] = *(const bf16x8*)(sb.vnF + ((size_t)(un * 8 + sl) * 2 + s2) * 512 + lane * 8);
#pragma unroll
    for (int it = 0; it < 2; ++it) { const int idx = tid + 512 * it, tok = idx >> 4, c = idx & 15;
        I.qe[it] = *(const v4u*)(sb.qeF + (size_t)un * 8192 + idx * 8);
        I.z[it] = *(const v4u*)(P + (size_t)(64 * n + tok) * PW + C_ZG + h * 128 + c * 8); }
    I.qk = *(const v4u*)(sb.qkF + (size_t)un * 4096 + tid * 8);
}
__device__ __forceinline__ void gdn_opass_units(const Frame& F, int u0, int ustride, const ScanBufs sb, const bf16* P, const float* gnw, bf16* MIX) {
    constexpr int QE_OFF = 0, QK_OFF = 16384, Z_OFF = 24576, SS_OFF = 40960, Y_OFF = 43264, Y_PITCH = 272;
    LAS unsigned char* L = F.lds + RING_OFF;
    const int tid = F.tid, lane = F.lane, sl = F.wave, quad = lane >> 4, l15 = lane & 15;
    const float gw = gnw[16 * sl + l15];
    LAS float* ssq = (LAS float*)(L + SS_OFF);
    OIn C{}, N{}, N2{};
    if (u0 < NUNIT) { opass_load(C, u0, tid, lane, sl, sb, P); opass_load(N, u0 + ustride < NUNIT ? u0 + ustride : u0, tid, lane, sl, sb, P); }
#pragma unroll 1
    for (int un = u0; un < NUNIT; un += ustride) {
        const int h = un >> 7, n = un & 127, nx = un + 2 * ustride < NUNIT ? un + 2 * ustride : un;
#pragma unroll
        for (int it = 0; it < 2; ++it) { const int idx = tid + 512 * it, tok = idx >> 4, c = idx & 15;
            *(LAS v4u*)(L + QE_OFF + idx * 16) = C.qe[it]; *(LAS v4u*)(L + Z_OFF + tok * 256 + c * 16) = C.z[it]; }
        *(LAS v4u*)(L + QK_OFF + tid * 16) = C.qk;
        LDS_BAR();
        opass_load(N2, nx, tid, lane, sl, sb, P);
        f32x4 acc[4];
#pragma unroll
        for (int ti = 0; ti < 4; ++ti) {
            bf16x8 a[6];
#pragma unroll
            for (int s = 0; s < 4; ++s) a[s] = *(const LAS bf16x8*)(L + QE_OFF + ((ti * 4 + s) * 64 + lane) * 16);
#pragma unroll
            for (int s2 = 0; s2 < 2; ++s2) a[4 + s2] = *(const LAS bf16x8*)(L + QK_OFF + ((ti * 2 + s2) * 64 + lane) * 16);
            __builtin_amdgcn_sched_barrier(0);
            f32x4 x = __builtin_amdgcn_mfma_f32_16x16x32_bf16(a[0], C.snf[0], (f32x4){0.f, 0.f, 0.f, 0.f}, 0, 0, 0), y = __builtin_amdgcn_mfma_f32_16x16x32_bf16(a[1], C.snf[1], (f32x4){0.f, 0.f, 0.f, 0.f}, 0, 0, 0);
            x = __builtin_amdgcn_mfma_f32_16x16x32_bf16(a[2], C.snf[2], x, 0, 0, 0); y = __builtin_amdgcn_mfma_f32_16x16x32_bf16(a[3], C.snf[3], y, 0, 0, 0);
            x = __builtin_amdgcn_mfma_f32_16x16x32_bf16(a[4], C.vnf[0], x, 0, 0, 0); y = __builtin_amdgcn_mfma_f32_16x16x32_bf16(a[5], C.vnf[1], y, 0, 0, 0);
            acc[ti] = x + y;
        }
#pragma unroll
        for (int ti = 0; ti < 4; ++ti)
#pragma unroll
            for (int r = 0; r < 4; ++r) { const float v = sum16(acc[ti][r] * acc[ti][r]); if (l15 == 0) ssq[(16 * ti + 4 * quad + r) * 8 + sl] = v; }
        LDS_BAR();
        if (tid < 64) {
            const f32x4 p0 = *(const LAS f32x4*)(ssq + tid * 8), p1 = *(const LAS f32x4*)(ssq + tid * 8 + 4);
            ssq[512 + tid] = rsqrtf((((p0.x + p0.y) + (p0.z + p0.w)) + ((p1.x + p1.y) + (p1.z + p1.w))) * (1.f / 128.f) + NORM_EPS); }
        LDS_BAR();
#pragma unroll
        for (int ti = 0; ti < 4; ++ti)
#pragma unroll
            for (int r = 0; r < 4; ++r) { const int tok = 16 * ti + 4 * quad + r;
                const float rs = ssq[512 + tok];
                const float z = bf2f(*(const LAS bf16*)(L + Z_OFF + tok * 256 + (16 * sl + l15) * 2));
                const float yv = acc[ti][r] * rs * gw * silu_f(z);
                *(LAS bf16*)(L + Y_OFF + tok * Y_PITCH + (16 * sl + l15) * 2) = (bf16)pg8::cvt_pk_bf16(yv, yv); }
        LDS_BAR();
#pragma unroll
        for (int it = 0; it < 2; ++it) { const int idx = tid + 512 * it, tok = idx >> 4, c = idx & 15;
            *(v4u*)(MIX + (size_t)(64 * n + tok) * DM + 2048 + h * 128 + c * 8) = *(const LAS v4u*)(L + Y_OFF + tok * Y_PITCH + c * 16); }
        LDS_BAR();
        C = N; N = N2;
    }
}
struct SampIn { f32x4 S[8]; float in[11]; float z0, z1; };
__device__ __forceinline__ void samp_load(SampIn& I, int u, int tid, int lane, int wave, const bf16* P, const float* AB, const float* state_conv, const float* conv_w, const float* a_log, const float* dt_bias, const float* S0p) {
    const int b = u >> 4, h = u & 15, rg = tid >> 5, jv = tid & 31;
#pragma unroll
    for (int i = 0; i < 8; ++i) I.S[i] = *(const f32x4*)(S0p + ((size_t)u * 128 + 8 * rg + i) * 128 + 4 * jv);
    const bool cv = tid < 384, gt = !cv && tid < 388;
    const int part = cv ? tid >> 7 : 0, ch = tid & 127, c = part * 2048 + h * 128 + ch;
    const size_t grow = (size_t)TP + 4 * b + (gt ? tid - 384 : 0);
    const float* f[7];
#pragma unroll
    for (int r = 0; r < 3; ++r) f[r] = state_conv + ((size_t)b * 3 + r) * 6144 + c;
#pragma unroll
    for (int i = 0; i < 4; ++i) f[3 + i] = conv_w + (size_t)i * 6144 + c;
    if (gt) { f[0] = AB + grow * 32 + h; f[1] = AB + grow * 32 + 16 + h; f[2] = a_log + h; f[3] = dt_bias + h; }
    I.in[0] = *f[0]; I.in[1] = *f[1]; I.in[2] = *f[2];
#pragma unroll
    for (int t = 0; t < 4; ++t) I.in[3 + t] = bf2f(P[(size_t)(TP + 4 * b + t) * PW + C_QKVG + c]);
    I.in[7] = *f[3]; I.in[8] = *f[4]; I.in[9] = *f[5]; I.in[10] = *f[6];
    const size_t zrow = (size_t)TP + 4 * b + (wave & 3); I.z0 = bf2f(P[zrow * PW + C_ZG + h * 128 + lane]); I.z1 = bf2f(P[zrow * PW + C_ZG + h * 128 + lane + 64]);
}
__device__ __forceinline__ void gdn_sample_units(const Frame& F, int u0, int ustride, const bf16* P, const float* AB, const float* state_conv, const float* conv_w, const float* a_log, const float* dt_bias,
                                                 const float* gnw, const float* S0p, float* Sout, bf16* MIX) {
    LAS float* xs = (LAS float*)(F.lds + RING_OFF);
    LAS float* gs = xs + 1536; LAS float* bs = gs + 4;
    LAS float* red = xs + 2048;
    LAS float* opart = red + 2048;
    const int tid = F.tid, lane = F.lane, wave = F.wave, rg = tid >> 5, jv = tid & 31;
    const float gn0 = gnw[lane], gn1 = gnw[lane + 64];
    SampIn C{}, N{};
    if (u0 < NSB * 16) samp_load(C, u0, tid, lane, wave, P, AB, state_conv, conv_w, a_log, dt_bias, S0p);
#pragma unroll 1
    for (int u = u0; u < NSB * 16; u += ustride) {
        const int b = u >> 4, h = u & 15, un = u + ustride < NSB * 16 ? u + ustride : u;
        if (tid < 384) {
            const int part = tid >> 7, ch = tid & 127;
#pragma unroll
            for (int t = 0; t < 4; ++t) xs[(part * 4 + t) * 128 + ch] = silu_f(C.in[t] * C.in[7] + C.in[t + 1] * C.in[8] + C.in[t + 2] * C.in[9] + C.in[t + 3] * C.in[10]);
        } else if (tid < 388) {
            const int t = tid - 384;
            gs[t] = __expf(-__expf(C.in[2]) * softplus_f(C.in[0] + C.in[7])); bs[t] = sigmoid_f(C.in[1]);
        }
        LDS_BAR();
        samp_load(N, un, tid, lane, wave, P, AB, state_conv, conv_w, a_log, dt_bias, S0p);
        { const int part = wave >> 2, t = wave & 3; LAS float* xv = xs + (part * 4 + t) * 128;
          const float v0 = xv[lane], v1 = xv[lane + 64];
          const float r = rsqrtf(wave_sum(v0 * v0 + v1 * v1) + NORM_EPS) * (part == 0 ? 0.08838834764831845f : 1.0f);
          xv[lane] = v0 * r; xv[lane + 64] = v1 * r; }
        LDS_BAR();
#pragma unroll
        for (int t = 0; t < 4; ++t) {
            const float a = gs[t], be = bs[t];
            const f32x4 k0 = *(const LAS f32x4*)(xs + (4 + t) * 128 + 8 * rg), k1 = *(const LAS f32x4*)(xs + (4 + t) * 128 + 8 * rg + 4);
            const f32x4 q0 = *(const LAS f32x4*)(xs + t * 128 + 8 * rg), q1 = *(const LAS f32x4*)(xs + t * 128 + 8 * rg + 4);
            const f32x4 v4 = *(const LAS f32x4*)(xs + (8 + t) * 128 + 4 * jv);
            f32x4 r4 = ((C.S[0] * k0.x + C.S[1] * k0.y) + (C.S[2] * k0.z + C.S[3] * k0.w)) + ((C.S[4] * k1.x + C.S[5] * k1.y) + (C.S[6] * k1.z + C.S[7] * k1.w));
            r4.x += __shfl_xor(r4.x, 32); r4.y += __shfl_xor(r4.y, 32); r4.z += __shfl_xor(r4.z, 32); r4.w += __shfl_xor(r4.w, 32);
            LAS f32x4* rb = (LAS f32x4*)(red + (t & 1) * 1024);
            if (lane < 32) rb[wave * 32 + jv] = r4;
            LDS_BAR();
            f32x4 rs = (rb[jv] + rb[32 + jv]) + (rb[64 + jv] + rb[96 + jv]); rs = rs + ((rb[128 + jv] + rb[160 + jv]) + (rb[192 + jv] + rb[224 + jv]));
            const f32x4 cvv = (v4 - rs * a) * be;
            const float kk[8] = {k0.x, k0.y, k0.z, k0.w, k1.x, k1.y, k1.z, k1.w}, qq[8] = {q0.x, q0.y, q0.z, q0.w, q1.x, q1.y, q1.z, q1.w};
            f32x4 o4 = (f32x4){0.f, 0.f, 0.f, 0.f};
#pragma unroll
            for (int i = 0; i < 8; ++i) { C.S[i] = C.S[i] * a + cvv * kk[i]; o4 = o4 + C.S[i] * qq[i]; }
            o4.x += __shfl_xor(o4.x, 32); o4.y += __shfl_xor(o4.y, 32); o4.z += __shfl_xor(o4.z, 32); o4.w += __shfl_xor(o4.w, 32);
            if (lane < 32) ((LAS f32x4*)(opart + (t * 8 + wave) * 128))[jv] = o4;
        }
#pragma unroll
        for (int i = 0; i < 8; ++i) *(f32x4*)(Sout + ((size_t)u * 128 + 8 * rg + i) * 128 + 4 * jv) = C.S[i];
        LDS_BAR();
        if (wave < 4) { const int t = wave; const size_t row = (size_t)TP + 4 * b + t;
            float o0 = 0.f, o1 = 0.f;
#pragma unroll
            for (int w = 0; w < 8; ++w) { o0 += opart[(t * 8 + w) * 128 + lane]; o1 += opart[(t * 8 + w) * 128 + lane + 64]; }
            const float r = rsqrtf(wave_sum(o0 * o0 + o1 * o1) * (1.f / 128.f) + NORM_EPS);
            MIX[row * DM + 2048 + h * 128 + lane] = (bf16)f2bf(o0 * r * gn0 * silu_f(C.z0));
            MIX[row * DM + 2048 + h * 128 + lane + 64] = (bf16)f2bf(o1 * r * gn1 * silu_f(C.z1)); }
        LDS_BAR();
        C = N;
    }
}
constexpr int ATT_KIMG = 0, ATT_VIMG = 69632, ATT_IMG_ROWS = 272;
constexpr int ATT_BTAB_OFF = MISC_OFF + 128;
__device__ __forceinline__ void attn_load_q(bf16x8 (&qf)[4], const bf16* qptr, int lane) {
#pragma unroll
    for (int s = 0; s < 4; ++s) qf[s] = *(const bf16x8*)(qptr + 32 * s + 8 * (lane >> 4));
}
__device__ __forceinline__ void attn_tile(LAS unsigned char* L, const LAS float* btab, const bf16x8 (&qf)[4], int kt0, int dist0, int jlo, int jhi, float sink, int g, bf16* optr, int lane) {
    const int quad = lane >> 4, l15 = lane & 15;
    f32x4 sc[9];
    bf16x8 kf[2][4];
#pragma unroll
    for (int s = 0; s < 4; ++s) kf[0][s] = *(const LAS bf16x8*)(L + ATT_KIMG + row_read_addr_16(lane, kt0, s));
#pragma unroll
    for (int i = 0; i < 9; ++i) {
        if (i + 1 < 9) {
#pragma unroll
            for (int s = 0; s < 4; ++s) kf[(i + 1) & 1][s] = *(const LAS bf16x8*)(L + ATT_KIMG + row_read_addr_16(lane, kt0 + i + 1, s)); }
        __builtin_amdgcn_sched_barrier(0);
        f32x4 a0 = __builtin_amdgcn_mfma_f32_16x16x32_bf16(kf[i & 1][0], qf[0], (f32x4){0.f, 0.f, 0.f, 0.f}, 0, 0, 0), a1 = __builtin_amdgcn_mfma_f32_16x16x32_bf16(kf[i & 1][1], qf[1], (f32x4){0.f, 0.f, 0.f, 0.f}, 0, 0, 0);
        a0 = __builtin_amdgcn_mfma_f32_16x16x32_bf16(kf[i & 1][2], qf[2], a0, 0, 0, 0); a1 = __builtin_amdgcn_mfma_f32_16x16x32_bf16(kf[i & 1][3], qf[3], a1, 0, 0, 0);
        sc[i] = a0 + a1;
        __builtin_amdgcn_sched_barrier(0);
    }
    float m = sink;
    const bool interior_free = (jlo <= 16 * (kt0 + 1)) && (jhi >= 16 * (kt0 + 8));
#pragma unroll
    for (int i = 0; i < 9; ++i) {
        if (i >= 1 && i <= 7 && interior_free) {
#pragma unroll
            for (int r = 0; r < 4; ++r) { const float v = sc[i][r] * 0.08838834764831845f + btab[g * 132 + dist0 - 16 * i - r]; sc[i][r] = v; m = fmaxf(m, v); }
        } else {
#pragma unroll
            for (int r = 0; r < 4; ++r) { const int dist = dist0 - 16 * i - r, j = 16 * (kt0 + i) + 4 * quad + r; const bool ok = dist >= 0 && dist <= 128 && j >= jlo && j < jhi;
                const float b = btab[g * 132 + (ok ? dist : 0)]; const float v = ok ? sc[i][r] * 0.08838834764831845f + b : -3.0e38f; sc[i][r] = v; m = fmaxf(m, v); }
        }
    }
    m = fmaxf(m, __shfl_xor(m, 16)); m = fmaxf(m, __shfl_xor(m, 32));
    float sum = 0.f;
#pragma unroll
    for (int i = 0; i < 9; ++i)
#pragma unroll
        for (int r = 0; r < 4; ++r) { const float pv = sc[i][r] > -1.0e38f ? __expf(sc[i][r] - m) : 0.f; sc[i][r] = pv; sum += pv; }
    sum += __shfl_xor(sum, 16); sum += __shfl_xor(sum, 32);
    const float inv = __builtin_amdgcn_rcpf(sum + __expf(sink - m));
    bf16x8 pf[5];
#pragma unroll
    for (int p = 0; p < 5; ++p) {
        const f32x4 a = sc[2 * p] * inv; const f32x4 b = (p < 4) ? sc[2 * p + 1 < 9 ? 2 * p + 1 : 8] * inv : (f32x4){0.f, 0.f, 0.f, 0.f};
        pf[p] = __builtin_bit_cast(bf16x8, (v4u){pg8::cvt_pk_bf16(a[0], a[1]), pg8::cvt_pk_bf16(a[2], a[3]), pg8::cvt_pk_bf16(b[0], b[1]), pg8::cvt_pk_bf16(b[2], b[3])});
    }
    const unsigned vbase = lds_addr(L) + ATT_VIMG; const unsigned q4 = (unsigned)l15 >> 2, p2 = (unsigned)lane & 3;
    const unsigned vrow = 16u * (unsigned)kt0 + 4u * (unsigned)quad + q4;
#pragma unroll
    for (int c = 0; c < 8; ++c) {
        const unsigned va = vbase + off_b(vrow, 2 * c + (p2 >> 1)) + 8 * (p2 & 1);
        s16x4 t0, t1, t2, t3, t4, t5, t6, t7, t8, t9;
        asm volatile("ds_read_b64_tr_b16 %0, %10\n\tds_read_b64_tr_b16 %1, %10 offset:4096\n\tds_read_b64_tr_b16 %2, %10 offset:8192\n\tds_read_b64_tr_b16 %3, %10 offset:12288\n\t"
                     "ds_read_b64_tr_b16 %4, %10 offset:16384\n\tds_read_b64_tr_b16 %5, %10 offset:20480\n\tds_read_b64_tr_b16 %6, %10 offset:24576\n\tds_read_b64_tr_b16 %7, %10 offset:28672\n\t"
                     "ds_read_b64_tr_b16 %8, %10 offset:32768\n\tds_read_b64_tr_b16 %9, %10 offset:36864\n\ts_waitcnt lgkmcnt(0)"
                     : "=&v"(t0), "=&v"(t1), "=&v"(t2), "=&v"(t3), "=&v"(t4), "=&v"(t5), "=&v"(t6), "=&v"(t7), "=&v"(t8), "=&v"(t9) : "v"(va) : "memory");
        f32x4 o = (f32x4){0.f, 0.f, 0.f, 0.f};
        o = __builtin_amdgcn_mfma_f32_16x16x32_bf16((bf16x8){t0[0], t0[1], t0[2], t0[3], t1[0], t1[1], t1[2], t1[3]}, pf[0], o, 0, 0, 0);
        o = __builtin_amdgcn_mfma_f32_16x16x32_bf16((bf16x8){t2[0], t2[1], t2[2], t2[3], t3[0], t3[1], t3[2], t3[3]}, pf[1], o, 0, 0, 0);
        o = __builtin_amdgcn_mfma_f32_16x16x32_bf16((bf16x8){t4[0], t4[1], t4[2], t4[3], t5[0], t5[1], t5[2], t5[3]}, pf[2], o, 0, 0, 0);
        o = __builtin_amdgcn_mfma_f32_16x16x32_bf16((bf16x8){t6[0], t6[1], t6[2], t6[3], t7[0], t7[1], t7[2], t7[3]}, pf[3], o, 0, 0, 0);
        o = __builtin_amdgcn_mfma_f32_16x16x32_bf16((bf16x8){t8[0], t8[1], t8[2], t8[3], t9[0], t9[1], t9[2], t9[3]}, pf[4], o, 0, 0, 0);
        v2u w; w.x = pk2(o[0], o[1]); w.y = pk2(o[2], o[3]);
        *(v2u*)(optr + 16 * c + 4 * quad) = w;
    }
}
__device__ __forceinline__ void attn_btab(const Frame& F, const float* rel_bias, int kvh) {
    LAS float* btab = (LAS float*)(F.lds + ATT_BTAB_OFF);
    for (int t = F.tid; t < 4 * 129; t += NWAVES * 64) { const int g = t / 129, d = t - g * 129; btab[g * 132 + d] = rel_bias[rel_bucket_dev(d) * 16 + kvh * 4 + g]; }
}
__device__ __forceinline__ void attn_prompt_unit(const Frame& F, int qb, int kvh, const bf16* P, const float* rel_bias, const float* sinks, bf16* MIX) {
    LAS unsigned char* L = F.lds + RING_OFF;
    const int tid = F.tid, lane = F.lane, wave = F.wave;
    attn_btab(F, rel_bias, kvh);
    const int krow0 = 128 * (qb - 1);
    {
        v4u kv[8], vv[8];
#pragma unroll
        for (int it = 0; it < 8; ++it) { const int cid = tid + 512 * it, row = cid >> 4, ch = cid & 15, gr = krow0 + row, gc = gr < 0 ? 0 : gr;
            kv[it] = *(const v4u*)(P + (size_t)gc * PW + C_KA + kvh * 128 + ch * 8); vv[it] = *(const v4u*)(P + (size_t)gc * PW + C_VA + kvh * 128 + ch * 8); }
#pragma unroll
        for (int it = 0; it < 8; ++it) { const int cid = tid + 512 * it, row = cid >> 4, ch = cid & 15; const bool ok = krow0 + row >= 0;
            *(LAS v4u*)(L + ATT_KIMG + off_b(row, ch)) = ok ? kv[it] : (v4u){0u, 0u, 0u, 0u}; *(LAS v4u*)(L + ATT_VIMG + off_b(row, ch)) = ok ? vv[it] : (v4u){0u, 0u, 0u, 0u}; }
    }
    if (tid < 256) { const int row = 256 + (tid >> 4), ch = tid & 15; *(LAS v4u*)(L + ATT_VIMG + off_b(row, ch)) = (v4u){0u, 0u, 0u, 0u}; *(LAS v4u*)(L + ATT_KIMG + off_b(row, ch)) = (v4u){0u, 0u, 0u, 0u}; }
    __syncthreads();
    const LAS float* btab = (const LAS float*)(F.lds + ATT_BTAB_OFF);
    const int quad = lane >> 4, l15 = lane & 15, g = wave >> 1, h = kvh * 4 + g; const float sink = sinks[h];
    bf16x8 qf[4], qn[4];
    attn_load_q(qf, P + (size_t)(128 * qb + 16 * ((wave & 1) * 4) + l15) * PW + C_QA + h * 128, lane);
#pragma unroll 1
    for (int k = 0; k < 4; ++k) { const int qt = (wave & 1) * 4 + k, row = 128 * qb + 16 * qt + l15;
        attn_load_q(qn, P + (size_t)(row + (k < 3 ? 16 : 0)) * PW + C_QA + h * 128, lane);
        attn_tile(L, btab, qf, qt, 128 + l15 - 4 * quad, qb == 0 ? 128 : 0, 256, sink, g, MIX + (size_t)row * DM + h * 128, lane);
#pragma unroll
        for (int s = 0; s < 4; ++s) qf[s] = qn[s]; }
    __syncthreads();
}
__device__ __forceinline__ void attn_sample_unit(const Frame& F, int b, int kvh, const bf16* P, const float* ck, const float* cv, const float* rel_bias, const float* sinks, bf16* MIX) {
    LAS unsigned char* L = F.lds + RING_OFF;
    const int tid = F.tid, lane = F.lane, wave = F.wave;
    attn_btab(F, rel_bias, kvh);
    {
        f32x4 c0[4], c1[4];
#pragma unroll
        for (int kv = 0; kv < 2; ++kv) {
            const float* src = kv ? cv : ck; const int img = kv ? ATT_VIMG : ATT_KIMG;
#pragma unroll
            for (int it = 0; it < 4; ++it) { const int cid = tid + 512 * it, row = cid >> 4, ch = cid & 15; const float* kp = src + ((size_t)(b * 128 + row) * 4 + kvh) * 128 + ch * 8;
                c0[it] = *(const f32x4*)kp; c1[it] = *(const f32x4*)(kp + 4); }
#pragma unroll
            for (int it = 0; it < 4; ++it) { const int cid = tid + 512 * it, row = cid >> 4, ch = cid & 15;
                *(LAS v4u*)(L + img + off_b(row, ch)) = (v4u){pk2(c0[it].x, c0[it].y), pk2(c0[it].z, c0[it].w), pk2(c1[it].x, c1[it].y), pk2(c1[it].z, c1[it].w)}; }
        }
        { const int cid = tid + 2048, row = cid >> 4, ch = cid & 15;
          v4u kv = (v4u){0u, 0u, 0u, 0u}, vv = kv;
          if (row < 132) { const size_t gr = (size_t)TP + 4 * b + (row - 128); kv = *(const v4u*)(P + gr * PW + C_KA + kvh * 128 + ch * 8); vv = *(const v4u*)(P + gr * PW + C_VA + kvh * 128 + ch * 8); }
          *(LAS v4u*)(L + ATT_KIMG + off_b(row, ch)) = kv; *(LAS v4u*)(L + ATT_VIMG + off_b(row, ch)) = vv; }
    }
    __syncthreads();
    if (wave == 0) {
        const LAS float* btab = (const LAS float*)(F.lds + ATT_BTAB_OFF);
        const int quad = lane >> 4, l15 = lane & 15, g = l15 >> 2, t = l15 & 3, h = kvh * 4 + g, row = TP + 4 * b + t;
        bf16x8 qf[4]; attn_load_q(qf, P + (size_t)row * PW + C_QA + h * 128, lane);
        attn_tile(L, btab, qf, 0, 128 + t - 4 * quad, 0, 132, sinks[h], g, MIX + (size_t)row * DM + h * 128, lane);
    }
    __syncthreads();
}
constexpr int N_PHASES = 10;
__global__ void __launch_bounds__(NWAVES * 64, 2) mega_fwd(Params p) {
    extern __shared__ __attribute__((aligned(16))) unsigned char lds[];
    Frame F;
    F.lds = (LAS unsigned char*)lds;
    F.MISC = (volatile LAS unsigned*)(F.lds + MISC_OFF);
    F.tid = threadIdx.x; F.lane = F.tid & 63; F.wave = __builtin_amdgcn_readfirstlane(F.tid >> 6);
    F.G = gridDim.x; { const int bx = blockIdx.x; F.vcu = (F.G % 8 == 0) ? (bx % 8) * (F.G / 8) + bx / 8 : bx; }
    unsigned char* ws = p.ws;
    F.ctl = (gu32*)(ws + WS_CTL);
    for (int u = F.tid; u < (LDS_BYTES - LDSCTL_OFF) / 4; u += NWAVES * 64) ((LAS unsigned*)(F.lds + LDSCTL_OFF))[u] = 0u;
    __syncthreads();
    XcdBarrier bar = xcd_barrier_post((unsigned*)(F.ctl + CW_BAR) + p.li * XCD_BAR_WORDS, F.MISC + 8);
    const int lo = p.ph_lo, hi = p.ph_hi;
#define IN(k) (lo <= (k) && (k) < hi)
#define BOTH(k) (IN(k) && IN((k) + 1))
#define GRID_BAR() xcd_barrier(bar)
#ifdef PROBE_A
    unsigned long long* stamps = (unsigned long long*)(p.ws + WS_QN);
#define STAMP(id) do { if (F.tid == 0) stamps[(size_t)blockIdx.x * 64 + (id)] = wall_clock64(); } while (0)
#else
#define STAMP(id) do {} while (0)
#endif
    STAMP(0);
    bf16* Win_t = (bf16*)(ws + WS_WIN); bf16* Wout_t = (bf16*)(ws + WS_WOUT); bf16* Wgu_t = (bf16*)(ws + WS_WGU); bf16* Wdn_t = (bf16*)(ws + WS_WDN);
    bf16* H = (bf16*)(ws + WS_H); bf16* MIX = (bf16*)(ws + WS_MIX); bf16* P = (bf16*)(ws + WS_P); bf16* ACT = (bf16*)(ws + WS_ACT);
    float* AB = (float*)(ws + WS_AB); bf16* MIXO = (bf16*)(ws + WS_MIXO); bf16* FFNO = (bf16*)(ws + WS_FFNO);
    bf16* SLAB = (bf16*)(ws + WS_VBG);
    const ScanBufs sb{(bf16*)(ws + WS_WF), (bf16*)(ws + WS_KDF), (bf16*)(ws + WS_QEF), (bf16*)(ws + WS_QKF), (float*)(ws + WS_UF), (float*)(ws + WS_EGL), ws + WS_VBG, (bf16*)(ws + WS_SNF), (bf16*)(ws + WS_VNF)};
    float* out = p.out;

    if (IN(0)) { p0_prologue(F, p); STAMP(1); if (BOTH(0)) GRID_BAR(); STAMP(2); }
    if (IN(1)) {
        pg8::Gemm g{H, Win_t, MROWS, PROJ_PAD, DM}; pg8::StaticOrder S; S.init(MROWS, PROJ_PAD, DM, F.G, (int)blockIdx.x);
        pg8::EpiProj E{P, AB, PW};
        pg8::gemm_phase<pg8::EpiProj, pg8::StaticOrder, true, true>(F.lds + RING_OFF, g, S, E);
        STAMP(3); if (BOTH(1)) GRID_BAR(); STAMP(4);
    }
    if (IN(2)) {
        if (p.pad & 1) ph_copy_states(F, P, p.in[2], p.in[3], out);
        STAMP(5);
        if (p.pad & 2) gdn_sample_units(F, F.vcu, F.G, P, AB, p.in[4], p.in[9], p.in[10], p.in[11], p.in[12], p.in[5], out + O_SGDN, MIX);
        STAMP(6);
        if (p.pad & 4) gdn_prep_all(F, P, AB, p.in[9], p.in[10], p.in[11], sb);
        STAMP(7); if (BOTH(2)) GRID_BAR(); STAMP(8);
    }
    if (IN(3)) {
        if (F.G == 256) {
            const int xcd = F.vcu >> 5, r = F.vcu & 31;
            if (r < 16) gdn_scan_unit(F, xcd * 2 + (r >> 3), r & 7, sb, out + O_PGDN);
            else { const int aw = xcd * 16 + (r - 16);
                for (int u = aw; u < 256; u += 128) attn_prompt_unit(F, u >> 2, u & 3, P, p.in[6], p.in[8], MIX);
                for (int u = aw; u < 512; u += 128) attn_sample_unit(F, u >> 2, u & 3, P, p.in[2], p.in[3], p.in[6], p.in[8], MIX);
                STAMP(24);
                w_up_convert(F, p, aw, 128); }
        } else {
            for (int su = F.vcu; su < 128; su += F.G) gdn_scan_unit(F, su >> 3, su & 7, sb, out + O_PGDN);
            for (int u = F.vcu; u < 256; u += F.G) attn_prompt_unit(F, u >> 2, u & 3, P, p.in[6], p.in[8], MIX);
            for (int u = F.vcu; u < 512; u += F.G) attn_sample_unit(F, u >> 2, u & 3, P, p.in[2], p.in[3], p.in[6], p.in[8], MIX);
            w_up_convert(F, p, F.vcu, F.G);
        }
        STAMP(9); if (BOTH(3)) GRID_BAR(); STAMP(10);
    }
    if (IN(4)) { gdn_opass_units(F, F.vcu, F.G, sb, P, p.in[12], MIX); STAMP(11); if (BOTH(4)) GRID_BAR(); STAMP(12); }
    if (IN(5)) {
        pg8::Gemm g{MIX, Wout_t, MROWS, DM, DM}; pg8::SplitTailOrder S; S.init(TP, NSB * NST, DM, DM, F.G, (int)blockIdx.x);
        pg8::EpiBfSlab E{MIXO, DM, SLAB, TP / 256, DM / 64, (size_t)NSB * NST * DM};
        pg8::gemm_phase<pg8::EpiBfSlab, pg8::SplitTailOrder, true, true>(F.lds + RING_OFF, g, S, E);
        STAMP(13); if (BOTH(5)) GRID_BAR(); STAMP(14);
    }
    if (IN(6)) { ph_postmix(F, p, MIXO, SLAB, out, H); STAMP(15); if (BOTH(6)) GRID_BAR(); STAMP(16); }
    if (IN(7)) {
        pg8::Gemm g{H, Wgu_t, MROWS, NGU, DM}; pg8::StaticOrder S; S.init(MROWS, NGU, DM, F.G, (int)blockIdx.x);
        pg8::EpiSwiGLU E{ACT, FF};
        pg8::gemm_phase<pg8::EpiSwiGLU, pg8::StaticOrder, true, true>(F.lds + RING_OFF, g, S, E);
        STAMP(17);
        { const int n12 = S.nwg % F.G, c = (int)blockIdx.x;
          if (n12 == 0) { w_down_convert(F, p, c, F.G); copy_cache_rows(F, p.in[2], p.in[3], out, c, F.G); }
          else if (c >= n12) { w_down_convert(F, p, c - n12, F.G - n12); copy_cache_rows(F, p.in[2], p.in[3], out, c - n12, F.G - n12); } }
        STAMP(18); if (BOTH(7)) GRID_BAR(); STAMP(19);
    }
    if (IN(8)) {
        pg8::Gemm g{ACT, Wdn_t, MROWS, DM, FF}; pg8::SplitTailOrder S; S.init(TP, NSB * NST, DM, FF, F.G, (int)blockIdx.x);
        pg8::EpiBfSlab E{FFNO, DM, SLAB, TP / 256, FF / 64, (size_t)NSB * NST * DM};
        pg8::gemm_phase<pg8::EpiBfSlab, pg8::SplitTailOrder, true, true>(F.lds + RING_OFF, g, S, E);
        STAMP(20); if (BOTH(8)) GRID_BAR(); STAMP(21);
    }
    if (IN(9)) ph_final(F, FFNO, SLAB, p.in[17], out);
#ifdef PROBE_A
    STAMP(22); GRID_BAR(); STAMP(23);
    if (blockIdx.x == 0 && F.tid == 0) {
        double acc = (PROBE_MODE == 2) ? 1e30 : 0.0; int cnt = 0;
        for (int b = 0; b < (int)gridDim.x; ++b) {
            const int vb = (gridDim.x % 8 == 0) ? (b % 8) * ((int)gridDim.x / 8) + b / 8 : b; const bool scanb = (vb & 31) < 16;
            if (PROBE_MODE == 0 && b != 0) continue; if (PROBE_MODE == 3 && !scanb) continue; if (PROBE_MODE == 4 && scanb) continue;
            const double d = (double)(long long)(stamps[(size_t)b * 64 + PROBE_B] - stamps[(size_t)b * 64 + PROBE_A]) * 0.01;
            if (PROBE_MODE == 2) acc = d < acc ? d : acc; else if (PROBE_MODE == 5) acc += d; else acc = d > acc ? d : acc; ++cnt; }
        if (PROBE_MODE == 5) acc /= cnt;
        out[O_SWK] = p.in[2][4 * 512] + (float)(acc / PROBE_DIV); }
#endif
#undef IN
#undef BOTH
#undef GRID_BAR
}
#ifndef MK_N_LAUNCHES
#define MK_N_LAUNCHES 1
#endif
extern "C" void kernel_launch(void* const* d_in, const int* in_sizes, int n_in, void* d_out, int out_size, void* d_ws, size_t ws_size, hipStream_t stream) {
    static int grid = 0;
    if (grid == 0) {
        if (n_in != 21 || out_size != (int)O_TOTAL || ws_size < WS_END) { fprintf(stderr, "kernel_launch: unexpected shapes (n_in %d, out %d, ws %zu < %zu)\n", n_in, out_size, ws_size, (size_t)WS_END); grid = -1; return; }
        int dev = 0, cus = 0;
        if (hipGetDevice(&dev) != hipSuccess || hipDeviceGetAttribute(&cus, hipDeviceAttributeMultiprocessorCount, dev) != hipSuccess) { grid = -1; return; }
        if (hipFuncSetAttribute((const void*)mega_fwd, hipFuncAttributeMaxDynamicSharedMemorySize, LDS_BYTES) != hipSuccess) { fprintf(stderr, "kernel_launch: hipFuncSetAttribute failed\n"); grid = -1; return; }
        int per_cu = 0; (void)hipOccupancyMaxActiveBlocksPerMultiprocessor(&per_cu, (const void*)mega_fwd, NWAVES * 64, LDS_BYTES); (void)hipGetLastError();
        grid = cus;
    }
    if (grid < 0) return;
    Params p{};
    for (int i = 0; i < 21; ++i) p.in[i] = (const float*)d_in[i];
    p.out = (float*)d_out; p.ws = (unsigned char*)d_ws;
#ifdef MK_PLAN
    const int plan[][3] = {MK_PLAN};
#else
    const int plan[][3] = {{0, N_PHASES, 7}};
#endif
    constexpr int nplan = (int)(sizeof(plan) / sizeof(plan[0]));
    static_assert((size_t)(CW_BAR + nplan * XCD_BAR_WORDS) * 4 <= CTL_ZERO_BYTES, "barrier words inside the control region");
    (void)hipMemsetAsync((char*)d_ws + WS_CTL, 0, (size_t)(CW_BAR + nplan * XCD_BAR_WORDS) * 4, stream);
    for (int li = 0; li < (int)(sizeof(plan) / sizeof(plan[0])); ++li) { p.ph_lo = plan[li][0]; p.ph_hi = plan[li][1]; p.li = li; p.pad = plan[li][2];
        hipLaunchKernelGGL(mega_fwd, dim3(grid), dim3(NWAVES * 64), LDS_BYTES, stream, p); }
}
```

```cpp
#include <hip/hip_runtime.h>
#include <cstdio>
#include <cstdint>
namespace pg8 {
#define PG8_LAS __attribute__((address_space(3)))
typedef unsigned short bf16_t;
typedef short bf16x8 __attribute__((ext_vector_type(8)));
typedef float f32x4 __attribute__((ext_vector_type(4)));
typedef unsigned u32x4 __attribute__((ext_vector_type(4)));
constexpr int BM = 256, BK = 64, HALF = 128, HTB = HALF * BK * 2  , STAGE_BYTES = 8 * HTB, NXCD = 8, WGM = 8;

__host__ __device__ __forceinline__ int lds_byte(int r, int c) { const int st = (r >> 4) * 2 + (c >> 5), rr = r & 15, cc = c & 31, ob = rr * 64 + cc * 2; return st * 1024 + (ob ^ (((ob >> 9) & 1) << 5)); }
__host__ __device__ __forceinline__ void stage_rc(int b, int& R, int& C) { const int st = b / 1024, sb = b % 1024, swz = sb ^ (((sb >> 9) & 1) << 5); R = (st >> 1) * 16 + swz / 64; C = (st & 1) * 32 + (swz % 64) / 2; }
__host__ __device__ __forceinline__ int perm32(int rho) { const int n = rho >> 4, i = rho & 15; return 8 * (i >> 2) + 4 * n + (i & 3); }

struct Unit { int pm, pn, k0, nk; };
struct Gemm { const bf16_t* A; const bf16_t* Bt; int M, N, K; };

struct StaticOrder {
    int nM, nN, nwg, G, c, ntf;
    __host__ __device__ void init(int M, int N, int K, int G_, int c_) { nM = M / BM; nN = N / BM; nwg = nM * nN; G = G_; c = c_; ntf = K / BK; }
    __host__ __device__ bool next(int i, Unit& u) const {
        const long L = (long)i * G + c; if (L >= nwg) return false;
        int wgid = (int)L; { const int q = nwg / NXCD, r = nwg % NXCD, xcd = wgid % NXCD, off = wgid / NXCD; wgid = (xcd < r ? xcd * (q + 1) : r * (q + 1) + (xcd - r) * q) + off; }
        const int nig = WGM * nN, gid = wgid / nig, fm = gid * WGM, gsz = (nM - fm) < WGM ? (nM - fm) : WGM;
        u.pm = fm + ((wgid % nig) % gsz); u.pn = (wgid % nig) / gsz; u.k0 = 0; u.nk = ntf; return true;
    }
    __device__ __forceinline__ void a_ready(const Unit&) const {}
    __device__ __forceinline__ void done(const Unit&) const {}
};
struct SplitTailOrder {
    StaticOrder base; int mp, ntail_items;
    __host__ __device__ void init(int Mprompt, int Msample, int N, int K, int G_, int c_) { base.init(Mprompt, N, K, G_, c_); mp = Mprompt / BM; ntail_items = (Msample / BM) * (N / BM) * 8; }
    __host__ __device__ bool next(int i, Unit& u) const {
        Unit t; t.pm = 0; t.pn = 0; t.k0 = 0; t.nk = base.ntf; const bool full = base.next(i, t);
        const int nb = (base.nwg - base.c + base.G - 1) / base.G;
        const int item = (i - nb) * base.G + base.c; const bool tail = !full && i >= nb && item < ntail_items;
        const int tt = item >> 3, sp = item & 7, per = (base.ntf / 16) * 2, rem = (base.ntf - 8 * per) / 2;
        u.pm = full ? t.pm : mp + tt / base.nN; u.pn = full ? t.pn : tt % base.nN; u.nk = full ? t.nk : per + (sp < rem ? 2 : 0); u.k0 = full ? 0 : sp * per + 2 * (sp < rem ? sp : rem);
        return full || tail;
    }
    __device__ __forceinline__ void a_ready(const Unit&) const {}
    __device__ __forceinline__ void done(const Unit&) const {}
};
__device__ __forceinline__ unsigned cvt_pk_bf16(float lo, float hi) { unsigned r; asm volatile("v_cvt_pk_bf16_f32 %0, %1, %2" : "=v"(r) : "v"(lo), "v"(hi)); return r; }
typedef float f32x2 __attribute__((ext_vector_type(2)));
__device__ __forceinline__ float silu_f(float x) { return x * __builtin_amdgcn_rcpf(1.0f + __expf(-x)); }
struct EpiProj {
    static constexpr bool PERM = true, AFTER_DRAIN = false;
    bf16_t* P; float* AB; int ldp;
    __device__ __forceinline__ void operator()(const f32x4 (&acc)[2][2][4][2], const Unit& u, int wr, int wc, int fr, int fq) const {
        const int row0 = u.pm * BM + wr * 64 + fr;
        if (u.pn < 44) {
            const int col0 = u.pn * BM + wc * 32 + 8 * fq;
#pragma unroll
            for (int ai = 0; ai < 2; ++ai)
#pragma unroll
                for (int m = 0; m < 4; ++m) { bf16_t* rowp = P + (size_t)(row0 + ai * HALF + m * 16) * ldp + col0;
#pragma unroll
                    for (int bj = 0; bj < 2; ++bj) { const f32x4 v0 = acc[ai][bj][m][0], v1 = acc[ai][bj][m][1];
                        u32x4 w; w.x = cvt_pk_bf16(v0[0], v0[1]); w.y = cvt_pk_bf16(v0[2], v0[3]); w.z = cvt_pk_bf16(v1[0], v1[1]); w.w = cvt_pk_bf16(v1[2], v1[3]);
                        *(u32x4*)(rowp + bj * HALF) = w; } }
        } else if (wc == 0) {
#pragma unroll
            for (int ai = 0; ai < 2; ++ai)
#pragma unroll
                for (int m = 0; m < 4; ++m) { float* rp = AB + (size_t)(row0 + ai * HALF + m * 16) * 32 + 8 * fq;
                    *(f32x4*)(rp) = acc[ai][0][m][0]; *(f32x4*)(rp + 4) = acc[ai][0][m][1]; }
        }
    }
};
struct EpiBfSlab {
    static constexpr bool PERM = true, AFTER_DRAIN = false;
    bf16_t* C; int ldc; bf16_t* slab; int mp, ntf; size_t slab_stride;
    __device__ __forceinline__ void operator()(const f32x4 (&acc)[2][2][4][2], const Unit& u, int wr, int wc, int fr, int fq) const {
        const int col0 = u.pn * BM + wc * 32 + 8 * fq, row0 = u.pm * BM + wr * 64 + fr;
        if (u.nk == ntf) {
#pragma unroll
            for (int ai = 0; ai < 2; ++ai)
#pragma unroll
                for (int m = 0; m < 4; ++m) { bf16_t* rowp = C + (size_t)(row0 + ai * HALF + m * 16) * ldc + col0;
#pragma unroll
                    for (int bj = 0; bj < 2; ++bj) { const f32x4 v0 = acc[ai][bj][m][0], v1 = acc[ai][bj][m][1];
                        u32x4 w; w.x = cvt_pk_bf16(v0[0], v0[1]); w.y = cvt_pk_bf16(v0[2], v0[3]); w.z = cvt_pk_bf16(v1[0], v1[1]); w.w = cvt_pk_bf16(v1[2], v1[3]);
                        *(u32x4*)(rowp + bj * HALF) = w; } }
        } else {
            const int per = (ntf / 16) * 2, rem = (ntf - 8 * per) / 2; const int sp = u.k0 < rem * (per + 2) ? u.k0 / (per + 2) : rem + (u.k0 - rem * (per + 2)) / per;
            bf16_t* Cb = slab + (size_t)sp * slab_stride; const int r0 = row0 - mp * BM;
#pragma unroll
            for (int ai = 0; ai < 2; ++ai)
#pragma unroll
                for (int m = 0; m < 4; ++m) { bf16_t* rowp = Cb + (size_t)(r0 + ai * HALF + m * 16) * ldc + col0;
#pragma unroll
                    for (int bj = 0; bj < 2; ++bj) { const f32x4 v0 = acc[ai][bj][m][0], v1 = acc[ai][bj][m][1];
                        u32x4 w; w.x = cvt_pk_bf16(v0[0], v0[1]); w.y = cvt_pk_bf16(v0[2], v0[3]); w.z = cvt_pk_bf16(v1[0], v1[1]); w.w = cvt_pk_bf16(v1[2], v1[3]);
                        *(u32x4*)(rowp + bj * HALF) = w; } }
        }
    }
};
struct EpiSwiGLU {
    static constexpr bool PERM = true, AFTER_DRAIN = false;
    bf16_t* O; int ldc;
    __device__ __forceinline__ void operator()(const f32x4 (&acc)[2][2][4][2], const Unit& u, int wr, int wc, int fr, int fq) const {
        const int row0 = u.pm * BM + wr * 64 + fr, col0 = u.pn * HALF + wc * 32 + 8 * fq;
#pragma unroll
        for (int ai = 0; ai < 2; ++ai)
#pragma unroll
            for (int m = 0; m < 4; ++m) { bf16_t* rowp = O + (size_t)(row0 + ai * HALF + m * 16) * ldc + col0;
                const f32x4 g0 = acc[ai][0][m][0], g1 = acc[ai][0][m][1], u0 = acc[ai][1][m][0], u1 = acc[ai][1][m][1];
                u32x4 w; w.x = cvt_pk_bf16(silu_f(g0[0]) * u0[0], silu_f(g0[1]) * u0[1]); w.y = cvt_pk_bf16(silu_f(g0[2]) * u0[2], silu_f(g0[3]) * u0[3]);
                w.z = cvt_pk_bf16(silu_f(g1[0]) * u1[0], silu_f(g1[1]) * u1[1]); w.w = cvt_pk_bf16(silu_f(g1[2]) * u1[2], silu_f(g1[3]) * u1[3]);
                *(u32x4*)rowp = w; }
    }
};
template <class Epi, class Sched, bool ALIGN_EPI = false, bool SP2 = false>
__device__ __forceinline__ void gemm_phase(PG8_LAS unsigned char* lds, const Gemm g, const Sched& S, const Epi& E) {
    const int tid = threadIdx.x, wid = __builtin_amdgcn_readfirstlane(tid >> 6), lane = tid & 63, wr = wid >> 2, wc = wid & 3, fr = lane & 15, fq = lane >> 4;
    const int K = g.K;
    unsigned voffA[2], voffB[2];
#pragma unroll
    for (int i = 0; i < 2; ++i) { int R, C; stage_rc(tid * 16 + i * 8192, R, C); const int Rb = Epi::PERM ? ((R & ~31) + perm32(R & 31)) : R;
        voffA[i] = (unsigned)(R * K + C) * 2u; voffB[i] = (unsigned)(Rb * K + C) * 2u; }
    const size_t kstep = (size_t)(BK * 2);
    const size_t hstep = (size_t)HALF * K * 2;
    const size_t tstep = 2 * hstep;
    const unsigned ldsw = (unsigned)wid * 1024u;
    const int aoff = lds_byte(wr * 64 + fr, fq * 8), boff = lds_byte(wc * 32 + fr, fq * 8);
#define PG8_SA(b, h) (((b) * 2 + (h)) * HTB)
#define PG8_SB(b, h) ((4 + (b) * 2 + (h)) * HTB)
#define PG8_STAGE(bufoff, gbase, voff) do { _Pragma("unroll") for (int _i = 0; _i < 2; ++_i) \
        __builtin_amdgcn_global_load_lds((const unsigned*)((const char*)(gbase) + (voff)[_i]), (PG8_LAS unsigned*)(lds + (bufoff) + ldsw + _i * 8192), 16, 0, 0); } while (0)
#define PG8_LDA(dst, b, h) do { _Pragma("unroll") for (int m = 0; m < 4; ++m) _Pragma("unroll") for (int k = 0; k < 2; ++k) dst[m][k] = *(const PG8_LAS bf16x8*)(lds + PG8_SA(b, h) + aoff + m * 2048 + k * 1024); } while (0)
#define PG8_LDB(dst, b, h) do { _Pragma("unroll") for (int n = 0; n < 2; ++n) _Pragma("unroll") for (int k = 0; k < 2; ++k) dst[n][k] = *(const PG8_LAS bf16x8*)(lds + PG8_SB(b, h) + boff + n * 2048 + k * 1024); } while (0)
#define PG8_MMA(ai, bj, At, Bt) do { __builtin_amdgcn_s_setprio(1); _Pragma("unroll") for (int m = 0; m < 4; ++m) _Pragma("unroll") for (int n = 0; n < 2; ++n) _Pragma("unroll") for (int k = 0; k < 2; ++k) \
        acc[ai][bj][m][n] = __builtin_amdgcn_mfma_f32_16x16x32_bf16(Bt[n][k], At[m][k], acc[ai][bj][m][n], 0, 0, 0); __builtin_amdgcn_s_setprio(0); } while (0)
#define PG8_WAIT_V(n) asm volatile("s_waitcnt vmcnt(" #n ")" ::: "memory")
#define PG8_WAIT_L(n) asm volatile("s_waitcnt lgkmcnt(" #n ")" ::: "memory")
#define PG8_BAR __builtin_amdgcn_s_barrier()
#define PG8_SCHED __builtin_amdgcn_sched_barrier(0)
    Unit cur, nxt; int ui = 0;
    if (!S.next(0, cur)) return;
    f32x4 acc[2][2][4][2];
#pragma unroll
    for (int a = 0; a < 2; ++a)
#pragma unroll
        for (int b = 0; b < 2; ++b)
#pragma unroll
            for (int m = 0; m < 4; ++m)
#pragma unroll
                for (int n = 0; n < 2; ++n) acc[a][b][m][n] = (f32x4){0.f, 0.f, 0.f, 0.f};
    bf16x8 At[4][2], B0[2][2], B1[2][2];
    const char* cA = (const char*)g.A + (size_t)cur.pm * tstep + (size_t)cur.k0 * (BK * 2); const char* cB = (const char*)g.Bt + (size_t)cur.pn * tstep + (size_t)cur.k0 * (BK * 2);
    S.a_ready(cur);
    if constexpr (SP2) {
        PG8_STAGE(PG8_SB(0, 0), cB, voffB); PG8_STAGE(PG8_SB(0, 1), cB + hstep, voffB); PG8_STAGE(PG8_SA(0, 0), cA, voffA); PG8_STAGE(PG8_SA(0, 1), cA + hstep, voffA);
        if (wr == 1) PG8_BAR;
        PG8_WAIT_V(2); PG8_BAR;
        PG8_STAGE(PG8_SB(1, 0), cB + kstep, voffB); PG8_STAGE(PG8_SA(1, 0), cA + kstep, voffA); PG8_STAGE(PG8_SB(1, 1), cB + hstep + kstep, voffB);
        PG8_WAIT_V(6); PG8_BAR;
    } else {
        PG8_STAGE(PG8_SB(0, 0), cB, voffB); PG8_STAGE(PG8_SA(0, 0), cA, voffA); PG8_STAGE(PG8_SB(0, 1), cB + hstep, voffB); PG8_STAGE(PG8_SA(0, 1), cA + hstep, voffA);
        if (wr == 1) PG8_BAR;
        PG8_WAIT_V(4); PG8_BAR;
        PG8_STAGE(PG8_SB(1, 0), cB + kstep, voffB); PG8_STAGE(PG8_SA(1, 0), cA + kstep, voffA); PG8_STAGE(PG8_SB(1, 1), cB + hstep + kstep, voffB);
        PG8_WAIT_V(6); PG8_BAR;
    }
    for (;;) {
        const bool has_next = S.next(ui + 1, nxt);
        const char* nA = has_next ? (const char*)g.A + (size_t)nxt.pm * tstep + (size_t)nxt.k0 * (BK * 2) : cA; const char* nB = has_next ? (const char*)g.Bt + (size_t)nxt.pn * tstep + (size_t)nxt.k0 * (BK * 2) : cB;
        const int nt = cur.nk;
        for (int t = 0; t < nt; t += 2) {
            const bool last = (t == nt - 2);
            const char* a1 = cA + (size_t)(t + 1) * kstep;
            const char* a2 = last ? nA : cA + (size_t)(t + 2) * kstep; const char* b2 = last ? nB : cB + (size_t)(t + 2) * kstep;
            const char* a3 = a2 + kstep; const char* b3 = b2 + kstep;
            if (last && has_next) S.a_ready(nxt);
            if constexpr (SP2) {
            PG8_LDB(B0, 0, 0); PG8_LDB(B1, 0, 1); PG8_SCHED; PG8_LDA(At, 0, 0); PG8_STAGE(PG8_SA(1, 1), a1 + hstep, voffA);
            PG8_WAIT_V(8); PG8_WAIT_L(0); PG8_BAR; PG8_MMA(0, 0, At, B0); PG8_MMA(0, 1, At, B1); PG8_BAR; PG8_SCHED;
            PG8_LDA(At, 0, 1); PG8_STAGE(PG8_SB(0, 0), b2, voffB); PG8_STAGE(PG8_SB(0, 1), b2 + hstep, voffB); PG8_STAGE(PG8_SA(0, 0), a2, voffA);
            PG8_WAIT_V(8); PG8_WAIT_L(0); PG8_BAR; PG8_MMA(1, 0, At, B0); PG8_MMA(1, 1, At, B1); PG8_BAR; PG8_SCHED;
            PG8_LDB(B0, 1, 0); PG8_LDB(B1, 1, 1); PG8_SCHED; PG8_LDA(At, 1, 0); PG8_STAGE(PG8_SA(0, 1), a2 + hstep, voffA);
            PG8_WAIT_V(8); PG8_WAIT_L(0); PG8_BAR; PG8_MMA(0, 0, At, B0); PG8_MMA(0, 1, At, B1); PG8_BAR; PG8_SCHED;
            PG8_LDA(At, 1, 1); PG8_STAGE(PG8_SB(1, 0), b3, voffB); PG8_STAGE(PG8_SB(1, 1), b3 + hstep, voffB); PG8_STAGE(PG8_SA(1, 0), a3, voffA);
            PG8_WAIT_V(8); PG8_WAIT_L(0); PG8_BAR; PG8_MMA(1, 0, At, B0); PG8_MMA(1, 1, At, B1); PG8_BAR; PG8_SCHED;
            } else {
            PG8_LDB(B0, 0, 0); PG8_SCHED; PG8_LDA(At, 0, 0); PG8_STAGE(PG8_SA(1, 1), a1 + hstep, voffA);
            PG8_WAIT_L(8); PG8_BAR; PG8_WAIT_L(0); PG8_MMA(0, 0, At, B0); PG8_BAR; PG8_SCHED;
            PG8_LDB(B1, 0, 1); PG8_STAGE(PG8_SB(0, 0), b2, voffB);
            PG8_BAR; PG8_WAIT_L(0); PG8_MMA(0, 1, At, B1); PG8_BAR;
            PG8_LDA(At, 0, 1); PG8_STAGE(PG8_SA(0, 0), a2, voffA);
            PG8_BAR; PG8_WAIT_L(0); PG8_MMA(1, 0, At, B0); PG8_BAR; PG8_SCHED;
            PG8_STAGE(PG8_SB(0, 1), b2 + hstep, voffB);
            PG8_WAIT_V(6); PG8_BAR; PG8_MMA(1, 1, At, B1); PG8_BAR;
            PG8_LDB(B0, 1, 0); PG8_SCHED; PG8_LDA(At, 1, 0); PG8_STAGE(PG8_SA(0, 1), a2 + hstep, voffA);
            PG8_WAIT_L(8); PG8_BAR; PG8_WAIT_L(0); PG8_MMA(0, 0, At, B0); PG8_BAR; PG8_SCHED;
            PG8_LDB(B1, 1, 1); PG8_STAGE(PG8_SB(1, 0), b3, voffB);
            PG8_BAR; PG8_WAIT_L(0); PG8_MMA(0, 1, At, B1); PG8_BAR;
            PG8_LDA(At, 1, 1); PG8_STAGE(PG8_SA(1, 0), a3, voffA);
            PG8_BAR; PG8_WAIT_L(0); PG8_MMA(1, 0, At, B0); PG8_BAR; PG8_SCHED;
            PG8_STAGE(PG8_SB(1, 1), b3 + hstep, voffB);
            PG8_WAIT_V(6); PG8_BAR; PG8_MMA(1, 1, At, B1); PG8_BAR;
            }
        }
        if constexpr (ALIGN_EPI) { if (wr == 0) PG8_BAR; }
        if constexpr (!Epi::AFTER_DRAIN) { E(acc, cur, wr, wc, fr, fq); S.done(cur); }
        if (!has_next) break;
#pragma unroll
        for (int a = 0; a < 2; ++a)
#pragma unroll
            for (int b = 0; b < 2; ++b)
#pragma unroll
                for (int m = 0; m < 4; ++m)
#pragma unroll
                    for (int n = 0; n < 2; ++n) acc[a][b][m][n] = (f32x4){0.f, 0.f, 0.f, 0.f};
        cur = nxt; cA = nA; cB = nB; ++ui;
        if constexpr (ALIGN_EPI) { if (wr == 1) PG8_BAR; }
    }
    PG8_WAIT_V(0);
    if constexpr (!ALIGN_EPI) { if (wr == 0) PG8_BAR; }
    PG8_BAR;
    if constexpr (Epi::AFTER_DRAIN) { E.fused(acc, cur, wr, wc, fr, fq, lds, wid, lane); S.done(cur); }
#undef PG8_SA
#undef PG8_SB
#undef PG8_STAGE
#undef PG8_LDA
#undef PG8_LDB
#undef PG8_MMA
#undef PG8_WAIT_V
#undef PG8_WAIT_L
#undef PG8_BAR
#undef PG8_SCHED
}
}
constexpr int NWAVES = 8;
constexpr int DM = 4096, TP = 8192, NSB = 128, NST = 4, MROWS = TP + NSB * NST;
constexpr int PROJ_W = 11296, PROJ_PAD = 11520, PW = 11264;
constexpr int C_QA = 0, C_KA = 2048, C_VA = 2560, C_QKVG = 3072, C_ZG = 9216;
constexpr int FF = 11008, NGU = 2 * FF;
constexpr float NORM_EPS = 1e-6f;
constexpr size_t O_YP = 0, O_YS = 33554432, O_PWK = 35651584, O_PWV = 35717120, O_PCONV = 35782656, O_PGDN = 35801088,
                 O_SWK = 36063232, O_SWV = 44451840, O_SCONV = 52840448, O_SGDN = 55199744, O_TOTAL = 88754176;
constexpr size_t WS_CTL = 0, CTL_ZERO_BYTES = 1u << 20;
constexpr size_t WS_WIN = CTL_ZERO_BYTES;
constexpr size_t WS_WOUT = WS_WIN + (size_t)PROJ_PAD * DM * 2;
constexpr size_t WS_WGU = WS_WOUT + (size_t)DM * DM * 2;
constexpr size_t WS_WDN = WS_WGU + (size_t)NGU * DM * 2;
constexpr size_t WS_H = WS_WDN + (size_t)DM * FF * 2;
constexpr size_t WS_MIX = WS_H + (size_t)MROWS * DM * 2;
constexpr size_t WS_FFNO = WS_H;
constexpr size_t WS_P = WS_MIX + (size_t)MROWS * DM * 2;
constexpr size_t WS_MIXO = WS_P;
constexpr size_t WS_ACT = WS_P;
constexpr size_t WS_AB = WS_P + (size_t)MROWS * PW * 2;
constexpr size_t WS_QN = WS_AB + (size_t)MROWS * 32 * 4;
constexpr size_t WS_KN = WS_QN + (size_t)NSB * NST * 2048 * 4;
constexpr size_t WS_VN = WS_KN + (size_t)NSB * NST * 2048 * 4;
constexpr size_t WS_GB = WS_VN + (size_t)NSB * NST * 2048 * 4;
constexpr size_t WS_ORAW = WS_GB + (size_t)MROWS * 32 * 4;
constexpr int NUNIT = 16 * 128;
constexpr size_t WS_WF = WS_ORAW + (size_t)MROWS * 2048 * 4;
constexpr size_t WS_KDF = WS_WF + (size_t)NUNIT * 16384;
constexpr size_t WS_QEF = WS_KDF + (size_t)NUNIT * 16384;
constexpr size_t WS_QKF = WS_QEF + (size_t)NUNIT * 16384;
constexpr size_t WS_UF = WS_QKF + (size_t)NUNIT * 8192;
constexpr size_t WS_EGL = WS_UF + (size_t)NUNIT * 32768;
constexpr size_t WS_VBG = WS_EGL + (size_t)NUNIT * 4;
constexpr size_t WS_VNF = WS_VBG + (size_t)NUNIT * 32768;
constexpr size_t WS_END = WS_VNF + (size_t)NUNIT * 16384;
constexpr size_t WS_SNF = WS_ORAW;
static_assert((size_t)MROWS * DM * 4 <= 2 * (size_t)MROWS * DM * 2 && (size_t)MROWS * FF * 2 <= (size_t)MROWS * PW * 2, "overlays");
constexpr int CW_TMO = 0, CW_CODE = 1, CW_BAR = 4096;
constexpr int RING_OFF = 0, RING_BYTES = 139264;
constexpr int LDSCTL_OFF = RING_BYTES, MISC_OFF = LDSCTL_OFF + 320;
constexpr int LDS_BYTES = 147456;
#define GAS __attribute__((address_space(1)))
#define LAS __attribute__((address_space(3)))
typedef unsigned short bf16;
typedef unsigned v4u __attribute__((ext_vector_type(4)));
typedef unsigned v2u __attribute__((ext_vector_type(2)));
typedef float f32x4 __attribute__((ext_vector_type(4)));
typedef short bf16x8 __attribute__((ext_vector_type(8)));
typedef GAS unsigned gu32;
#define RLX_AGENT __ATOMIC_RELAXED, __HIP_MEMORY_SCOPE_AGENT
#define LDS_WAIT() asm volatile("s_waitcnt lgkmcnt(0)" ::: "memory")
#define VM_WAIT() asm volatile("s_waitcnt vmcnt(0)" ::: "memory")
#define LDS_BAR() do { asm volatile("s_waitcnt lgkmcnt(0)" ::: "memory"); __builtin_amdgcn_s_barrier(); asm volatile("" ::: "memory"); } while (0)
__device__ __forceinline__ unsigned f2bf(float f) { unsigned u = __builtin_bit_cast(unsigned, f); return (u + 0x7fffu + ((u >> 16) & 1u)) >> 16; }
__device__ __forceinline__ unsigned pk2(float lo, float hi) { return f2bf(lo) | (f2bf(hi) << 16); }
__device__ __forceinline__ float bf2f(unsigned short b) { return __builtin_bit_cast(float, ((unsigned)b) << 16); }
__device__ __forceinline__ float bflo(unsigned w) { return __builtin_bit_cast(float, w << 16); }
__device__ __forceinline__ float bfhi(unsigned w) { return __builtin_bit_cast(float, w & 0xffff0000u); }
__device__ __forceinline__ float wave_sum(float v) {
#pragma unroll
    for (int o = 1; o < 64; o <<= 1) v += __shfl_xor(v, o);
    return v;
}
__device__ __forceinline__ float wave_max(float v) {
#pragma unroll
    for (int o = 1; o < 64; o <<= 1) v = fmaxf(v, __shfl_xor(v, o));
    return v;
}
__device__ __forceinline__ float sigmoid_f(float x) { return __builtin_amdgcn_rcpf(1.0f + __expf(-x)); }
__device__ __forceinline__ float silu_f(float x) { return x * __builtin_amdgcn_rcpf(1.0f + __expf(-x)); }
__device__ __forceinline__ float softplus_f(float x) { return fmaxf(x, 0.f) + log1pf(__expf(-fabsf(x))); }
template <int CTRL> __device__ __forceinline__ float dpp_mov(float v) { return __builtin_bit_cast(float, __builtin_amdgcn_update_dpp(0, __builtin_bit_cast(int, v), CTRL, 0xf, 0xf, true)); }
__device__ __forceinline__ float sum16(float v) { v += dpp_mov<0xB1>(v); v += dpp_mov<0x4E>(v); v += dpp_mov<0x141>(v); v += dpp_mov<0x140>(v); return v; }
#define XB_TMO      128
#define XB_XCNT(j)  (256  + 64 * (j))
#define XB_XSUB(j)  (1280 + 64 * (j))
#define XB_XGEN(j)  (2304 + 64 * (j))
#define XB_TOP      3328
#define XB_TOPGEN   3392
#define XCD_BAR_WORDS 3456
#define XB_SPIN_CAP (1u << 18)

__device__ __forceinline__ unsigned xb_ld(unsigned* p)              { return __hip_atomic_load(p, __ATOMIC_RELAXED, __HIP_MEMORY_SCOPE_AGENT); }
__device__ __forceinline__ unsigned xb_add(unsigned* p, unsigned v) { return __hip_atomic_fetch_add(p, v, __ATOMIC_RELAXED, __HIP_MEMORY_SCOPE_AGENT); }
__device__ __forceinline__ unsigned xb_xcc_id() { return (unsigned)__builtin_amdgcn_s_getreg((3 << 11) | 20) & 0xFu; }
#define XB_SPIN(cond, bar) do { unsigned _sp = 0; while (cond) { __builtin_amdgcn_s_sleep(1); \
    if ((++_sp & 255u) == 0u) { if (xb_ld(&(bar)[XB_TMO])) break; if (_sp > XB_SPIN_CAP) { atomicAdd(&(bar)[XB_TMO], 1u); break; } } } } while (0)

struct XcdBarrier {
    unsigned* bar; unsigned x;
    volatile LAS unsigned* st;
};

__device__ __forceinline__ XcdBarrier xcd_barrier_post(unsigned* bar, volatile LAS unsigned* st) {
    XcdBarrier b; b.bar = bar; b.x = xb_xcc_id(); b.st = st;
    if (threadIdx.x == 0) (void)xb_add(&bar[XB_XCNT(b.x)], 1u);
    return b;
}
__device__ __forceinline__ void xcd_barrier_complete(unsigned* bar, unsigned x, unsigned& nloc, unsigned& nx) {
    const unsigned G = gridDim.x * gridDim.y * gridDim.z;
    unsigned sum, cnt, mine, sp = 0u;
    for (;;) {
        sum = 0u; cnt = 0u; mine = 0u;
#pragma unroll
        for (unsigned j = 0; j < 16; ++j) { const unsigned c = xb_ld(&bar[XB_XCNT(j)]); sum += c; cnt += (c > 0u) ? 1u : 0u; mine = (j == x) ? c : mine; }
        if (sum == G) break;
        __builtin_amdgcn_s_sleep(1);
        if ((++sp & 255u) == 0u) { if (xb_ld(&bar[XB_TMO])) break; if (sp > XB_SPIN_CAP) { atomicAdd(&bar[XB_TMO], 1u); break; } }
    }
    nloc = mine > 0u ? mine : 1u; nx = cnt > 0u ? cnt : 1u;
}

__device__ __forceinline__ void xcd_barrier(const XcdBarrier& b) {
    asm volatile("s_waitcnt vmcnt(0)" ::: "memory");
    __syncthreads();
    if (threadIdx.x == 0) {
        unsigned* bar = b.bar;
        __builtin_amdgcn_s_waitcnt(0);
        unsigned nloc = b.st[0], nx = b.st[1];
        if (nloc == 0u) { xcd_barrier_complete(bar, b.x, nloc, nx); b.st[0] = nloc; b.st[1] = nx; }
        const unsigned old = xb_add(&bar[XB_XSUB(b.x)], 1u);
        const unsigned gen = old / nloc;
        if (old + 1u == (gen + 1u) * nloc) {
            __builtin_amdgcn_fence(__ATOMIC_RELEASE, "agent");
            asm volatile("s_waitcnt vmcnt(0)" ::: "memory");
            const unsigned og = xb_add(&bar[XB_TOP], 1u);
            const unsigned tg = og / nx;
            if (og + 1u == (tg + 1u) * nx) xb_add(&bar[XB_TOPGEN], 1u);
            else XB_SPIN(xb_ld(&bar[XB_TOPGEN]) == tg, bar);
            __builtin_amdgcn_fence(__ATOMIC_ACQUIRE, "agent");
            xb_add(&bar[XB_XGEN(b.x)], 1u);
            asm volatile("s_waitcnt vmcnt(0)" ::: "memory");
        } else {
            XB_SPIN(xb_ld(&bar[XB_XGEN(b.x)]) == gen, bar);
            __builtin_amdgcn_fence(__ATOMIC_ACQUIRE, "agent");
            asm volatile("s_waitcnt vmcnt(0)" ::: "memory");
        }
    }
    __syncthreads();
}
struct Params {
    const float* in[21]; float* out; unsigned char* ws; int ph_lo, ph_hi, li, pad;
};
struct Frame {
    LAS unsigned char* lds;
    volatile LAS unsigned* MISC;
    gu32* ctl;
    int tid, lane, wave, vcu, G;
};
__device__ __forceinline__ void p0_transpose_item(const float* W, int K, int N, bf16* WT, int k0, int n0, int dst_row0, LAS float* scr, int lane) {
#pragma unroll 8
    for (int i = 0; i < 32; ++i) { const int kk = 2 * i + (lane >> 5); scr[kk * 33 + (lane & 31)] = W[(size_t)(k0 + kk) * N + n0 + (lane & 31)]; }
    LDS_WAIT(); asm volatile("" ::: "memory");
    const int c = lane & 7;
#pragma unroll
    for (int j = 0; j < 4; ++j) { const int n = (lane >> 3) + 8 * j; const LAS float* s = scr + (8 * c) * 33 + n;
        v4u o; o.x = pk2(s[0 * 33], s[1 * 33]); o.y = pk2(s[2 * 33], s[3 * 33]); o.z = pk2(s[4 * 33], s[5 * 33]); o.w = pk2(s[6 * 33], s[7 * 33]);
        *(GAS v4u*)(WT + (size_t)(dst_row0 + n) * K + k0 + 8 * c) = o; }
    LDS_WAIT(); asm volatile("" ::: "memory");
}
__device__ __forceinline__ const float* x_row(const Params& p, int m) { return m < TP ? p.in[0] + (size_t)m * DM : p.in[1] + (size_t)(m - TP) * DM; }
__device__ __forceinline__ void rms_row_to_bf16(const float* xrow, const float* w, bf16* orow, int lane) {
    const GAS f32x4* xr = (const GAS f32x4*)xrow + lane; const GAS f32x4* wr = (const GAS f32x4*)w + lane;
    f32x4 v[16]; float s = 0.f;
#pragma unroll
    for (int j = 0; j < 16; ++j) { v[j] = xr[64 * j]; s += (v[j].x * v[j].x + v[j].y * v[j].y) + (v[j].z * v[j].z + v[j].w * v[j].w); }
    const float r = rsqrtf(wave_sum(s) * (1.f / DM) + NORM_EPS);
    GAS v2u* o8 = (GAS v2u*)orow + lane;
#pragma unroll
    for (int j = 0; j < 16; ++j) { const f32x4 ww = wr[64 * j]; v2u o; o.x = pk2(v[j].x * r * ww.x, v[j].y * r * ww.y); o.y = pk2(v[j].z * r * ww.z, v[j].w * r * ww.w); o8[64 * j] = o; }
}
__device__ __forceinline__ void p0_prologue(Frame& F, const Params& p) {
    LAS float* scr = (LAS float*)(F.lds + RING_OFF + F.wave * 16384);
    const int gw = F.vcu * NWAVES + F.wave, NGW = F.G * NWAVES;
    unsigned char* ws = p.ws;
    bf16* Win_t = (bf16*)(ws + WS_WIN); bf16* Wout_t = (bf16*)(ws + WS_WOUT); bf16* Wgu_t = (bf16*)(ws + WS_WGU);
    constexpr int I_IN = (DM / 64) * (PROJ_W / 32), I_OUT = (DM / 64) * (DM / 32), I_G = (DM / 64) * (FF / 32);
    constexpr int NITEMS = I_IN + I_OUT + I_G;
    for (int it = gw; it < NITEMS; it += NGW) {
        int r = it;
        if (r < I_IN) { const int nb = r % (PROJ_W / 32), kb = r / (PROJ_W / 32); p0_transpose_item(p.in[7], DM, PROJ_W, Win_t, 64 * kb, 32 * nb, 32 * nb, scr, F.lane); continue; } r -= I_IN;
        if (r < I_OUT) { const int nb = r % (DM / 32), kb = r / (DM / 32); p0_transpose_item(p.in[13], DM, DM, Wout_t, 64 * kb, 32 * nb, 32 * nb, scr, F.lane); continue; } r -= I_OUT;
        { const int nb = r % (FF / 32), kb = r / (FF / 32), n0 = 32 * nb; p0_transpose_item(p.in[18], DM, FF, Wgu_t, 64 * kb, n0, 256 * (n0 >> 7) + (n0 & 127), scr, F.lane); }
    }
    { GAS v4u* z = (GAS v4u*)(Win_t + (size_t)PROJ_W * DM); const size_t n16 = (size_t)(PROJ_PAD - PROJ_W) * DM * 2 / 16;
      for (size_t i = (size_t)gw * 64 + F.lane; i < n16; i += (size_t)NGW * 64) z[i] = (v4u){0u, 0u, 0u, 0u}; }
    bf16* H = (bf16*)(ws + WS_H);
    for (int m = gw; m < MROWS; m += NGW) rms_row_to_bf16(x_row(p, m), p.in[14], H + (size_t)m * DM, F.lane);
}
__device__ __forceinline__ void w_down_convert(const Frame& F, const Params& p, int wi, int nw) {
    LAS float* scr = (LAS float*)(F.lds + RING_OFF + F.wave * 16384);
    bf16* Wdn_t = (bf16*)(p.ws + WS_WDN);
    constexpr int I_D = (FF / 64) * (DM / 32);
    for (int r = wi * NWAVES + F.wave; r < I_D; r += nw * NWAVES) { const int nb = r % (DM / 32), kb = r / (DM / 32); p0_transpose_item(p.in[20], FF, DM, Wdn_t, 64 * kb, 32 * nb, 32 * nb, scr, F.lane); }
}
__device__ __forceinline__ void w_up_convert(const Frame& F, const Params& p, int wi, int nw) {
    LAS float* scr = (LAS float*)(F.lds + RING_OFF + F.wave * 16384);
    bf16* Wgu_t = (bf16*)(p.ws + WS_WGU);
    constexpr int I_G = (DM / 64) * (FF / 32);
    for (int r = wi * NWAVES + F.wave; r < I_G; r += nw * NWAVES) { const int nb = r % (FF / 32), kb = r / (FF / 32), n0 = 32 * nb; p0_transpose_item(p.in[19], DM, FF, Wgu_t, 64 * kb, n0, 256 * (n0 >> 7) + 128 + (n0 & 127), scr, F.lane); }
}
__device__ __forceinline__ int rel_bucket_dev(int n) {
    if (n < 16) return n;
    int large = 16 + (int)(logf((float)n * 0.0625f) / 2.0794415416798357f * 16.0f);
    return large < 31 ? large : 31;
}
__device__ __forceinline__ f32x4 bf4_to_f32(v2u w) { return (f32x4){bflo(w.x), bfhi(w.x), bflo(w.y), bfhi(w.y)}; }
__device__ __forceinline__ void ph_copy_states(const Frame& F, const bf16* P, const float* ck, const float* cv, float* out) {
    const int gid = F.vcu * 512 + F.tid, gs = F.G * 512;
    for (int id = gid; id < NSB * 2 * 4 * 128; id += gs) { const int b = id >> 10, kv = (id >> 9) & 1, j = 124 + ((id >> 7) & 3), c4 = id & 127;
        ((f32x4*)(out + (kv ? O_SWV : O_SWK) + ((size_t)b * 128 + j) * 512))[c4] = bf4_to_f32(((const v2u*)(P + (size_t)(TP + 4 * b + (j - 124)) * PW + (kv ? C_VA : C_KA)))[c4]); }
    for (int id = gid; id < 2 * 128 * 128; id += gs) { const int kv = id >> 14, j = (id >> 7) & 127, c4 = id & 127;
        ((f32x4*)(out + (kv ? O_PWV : O_PWK) + (size_t)j * 512))[c4] = bf4_to_f32(((const v2u*)(P + (size_t)(TP - 128 + j) * PW + (kv ? C_VA : C_KA)))[c4]); }
    for (int id = gid; id < 3 * 1536; id += gs) { const int r = id / 1536, c4 = id - r * 1536;
        ((f32x4*)(out + O_PCONV + (size_t)r * 6144))[c4] = bf4_to_f32(((const v2u*)(P + (size_t)(TP - 3 + r) * PW + C_QKVG))[c4]); }
    for (int id = gid; id < NSB * 3 * 1536; id += gs) { const int br = id / 1536, c4 = id - br * 1536, b = br / 3, r = br - 3 * b;
        ((f32x4*)(out + O_SCONV + (size_t)br * 6144))[c4] = bf4_to_f32(((const v2u*)(P + (size_t)(TP + 4 * b + r + 1) * PW + C_QKVG))[c4]); }
}
__device__ __forceinline__ void copy_cache_rows(const Frame& F, const float* ck, const float* cv, float* out, int wi, int nw) {
    for (int id = wi * 512 + F.tid; id < NSB * 2 * 128 * 128; id += nw * 512) { const int b = id >> 15, kv = (id >> 14) & 1, j = (id >> 7) & 127, c4 = id & 127;
        if (j < 124) ((f32x4*)(out + (kv ? O_SWV : O_SWK) + ((size_t)b * 128 + j) * 512))[c4] = ((const f32x4*)((kv ? cv : ck) + ((size_t)b * 128 + j + 4) * 512))[c4]; }
}
__device__ __forceinline__ void ph_gated_norm(const Frame& F, const float* ORAW, const bf16* P, const float* gw, bf16* MIX, int row_lo, int row_hi) {
    const int lane = F.lane;
    const f32x4 g4 = ((const f32x4*)gw)[lane & 31];
    for (int row = row_lo + F.vcu * NWAVES + F.wave; row < row_hi; row += F.G * NWAVES) {
        f32x4 o[8]; v2u z[8];
#pragma unroll
        for (int i = 0; i < 8; ++i) { o[i] = ((const f32x4*)(ORAW + (size_t)row * 2048))[64 * i + lane]; z[i] = ((const v2u*)(P + (size_t)row * PW + C_ZG))[64 * i + lane]; }
#pragma unroll
        for (int i = 0; i < 8; ++i) {
            float ss = (o[i].x * o[i].x + o[i].y * o[i].y) + (o[i].z * o[i].z + o[i].w * o[i].w);
#pragma unroll
            for (int sh = 1; sh < 32; sh <<= 1) ss += __shfl_xor(ss, sh);
            const float r = rsqrtf(ss * (1.f / 128.f) + NORM_EPS); const f32x4 zz = bf4_to_f32(z[i]);
            v2u w; w.x = pk2(o[i].x * r * g4.x * silu_f(zz.x), o[i].y * r * g4.y * silu_f(zz.y)); w.y = pk2(o[i].z * r * g4.z * silu_f(zz.z), o[i].w * r * g4.w * silu_f(zz.w));
            ((v2u*)(MIX + (size_t)row * DM + 2048))[64 * i + lane] = w;
        }
    }
}
__device__ __forceinline__ void row_gemm_out(const bf16* C, const bf16* slab, int row, int lane, f32x4 (&v)[16]) {
    if (row < TP) { const v2u* cr = (const v2u*)(C + (size_t)row * DM) + lane; v2u w[16];
#pragma unroll
        for (int j = 0; j < 16; ++j) w[j] = cr[64 * j];
#pragma unroll
        for (int j = 0; j < 16; ++j) v[j] = bf4_to_f32(w[j]);
    } else { const v2u* s = (const v2u*)(slab + (size_t)(row - TP) * DM) + lane; constexpr size_t st = (size_t)NSB * NST * DM / 4;
#pragma unroll
        for (int j = 0; j < 16; ++j) { const v2u* q = s + 64 * j; v[j] = ((bf4_to_f32(q[0]) + bf4_to_f32(q[st])) + (bf4_to_f32(q[2 * st]) + bf4_to_f32(q[3 * st]))) + ((bf4_to_f32(q[4 * st]) + bf4_to_f32(q[5 * st])) + (bf4_to_f32(q[6 * st]) + bf4_to_f32(q[7 * st]))); }
    }
}
__device__ __forceinline__ void slab_rows_to_lds(const Frame& F, const bf16* slab) {
    LAS f32x4* srow = (LAS f32x4*)(F.lds + RING_OFF); constexpr size_t st = (size_t)NSB * NST * DM / 4;
    for (int idx = F.tid; idx < NWAVES * 1024; idx += NWAVES * 64) { const int w = idx >> 10, c = idx & 1023, sr = w * F.G + F.vcu;
        if (sr < NSB * NST) { const v2u* q = (const v2u*)(slab + (size_t)sr * DM) + c; v2u t[8];
#pragma unroll
            for (int k = 0; k < 8; ++k) t[k] = q[k * st];
            srow[idx] = ((bf4_to_f32(t[0]) + bf4_to_f32(t[1])) + (bf4_to_f32(t[2]) + bf4_to_f32(t[3]))) + ((bf4_to_f32(t[4]) + bf4_to_f32(t[5])) + (bf4_to_f32(t[6]) + bf4_to_f32(t[7]))); } }
    __syncthreads();
}
__device__ __forceinline__ void ph_postmix(const Frame& F, const Params& p, const bf16* MIXO, const bf16* SLAB, float* out, bf16* H) {
    const int lane = F.lane; const f32x4* w_post = (const f32x4*)p.in[15] + lane; const f32x4* w_pre = (const f32x4*)p.in[16] + lane;
    const int NGW = F.G * NWAVES, np = (TP + NGW - 1) / NGW, ns = (NSB * NST + NGW - 1) / NGW;
    const bool lds_rows = ns == 1; if (lds_rows) slab_rows_to_lds(F, SLAB);
    for (int it = 0; it < np + ns; ++it) {
        const int row = it < np ? F.vcu * NWAVES + F.wave + it * NGW : TP + F.wave * F.G + F.vcu + (it - np) * NGW;
        if (it < np ? row >= TP : row >= MROWS) continue;
        const f32x4* xr = (const f32x4*)x_row(p, row) + lane;
        f32x4 v[16], x[16];
#pragma unroll
        for (int j = 0; j < 16; ++j) x[j] = xr[64 * j];
        if (it >= np && lds_rows) {
#pragma unroll
            for (int j = 0; j < 16; ++j) v[j] = ((const LAS f32x4*)(F.lds + RING_OFF))[F.wave * 1024 + lane + 64 * j];
        } else row_gemm_out(MIXO, SLAB, row, lane, v);
        float s = 0.f;
#pragma unroll
        for (int j = 0; j < 16; ++j) s += (v[j].x * v[j].x + v[j].y * v[j].y) + (v[j].z * v[j].z + v[j].w * v[j].w);
        const float r = rsqrtf(wave_sum(s) * (1.f / DM) + NORM_EPS); float s2 = 0.f;
        f32x4* orow = (f32x4*)(out + (size_t)row * DM) + lane;
#pragma unroll
        for (int j = 0; j < 16; ++j) { const f32x4 w = w_post[64 * j];
            v[j].x = x[j].x + v[j].x * r * w.x; v[j].y = x[j].y + v[j].y * r * w.y; v[j].z = x[j].z + v[j].z * r * w.z; v[j].w = x[j].w + v[j].w * r * w.w;
            orow[64 * j] = v[j]; s2 += (v[j].x * v[j].x + v[j].y * v[j].y) + (v[j].z * v[j].z + v[j].w * v[j].w); }
        const float r2 = rsqrtf(wave_sum(s2) * (1.f / DM) + NORM_EPS);
        v2u* hrow = (v2u*)(H + (size_t)row * DM) + lane;
#pragma unroll
        for (int j = 0; j < 16; ++j) { const f32x4 w = w_pre[64 * j]; v2u o; o.x = pk2(v[j].x * r2 * w.x, v[j].y * r2 * w.y); o.y = pk2(v[j].z * r2 * w.z, v[j].w * r2 * w.w); hrow[64 * j] = o; }
    }
}
__device__ __forceinline__ void ph_final(const Frame& F, const bf16* FFNO, const bf16* SLAB, const float* w_post_, float* out) {
    const int lane = F.lane; const f32x4* w_post = (const f32x4*)w_post_ + lane;
    const int NGW = F.G * NWAVES, np = (TP + NGW - 1) / NGW, ns = (NSB * NST + NGW - 1) / NGW;
    const bool lds_rows = ns == 1; if (lds_rows) slab_rows_to_lds(F, SLAB);
    for (int it = 0; it < np + ns; ++it) {
        const int row = it < np ? F.vcu * NWAVES + F.wave + it * NGW : TP + F.wave * F.G + F.vcu + (it - np) * NGW;
        if (it < np ? row >= TP : row >= MROWS) continue;
        f32x4* orow = (f32x4*)(out + (size_t)row * DM) + lane;
        f32x4 v[16], x[16];
#pragma unroll
        for (int j = 0; j < 16; ++j) x[j] = orow[64 * j];
        if (it >= np && lds_rows) {
#pragma unroll
            for (int j = 0; j < 16; ++j) v[j] = ((const LAS f32x4*)(F.lds + RING_OFF))[F.wave * 1024 + lane + 64 * j];
        } else row_gemm_out(FFNO, SLAB, row, lane, v);
        float s = 0.f;
#pragma unroll
        for (int j = 0; j < 16; ++j) s += (v[j].x * v[j].x + v[j].y * v[j].y) + (v[j].z * v[j].z + v[j].w * v[j].w);
        const float r = rsqrtf(wave_sum(s) * (1.f / DM) + NORM_EPS);
#pragma unroll
        for (int j = 0; j < 16; ++j) { const f32x4 w = w_post[64 * j];
            orow[64 * j] = (f32x4){x[j].x + v[j].x * r * w.x, x[j].y + v[j].y * r * w.y, x[j].z + v[j].z * r * w.z, x[j].w + v[j].w * r * w.w}; }
    }
}
__device__ __forceinline__ unsigned off_b(unsigned row, unsigned ch) { return 256u * row + 16u * (ch ^ (((row & 3) << 2) | ((row >> 2) & 3))); }
__device__ __forceinline__ unsigned row_read_addr_16(unsigned lane, unsigned rb, unsigned s) { return off_b((lane & 15) + 16 * rb, 4 * s + (lane >> 4)); }
__device__ __forceinline__ unsigned tr_read_addr_16(unsigned lane, unsigned c, unsigned ks, unsigned t) {
    const unsigned g = lane >> 4, q = (lane & 15) >> 2, p = lane & 3;
    return off_b(32 * ks + 8 * g + 4 * t + q, 2 * c + (p >> 1)) + 8 * (p & 1);
}
typedef short s16x4 __attribute__((ext_vector_type(4)));
__device__ __forceinline__ unsigned lds_addr(const LAS unsigned char* p) { return (unsigned)(__UINTPTR_TYPE__)p; }
__device__ __forceinline__ s16x4 tr_read_wait(unsigned a) { s16x4 r; asm volatile("ds_read_b64_tr_b16 %0, %1\n\ts_waitcnt lgkmcnt(0)" : "=&v"(r) : "v"(a) : "memory"); return r; }
__device__ __forceinline__ bf16x8 tr_frag(unsigned base, unsigned lane, unsigned c, unsigned ks) {
    const s16x4 lo = tr_read_wait(base + tr_read_addr_16(lane, c, ks, 0)), hi = tr_read_wait(base + tr_read_addr_16(lane, c, ks, 1));
    return (bf16x8){lo[0], lo[1], lo[2], lo[3], hi[0], hi[1], hi[2], hi[3]};
}
__device__ __forceinline__ v4u pack8(const float* y) { v4u o; o.x = pg8::cvt_pk_bf16(y[0], y[1]); o.y = pg8::cvt_pk_bf16(y[2], y[3]); o.z = pg8::cvt_pk_bf16(y[4], y[5]); o.w = pg8::cvt_pk_bf16(y[6], y[7]); return o; }
struct ScanBufs { bf16* wF; bf16* kdF; bf16* qeF; bf16* qkF; float* uF; float* egl; unsigned char* vbg; bf16* snF; bf16* vnF; };
constexpr int PREP_B = 4;
constexpr int PA_SLOT = 17408;
constexpr int PA_IMG = PREP_B * PA_SLOT;
constexpr int PA_MSC = PA_IMG + 65536;
struct PrepIn { v4u xw[11]; f32x4 w0[4], w1[4]; float ga, gb; };
__device__ __forceinline__ void gdn_prep_issue(PrepIn& I, int un, int tid, const bf16* P, const float* AB, const float* conv_w) {
    const int h = un >> 7, n = un & 127, row0 = 64 * n, lane = tid & 63;
    const int part = (tid >> 7) < 3 ? (tid >> 7) : 2, tok0 = ((tid >> 4) & 7) * 8, cl = tid & 15, ch = part * 2048 + h * 128 + cl * 8;
#pragma unroll
    for (int k = 0; k < 11; ++k) { const int r = row0 + tok0 - 3 + k, rc = r < 0 ? 0 : r; I.xw[k] = *(const v4u*)(P + (size_t)rc * PW + C_QKVG + ch); }
#pragma unroll
    for (int i = 0; i < 4; ++i) { const float* wp = conv_w + (size_t)i * 6144 + ch; I.w0[i] = *(const f32x4*)wp; I.w1[i] = *(const f32x4*)(wp + 4); }
    I.ga = AB[(size_t)(row0 + lane) * 32 + h]; I.gb = AB[(size_t)(row0 + lane) * 32 + 16 + h];
}
__device__ __forceinline__ void gdn_prep_a(const Frame& F, int un, int slot, PrepIn& I, int un_next, const bf16* P, const float* AB, const float* conv_w, const float* a_log, const float* dt_bias, const ScanBufs sb) {
    constexpr int KIMG = PA_IMG, QIMG = PA_IMG + 16384, QEIMG = PA_IMG + 32768, KDIMG = PA_IMG + 49152, QKB = QIMG;
    LAS unsigned char* L = F.lds + RING_OFF;
    LAS float* gcs = (LAS float*)(L + PA_MSC); LAS float* bts = gcs + 64; LAS float* Af = (LAS float*)(L + slot * PA_SLOT);
    int zv = 0; asm volatile("" : "+v"(zv));
    const int tid = F.tid + zv, lane = tid & 63, wave = F.wave, quad = lane >> 4, l15 = lane & 15;
    const int h = un >> 7, n = un & 127, row0 = 64 * n;
    const int part = tid >> 7, tok0 = ((tid >> 4) & 7) * 8, cl = tid & 15, ch = part * 2048 + h * 128 + cl * 8;
    v4u xw[11]; f32x4 w0[4], w1[4];
    unsigned char* vbg = sb.vbg + (size_t)un * 32768;
    if (tid < 384) {
#pragma unroll
        for (int k = 0; k < 11; ++k) { const int r = row0 + tok0 - 3 + k; xw[k] = r < 0 ? (v4u){0u, 0u, 0u, 0u} : I.xw[k]; }
#pragma unroll
        for (int i = 0; i < 4; ++i) { w0[i] = I.w0[i]; w1[i] = I.w1[i]; }
    } else if (wave == 6) {
        const float a = I.ga, bb = I.gb;
        float g = -__expf(a_log[h]) * softplus_f(a + dt_bias[h]);
#pragma unroll
        for (int o = 1; o < 64; o <<= 1) { const float t = __shfl_up(g, o); if (lane >= o) g += t; }
        gcs[lane] = g; bts[lane] = sigmoid_f(bb);
    }
    LDS_BAR();
    const float glast = gcs[63];
    if (tid < 384) {
#pragma unroll
        for (int t = 0; t < 8; ++t) {
            const int tok = tok0 + t; float y[8];
#pragma unroll
            for (int e = 0; e < 8; ++e) y[e] = 0.f;
#pragma unroll
            for (int i = 0; i < 4; ++i) { const v4u w = xw[t + i];
                y[0] += bflo(w.x) * w0[i].x; y[1] += bfhi(w.x) * w0[i].y; y[2] += bflo(w.y) * w0[i].z; y[3] += bfhi(w.y) * w0[i].w;
                y[4] += bflo(w.z) * w1[i].x; y[5] += bfhi(w.z) * w1[i].y; y[6] += bflo(w.w) * w1[i].z; y[7] += bfhi(w.w) * w1[i].w; }
            float ss = 0.f;
#pragma unroll
            for (int e = 0; e < 8; ++e) { y[e] = silu_f(y[e]); ss += y[e] * y[e]; }
            const float gc = gcs[tok], be = bts[tok], egc = __expf(gc), ekd = __expf(glast - gc);
            const unsigned o = off_b(tok, cl); float t8[8];
            if (part < 2) {
                ss = sum16(ss);
                const float rn = rsqrtf(ss + NORM_EPS) * (part == 0 ? 0.08838834764831845f : 1.0f);
#pragma unroll
                for (int e = 0; e < 8; ++e) y[e] *= rn;
            }
            if (part == 0) {
                *(LAS v4u*)(L + QIMG + o) = pack8(y);
#pragma unroll
                for (int e = 0; e < 8; ++e) t8[e] = y[e] * egc;
                *(LAS v4u*)(L + QEIMG + o) = pack8(t8);
            } else if (part == 1) {
                *(LAS v4u*)(L + KIMG + o) = pack8(y);
#pragma unroll
                for (int e = 0; e < 8; ++e) t8[e] = y[e] * (be * egc);
                *(v4u*)(vbg + 16384 + o) = pack8(t8);
#pragma unroll
                for (int e = 0; e < 8; ++e) t8[e] = y[e] * ekd;
                *(LAS v4u*)(L + KDIMG + o) = pack8(t8);
            } else {
#pragma unroll
                for (int e = 0; e < 8; ++e) t8[e] = y[e] * be;
                *(v4u*)(vbg + o) = pack8(t8);
            }
        }
    }
    gdn_prep_issue(I, un_next, tid, P, AB, conv_w);
    LDS_BAR();
    f32x4 accj[3];
#pragma unroll
    for (int r = 0; r < 3; ++r) {
        const int job = wave + 8 * r; accj[r] = (f32x4){0.f, 0.f, 0.f, 0.f};
        if (job < 20) {
            const int idx = job < 10 ? job : job - 10, ti = idx >= 6 ? 3 : idx >= 3 ? 2 : idx >= 1 ? 1 : 0, tj = idx - ti * (ti + 1) / 2;
            const int aimg = job < 10 ? KIMG : QIMG;
            bf16x8 fa[4], fb[4];
#pragma unroll
            for (int s = 0; s < 4; ++s) { fa[s] = *(const LAS bf16x8*)(L + aimg + row_read_addr_16(lane, ti, s)); fb[s] = *(const LAS bf16x8*)(L + KIMG + row_read_addr_16(lane, tj, s)); }
            __builtin_amdgcn_sched_barrier(0);
#pragma unroll
            for (int s = 0; s < 4; ++s) accj[r] = __builtin_amdgcn_mfma_f32_16x16x32_bf16(fa[s], fb[s], accj[r], 0, 0, 0);
        }
    }
    LDS_BAR();
#pragma unroll
    for (int r = 0; r < 3; ++r) {
        const int job = wave + 8 * r;
        if (job < 20) {
            const int idx = job < 10 ? job : job - 10, ti = idx >= 6 ? 3 : idx >= 3 ? 2 : idx >= 1 ? 1 : 0, tj = idx - ti * (ti + 1) / 2;
            const int j = 16 * tj + l15; const float gj = gcs[j];
#pragma unroll
            for (int e = 0; e < 4; ++e) { const int i = 16 * ti + 4 * quad + e; const float dec = __expf(fminf(gcs[i] - gj, 0.f));
                if (job < 10) Af[i * 68 + j] = (i > j) ? bts[i] * accj[r][e] * dec : 0.f;
                else ((LAS bf16*)(L + QKB))[i * 72 + j] = (bf16)f2bf(accj[r][e] * dec); }
        }
    }
    LDS_BAR();
    {
        const unsigned base = lds_addr(L);
#pragma unroll 1
        for (int job = wave; job < 40; job += 8) {
            if (job < 16) { const int ti = job >> 2, s = job & 3;
                *(v4u*)(sb.qeF + ((size_t)(un * 16 + job) * 64 + lane) * 8) = *(const LAS v4u*)(L + QEIMG + row_read_addr_16(lane, ti, s)); }
            else if (job < 32) { const int f = job - 16, di = f >> 1, s2 = f & 1;
                const bf16x8 fr = tr_frag(base + KDIMG, lane, di, s2);
                *(bf16x8*)(sb.kdF + ((size_t)(un * 16 + f) * 64 + lane) * 8) = fr; }
            else { const int f = job - 32, ti = f >> 1, s2 = f & 1, i = 16 * ti + l15, j0 = 32 * s2 + 8 * quad;
                v4u w = *(const LAS v4u*)(L + QKB + i * 144 + j0 * 2);
                w.x = (j0 + 0 <= i ? w.x & 0xffffu : 0u) | (j0 + 1 <= i ? w.x & 0xffff0000u : 0u); w.y = (j0 + 2 <= i ? w.y & 0xffffu : 0u) | (j0 + 3 <= i ? w.y & 0xffff0000u : 0u);
                w.z = (j0 + 4 <= i ? w.z & 0xffffu : 0u) | (j0 + 5 <= i ? w.z & 0xffff0000u : 0u); w.w = (j0 + 6 <= i ? w.w & 0xffffu : 0u) | (j0 + 7 <= i ? w.w & 0xffff0000u : 0u);
                *(v4u*)(sb.qkF + ((size_t)(un * 8 + f) * 64 + lane) * 8) = w; }
        }
    }
    if (tid == 0) sb.egl[un] = __expf(glast);
    LDS_BAR();
}
__device__ __forceinline__ void gdn_prep_c(const Frame& F, int un, int slot, const ScanBufs sb) {
    constexpr int VBIMG = PA_IMG, KGIMG = PA_IMG + 16384, WT = PA_IMG + 32768;
    LAS unsigned char* L = F.lds + RING_OFF;
    int zv = 0; asm volatile("" : "+v"(zv));
    const int tid = F.tid + zv, lane = tid & 63, wave = F.wave, quad = lane >> 4, l15 = lane & 15;
    const unsigned char* vbg = sb.vbg + (size_t)un * 32768;
#pragma unroll
    for (int it = 0; it < 4; ++it) { const int o = (tid + 512 * it) * 16; *(LAS v4u*)(L + VBIMG + o) = *(const v4u*)(vbg + o); }
    LDS_BAR();
    {
        const int ti = wave & 3, which = wave >> 2; const unsigned base = lds_addr(L) + (which ? KGIMG : VBIMG);
        bf16x8 ta[2];
#pragma unroll
        for (int s2 = 0; s2 < 2; ++s2) ta[s2] = *(const LAS bf16x8*)(L + slot * PA_SLOT + (16 * ti + l15) * 144 + (32 * s2 + 8 * quad) * 2);
#pragma unroll 2
        for (int ct = 0; ct < 8; ++ct) {
            f32x4 acc = (f32x4){0.f, 0.f, 0.f, 0.f};
            { const unsigned a0 = base + tr_read_addr_16(lane, ct, 0, 0), a1 = base + tr_read_addr_16(lane, ct, 0, 1), a2 = base + tr_read_addr_16(lane, ct, 1, 0), a3 = base + tr_read_addr_16(lane, ct, 1, 1);
              s16x4 t0, t1, t2, t3;
              asm volatile("ds_read_b64_tr_b16 %0, %4\n\tds_read_b64_tr_b16 %1, %5\n\tds_read_b64_tr_b16 %2, %6\n\tds_read_b64_tr_b16 %3, %7\n\ts_waitcnt lgkmcnt(0)"
                           : "=&v"(t0), "=&v"(t1), "=&v"(t2), "=&v"(t3) : "v"(a0), "v"(a1), "v"(a2), "v"(a3) : "memory");
              acc = __builtin_amdgcn_mfma_f32_16x16x32_bf16(ta[0], (bf16x8){t0[0], t0[1], t0[2], t0[3], t1[0], t1[1], t1[2], t1[3]}, acc, 0, 0, 0);
              acc = __builtin_amdgcn_mfma_f32_16x16x32_bf16(ta[1], (bf16x8){t2[0], t2[1], t2[2], t2[3], t3[0], t3[1], t3[2], t3[3]}, acc, 0, 0, 0); }
            if (which == 0) *(f32x4*)(sb.uF + ((size_t)((un * 4 + ti) * 8 + ct) * 64 + lane) * 4) = acc;
            else {
#pragma unroll
                for (int e = 0; e < 4; ++e) ((LAS bf16*)(L + WT))[(16 * ti + 4 * quad + e) * 136 + 16 * ct + l15] = (bf16)f2bf(acc[e]); }
        }
    }
    LDS_BAR();
#pragma unroll
    for (int it = 0; it < 2; ++it) { const int idx = tid + 512 * it, fr = idx >> 6, ln = idx & 63, ti = fr >> 2, s = fr & 3;
        *(v4u*)(sb.wF + ((size_t)(un * 16 + fr) * 64 + ln) * 8) = *(const LAS v4u*)(L + WT + (16 * ti + (ln & 15)) * 272 + (32 * s + 8 * (ln >> 4)) * 2); }
    LDS_BAR();
}
__device__ __forceinline__ void gdn_prep_invert_blocked(const Frame& F, int nslots) {
    LAS unsigned char* L = F.lds + RING_OFF;
    int zv = 0; asm volatile("" : "+v"(zv));
    const int tid = F.tid + zv, lane = tid & 63, wave = F.wave, q = lane >> 4, l15 = lane & 15;
    if (wave < nslots) {
        const LAS float* Af = (const LAS float*)(L + wave * PA_SLOT); LAS float* Tf = (LAS float*)(L + PA_IMG + wave * 16384);
        float t[16];
#pragma unroll
        for (int i = 0; i < 16; ++i) {
            const LAS float* rp = Af + (16 * q + i) * 68 + 16 * q; f32x4 ar[4];
#pragma unroll
            for (int jb = 0; jb < 4; ++jb) if (4 * jb < i) ar[jb] = *(const LAS f32x4*)(rp + 4 * jb);
            float acc = (l15 == i) ? 1.f : 0.f;
#pragma unroll
            for (int j = 0; j < i; ++j) acc -= ar[j >> 2][j & 3] * t[j];
            t[i] = acc;
        }
#pragma unroll
        for (int i = 0; i < 16; ++i) Tf[(16 * q + i) * 64 + 16 * q + l15] = t[i];
    }
    LDS_BAR();
#pragma unroll
    for (int d = 1; d < 4; ++d) {
        const int per = 4 - d, total = nslots * per;
#pragma unroll 1
        for (int job = wave; job < total; job += NWAVES) {
            const int slot = job / per, b = job - slot * per, a = b + d;
            const LAS float* Af = (const LAS float*)(L + slot * PA_SLOT); LAS float* Tf = (LAS float*)(L + PA_IMG + slot * 16384);
            f32x4 acc = (f32x4){0.f, 0.f, 0.f, 0.f};
            float ta[4];
#pragma unroll
            for (int s4 = 0; s4 < 4; ++s4) ta[s4] = Tf[(16 * a + l15) * 64 + 16 * a + 4 * q + s4];
#pragma unroll
            for (int cc = 0; cc < 3; ++cc) if (cc < d) {
                const int c = b + cc; float la[4], tb[4];
#pragma unroll
                for (int s4 = 0; s4 < 4; ++s4) { la[s4] = Af[(16 * a + l15) * 68 + 16 * c + 4 * s4 + q]; tb[s4] = Tf[(16 * c + 4 * s4 + q) * 64 + 16 * b + l15]; }
                __builtin_amdgcn_sched_barrier(0);
#pragma unroll
                for (int s4 = 0; s4 < 4; ++s4) acc = __builtin_amdgcn_mfma_f32_16x16x4f32(la[s4], tb[s4], acc, 0, 0, 0); }
            f32x4 res = (f32x4){0.f, 0.f, 0.f, 0.f};
#pragma unroll
            for (int s4 = 0; s4 < 4; ++s4) res = __builtin_amdgcn_mfma_f32_16x16x4f32(-ta[s4], acc[s4], res, 0, 0, 0);
#pragma unroll
            for (int r = 0; r < 4; ++r) Tf[(16 * a + 4 * q + r) * 64 + 16 * b + l15] = res[r];
        }
        LDS_BAR();
    }
    for (int idx = tid; idx < nslots * 4096; idx += NWAVES * 64) { const int slot = idx >> 12, e = idx & 4095, i = e >> 6, c = e & 63;
        const float v = ((c >> 4) <= (i >> 4)) ? ((const LAS float*)(L + PA_IMG + slot * 16384))[e] : 0.f;
        ((LAS bf16*)(L + slot * PA_SLOT))[i * 72 + c] = (bf16)f2bf(v); }
    VM_WAIT();
    LDS_BAR();
}
__device__ __forceinline__ void gdn_prep_all(const Frame& F, const bf16* P, const float* AB, const float* conv_w, const float* a_log, const float* dt_bias, const ScanBufs sb) {
    PrepIn I{};
    if (F.vcu < NUNIT) gdn_prep_issue(I, F.vcu, F.tid, P, AB, conv_w);
#pragma unroll 1
    for (int u0 = F.vcu; u0 < NUNIT; u0 += F.G * PREP_B) {
#pragma unroll 1
        for (int s = 0; s < PREP_B; ++s) { const int un = u0 + s * F.G; const int nx = un + F.G < NUNIT ? un + F.G : un;
            if (un < NUNIT) gdn_prep_a(F, un, s, I, nx, P, AB, conv_w, a_log, dt_bias, sb); }
        { int ns = 0;
#pragma unroll
          for (int k = 0; k < PREP_B; ++k) ns += (u0 + k * F.G < NUNIT) ? 1 : 0;
          gdn_prep_invert_blocked(F, ns); }
#pragma unroll 1
        for (int s = 0; s < PREP_B; ++s) { const int un = u0 + s * F.G; if (un < NUNIT) gdn_prep_c(F, un, s, sb); }
    }
}
constexpr int SCAN_D = 4;
__device__ __forceinline__ void gdn_scan_unit(const Frame& F, int h, int sl, const ScanBufs sb, float* Sout) {
    constexpr int SB_PITCH = 272, VN_PITCH = 144, SB_OFF = 0, VN_OFF = 16 * SB_PITCH;
    LAS unsigned char* L = F.lds + RING_OFF;
    const int lane = F.lane, wave = F.wave, quad = lane >> 4, l15 = lane & 15;
    for (int i = F.tid; i < (16 * SB_PITCH) / 4; i += NWAVES * 64) ((LAS unsigned*)(L + SB_OFF))[i] = 0u;
    __syncthreads();
    const LAS unsigned char* sfp = L + SB_OFF + l15 * SB_PITCH + quad * 16;
    const LAS unsigned char* vfp = L + VN_OFF + l15 * VN_PITCH + quad * 16;
    if (wave < 4) {
        const int ti = wave;
        f32x4 S0 = (f32x4){0.f, 0.f, 0.f, 0.f}, S1 = S0;
        bf16x8 wf[SCAN_D][4], kdf[SCAN_D][2][2]; f32x4 uf[SCAN_D]; float gl[SCAN_D];
#define LOAD_C(un_, W, KD, U, G) do { \
        _Pragma("unroll") for (int s = 0; s < 4; ++s) W[s] = *(const bf16x8*)(sb.wF + ((size_t)((un_) * 16 + ti * 4 + s) * 64 + lane) * 8); \
        _Pragma("unroll") for (int d = 0; d < 2; ++d) _Pragma("unroll") for (int s2 = 0; s2 < 2; ++s2) KD[d][s2] = *(const bf16x8*)(sb.kdF + ((size_t)((un_) * 16 + (2 * ti + d) * 2 + s2) * 64 + lane) * 8); \
        U = *(const f32x4*)(sb.uF + ((size_t)(((un_) * 4 + ti) * 8 + sl) * 64 + lane) * 4); G = sb.egl[un_]; } while (0)
#pragma unroll
        for (int k = 0; k < SCAN_D; ++k) LOAD_C(h * 128 + k, wf[k], kdf[k], uf[k], gl[k]);
#pragma unroll 1
        for (int n0 = 0; n0 < 128; n0 += SCAN_D) {
#pragma unroll
            for (int k = 0; k < SCAN_D; ++k) {
                bf16x8 sf[4];
#pragma unroll
                for (int s = 0; s < 4; ++s) sf[s] = *(const LAS bf16x8*)(sfp + s * 64);
                __builtin_amdgcn_sched_barrier(0);
                f32x4 acc = __builtin_amdgcn_mfma_f32_16x16x32_bf16(wf[k][0], sf[0], (f32x4){0.f, 0.f, 0.f, 0.f}, 0, 0, 0), acc2 = __builtin_amdgcn_mfma_f32_16x16x32_bf16(wf[k][1], sf[1], (f32x4){0.f, 0.f, 0.f, 0.f}, 0, 0, 0);
                acc = __builtin_amdgcn_mfma_f32_16x16x32_bf16(wf[k][2], sf[2], acc, 0, 0, 0); acc2 = __builtin_amdgcn_mfma_f32_16x16x32_bf16(wf[k][3], sf[3], acc2, 0, 0, 0);
                const f32x4 vn = uf[k] - (acc + acc2);
                { v2u w; w.x = pk2(vn[0], vn[1]); w.y = pk2(vn[2], vn[3]); *(LAS v2u*)(L + VN_OFF + l15 * VN_PITCH + (16 * ti + 4 * quad) * 2) = w; }
                LDS_BAR();
                S0 = S0 * gl[k]; S1 = S1 * gl[k];
                { const bf16x8 vf0 = *(const LAS bf16x8*)(vfp), vf1 = *(const LAS bf16x8*)(vfp + 64);
                  __builtin_amdgcn_sched_barrier(0);
                  S0 = __builtin_amdgcn_mfma_f32_16x16x32_bf16(kdf[k][0][0], vf0, S0, 0, 0, 0); S1 = __builtin_amdgcn_mfma_f32_16x16x32_bf16(kdf[k][1][0], vf0, S1, 0, 0, 0);
                  S0 = __builtin_amdgcn_mfma_f32_16x16x32_bf16(kdf[k][0][1], vf1, S0, 0, 0, 0); S1 = __builtin_amdgcn_mfma_f32_16x16x32_bf16(kdf[k][1][1], vf1, S1, 0, 0, 0); }
                { v2u w; w.x = pk2(S0[0], S0[1]); w.y = pk2(S0[2], S0[3]); *(LAS v2u*)(L + SB_OFF + l15 * SB_PITCH + (16 * (2 * ti) + 4 * quad) * 2) = w;
                  w.x = pk2(S1[0], S1[1]); w.y = pk2(S1[2], S1[3]); *(LAS v2u*)(L + SB_OFF + l15 * SB_PITCH + (16 * (2 * ti + 1) + 4 * quad) * 2) = w; }
                { const int nn = n0 + k + SCAN_D < 128 ? n0 + k + SCAN_D : 127; LOAD_C(h * 128 + nn, wf[k], kdf[k], uf[k], gl[k]); }
                LDS_BAR();
            }
        }
#undef LOAD_C
#pragma unroll
        for (int e = 0; e < 4; ++e) { Sout[((size_t)h * 128 + 16 * (2 * ti) + 4 * quad + e) * 128 + 16 * sl + l15] = S0[e]; Sout[((size_t)h * 128 + 16 * (2 * ti + 1) + 4 * quad + e) * 128 + 16 * sl + l15] = S1[e]; }
    } else {
        bf16* snp = sb.snF + ((size_t)(h * 128) * 8 + sl) * 2048 + lane * 8;
        bf16* vnp = sb.vnF + ((size_t)(h * 128) * 8 + sl) * 1024 + lane * 8;
#pragma unroll 1
        for (int n = 0; n < 128; ++n) {
            if (wave == 4) {
                bf16x8 sf[4];
#pragma unroll
                for (int s = 0; s < 4; ++s) sf[s] = *(const LAS bf16x8*)(sfp + s * 64);
#pragma unroll
                for (int s = 0; s < 4; ++s) *(bf16x8*)(snp + (size_t)n * 8 * 2048 + s * 512) = sf[s];
            }
            LDS_BAR();
            if (wave == 5) {
                const bf16x8 vf0 = *(const LAS bf16x8*)(vfp), vf1 = *(const LAS bf16x8*)(vfp + 64);
                *(bf16x8*)(vnp + (size_t)n * 8 * 1024) = vf0; *(bf16x8*)(vnp + (size_t)n * 8 * 1024 + 512) = vf1;
            }
            LDS_BAR();
        }
    }
    __syncthreads();
}
struct OIn { bf16x8 snf[4], vnf[2]; v4u qe[2], qk, z[2]; };
__device__ __forceinline__ void opass_load(OIn& I, int un, int tid, int lane, int sl, const ScanBufs sb, const bf16* P) {
    const int h = un >> 7, n = un & 127;
#pragma unroll
    for (int s = 0; s < 4; ++s) I.snf[s] = *(const bf16x8*)(sb.snF + ((size_t)(un * 8 + sl) * 4 + s) * 512 + lane * 8);
#pragma unroll
    for (int s2 = 0; s2 < 2; ++s2) I.vnf[s2] = *(const bf16x8*)(sb.vnF + ((size_t)(un * 8 + sl) * 2 + s2) * 512 + lane * 8);
#pragma unroll
    for (int it = 0; it < 2; ++it) { const int idx = tid + 512 * it, tok = idx >> 4, c = idx & 15;
        I.qe[it] = *(const v4u*)(sb.qeF + (size_t)un * 8192 + idx * 8);
        I.z[it] = *(const v4u*)(P + (size_t)(64 * n + tok) * PW + C_ZG + h * 128 + c * 8); }
    I.qk = *(const v4u*)(sb.qkF + (size_t)un * 4096 + tid * 8);
}
__device__ __forceinline__ void gdn_opass_units(const Frame& F, int u0, int ustride, const ScanBufs sb, const bf16* P, const float* gnw, bf16* MIX) {
    constexpr int QE_OFF = 0, QK_OFF = 16384, Z_OFF = 24576, SS_OFF = 40960, Y_OFF = 43264, Y_PITCH = 272;
    LAS unsigned char* L = F.lds + RING_OFF;
    const int tid = F.tid, lane = F.lane, sl = F.wave, quad = lane >> 4, l15 = lane & 15;
    const float gw = gnw[16 * sl + l15];
    LAS float* ssq = (LAS float*)(L + SS_OFF);
    OIn C{}, N{}, N2{};
    if (u0 < NUNIT) { opass_load(C, u0, tid, lane, sl, sb, P); opass_load(N, u0 + ustride < NUNIT ? u0 + ustride : u0, tid, lane, sl, sb, P); }
#pragma unroll 1
    for (int un = u0; un < NUNIT; un += ustride) {
        const int h = un >> 7, n = un & 127, nx = un + 2 * ustride < NUNIT ? un + 2 * ustride : un;
#pragma unroll
        for (int it = 0; it < 2; ++it) { const int idx = tid + 512 * it, tok = idx >> 4, c = idx & 15;
            *(LAS v4u*)(L + QE_OFF + idx * 16) = C.qe[it]; *(LAS v4u*)(L + Z_OFF + tok * 256 + c * 16) = C.z[it]; }
        *(LAS v4u*)(L + QK_OFF + tid * 16) = C.qk;
        LDS_BAR();
        opass_load(N2, nx, tid, lane, sl, sb, P);
        f32x4 acc[4];
#pragma unroll
        for (int ti = 0; ti < 4; ++ti) {
            bf16x8 a[6];
#pragma unroll
            for (int s = 0; s < 4; ++s) a[s] = *(const LAS bf16x8*)(L + QE_OFF + ((ti * 4 + s) * 64 + lane) * 16);
#pragma unroll
            for (int s2 = 0; s2 < 2; ++s2) a[4 + s2] = *(const LAS bf16x8*)(L + QK_OFF + ((ti * 2 + s2) * 64 + lane) * 16);
            __builtin_amdgcn_sched_barrier(0);
            f32x4 x = __builtin_amdgcn_mfma_f32_16x16x32_bf16(a[0], C.snf[0], (f32x4){0.f, 0.f, 0.f, 0.f}, 0, 0, 0), y = __builtin_amdgcn_mfma_f32_16x16x32_bf16(a[1], C.snf[1], (f32x4){0.f, 0.f, 0.f, 0.f}, 0, 0, 0);
            x = __builtin_amdgcn_mfma_f32_16x16x32_bf16(a[2], C.snf[2], x, 0, 0, 0); y = __builtin_amdgcn_mfma_f32_16x16x32_bf16(a[3], C.snf[3], y, 0, 0, 0);
            x = __builtin_amdgcn_mfma_f32_16x16x32_bf16(a[4], C.vnf[0], x, 0, 0, 0); y = __builtin_amdgcn_mfma_f32_16x16x32_bf16(a[5], C.vnf[1], y, 0, 0, 0);
            acc[ti] = x + y;
        }
#pragma unroll
        for (int ti = 0; ti < 4; ++ti)
#pragma unroll
            for (int r = 0; r < 4; ++r) { const float v = sum16(acc[ti][r] * acc[ti][r]); if (l15 == 0) ssq[(16 * ti + 4 * quad + r) * 8 + sl] = v; }
        LDS_BAR();
        if (tid < 64) {
            const f32x4 p0 = *(const LAS f32x4*)(ssq + tid * 8), p1 = *(const LAS f32x4*)(ssq + tid * 8 + 4);
            ssq[512 + tid] = rsqrtf((((p0.x + p0.y) + (p0.z + p0.w)) + ((p1.x + p1.y) + (p1.z + p1.w))) * (1.f / 128.f) + NORM_EPS); }
        LDS_BAR();
#pragma unroll
        for (int ti = 0; ti < 4; ++ti)
#pragma unroll
            for (int r = 0; r < 4; ++r) { const int tok = 16 * ti + 4 * quad + r;
                const float rs = ssq[512 + tok];
                const float z = bf2f(*(const LAS bf16*)(L + Z_OFF + tok * 256 + (16 * sl + l15) * 2));
                const float yv = acc[ti][r] * rs * gw * silu_f(z);
                *(LAS bf16*)(L + Y_OFF + tok * Y_PITCH + (16 * sl + l15) * 2) = (bf16)pg8::cvt_pk_bf16(yv, yv); }
        LDS_BAR();
#pragma unroll
        for (int it = 0; it < 2; ++it) { const int idx = tid + 512 * it, tok = idx >> 4, c = idx & 15;
            *(v4u*)(MIX + (size_t)(64 * n + tok) * DM + 2048 + h * 128 + c * 8) = *(const LAS v4u*)(L + Y_OFF + tok * Y_PITCH + c * 16); }
        LDS_BAR();
        C = N; N = N2;
    }
}
struct SampIn { f32x4 S[8]; float in[11]; float z0, z1; };
__device__ __forceinline__ void samp_load(SampIn& I, int u, int tid, int lane, int wave, const bf16* P, const float* AB, const float* state_conv, const float* conv_w, const float* a_log, const float* dt_bias, const float* S0p) {
    const int b = u >> 4, h = u & 15, rg = tid >> 5, jv = tid & 31;
#pragma unroll
    for (int i = 0; i < 8; ++i) I.S[i] = *(const f32x4*)(S0p + ((size_t)u * 128 + 8 * rg + i) * 128 + 4 * jv);
    const bool cv = tid < 384, gt = !cv && tid < 388;
    const int part = cv ? tid >> 7 : 0, ch = tid & 127, c = part * 2048 + h * 128 + ch;
    const size_t grow = (size_t)TP + 4 * b + (gt ? tid - 384 : 0);
    const float* f[7];
#pragma unroll
    for (int r = 0; r < 3; ++r) f[r] = state_conv + ((size_t)b * 3 + r) * 6144 + c;
#pragma unroll
    for (int i = 0; i < 4; ++i) f[3 + i] = conv_w + (size_t)i * 6144 + c;
    if (gt) { f[0] = AB + grow * 32 + h; f[1] = AB + grow * 32 + 16 + h; f[2] = a_log + h; f[3] = dt_bias + h; }
    I.in[0] = *f[0]; I.in[1] = *f[1]; I.in[2] = *f[2];
#pragma unroll
    for (int t = 0; t < 4; ++t) I.in[3 + t] = bf2f(P[(size_t)(TP + 4 * b + t) * PW + C_QKVG + c]);
    I.in[7] = *f[3]; I.in[8] = *f[4]; I.in[9] = *f[5]; I.in[10] = *f[6];
    const size_t zrow = (size_t)TP + 4 * b + (wave & 3); I.z0 = bf2f(P[zrow * PW + C_ZG + h * 128 + lane]); I.z1 = bf2f(P[zrow * PW + C_ZG + h * 128 + lane + 64]);
}
__device__ __forceinline__ void gdn_sample_units(const Frame& F, int u0, int ustride, const bf16* P, const float* AB, const float* state_conv, const float* conv_w, const float* a_log, const float* dt_bias,
                                                 const float* gnw, const float* S0p, float* Sout, bf16* MIX) {
    LAS float* xs = (LAS float*)(F.lds + RING_OFF);
    LAS float* gs = xs + 1536; LAS float* bs = gs + 4;
    LAS float* red = xs + 2048;
    LAS float* opart = red + 2048;
    const int tid = F.tid, lane = F.lane, wave = F.wave, rg = tid >> 5, jv = tid & 31;
    const float gn0 = gnw[lane], gn1 = gnw[lane + 64];
    SampIn C{}, N{};
    if (u0 < NSB * 16) samp_load(C, u0, tid, lane, wave, P, AB, state_conv, conv_w, a_log, dt_bias, S0p);
#pragma unroll 1
    for (int u = u0; u < NSB * 16; u += ustride) {
        const int b = u >> 4, h = u & 15, un = u + ustride < NSB * 16 ? u + ustride : u;
        if (tid < 384) {
            const int part = tid >> 7, ch = tid & 127;
#pragma unroll
            for (int t = 0; t < 4; ++t) xs[(part * 4 + t) * 128 + ch] = silu_f(C.in[t] * C.in[7] + C.in[t + 1] * C.in[8] + C.in[t + 2] * C.in[9] + C.in[t + 3] * C.in[10]);
        } else if (tid < 388) {
            const int t = tid - 384;
            gs[t] = __expf(-__expf(C.in[2]) * softplus_f(C.in[0] + C.in[7])); bs[t] = sigmoid_f(C.in[1]);
        }
        LDS_BAR();
        samp_load(N, un, tid, lane, wave, P, AB, state_conv, conv_w, a_log, dt_bias, S0p);
        { const int part = wave >> 2, t = wave & 3; LAS float* xv = xs + (part * 4 + t) * 128;
          const float v0 = xv[lane], v1 = xv[lane + 64];
          const float r = rsqrtf(wave_sum(v0 * v0 + v1 * v1) + NORM_EPS) * (part == 0 ? 0.08838834764831845f : 1.0f);
          xv[lane] = v0 * r; xv[lane + 64] = v1 * r; }
        LDS_BAR();
#pragma unroll
        for (int t = 0; t < 4; ++t) {
            const float a = gs[t], be = bs[t];
            const f32x4 k0 = *(const LAS f32x4*)(xs + (4 + t) * 128 + 8 * rg), k1 = *(const LAS f32x4*)(xs + (4 + t) * 128 + 8 * rg + 4);
            const f32x4 q0 = *(const LAS f32x4*)(xs + t * 128 + 8 * rg), q1 = *(const LAS f32x4*)(xs + t * 128 + 8 * rg + 4);
            const f32x4 v4 = *(const LAS f32x4*)(xs + (8 + t) * 128 + 4 * jv);
            f32x4 r4 = ((C.S[0] * k0.x + C.S[1] * k0.y) + (C.S[2] * k0.z + C.S[3] * k0.w)) + ((C.S[4] * k1.x + C.S[5] * k1.y) + (C.S[6] * k1.z + C.S[7] * k1.w));
            r4.x += __shfl_xor(r4.x, 32); r4.y += __shfl_xor(r4.y, 32); r4.z += __shfl_xor(r4.z, 32); r4.w += __shfl_xor(r4.w, 32);
            LAS f32x4* rb = (LAS f32x4*)(red + (t & 1) * 1024);
            if (lane < 32) rb[wave * 32 + jv] = r4;
            LDS_BAR();
            f32x4 rs = (rb[jv] + rb[32 + jv]) + (rb[64 + jv] + rb[96 + jv]); rs = rs + ((rb[128 + jv] + rb[160 + jv]) + (rb[192 + jv] + rb[224 + jv]));
            const f32x4 cvv = (v4 - rs * a) * be;
            const float kk[8] = {k0.x, k0.y, k0.z, k0.w, k1.x, k1.y, k1.z, k1.w}, qq[8] = {q0.x, q0.y, q0.z, q0.w, q1.x, q1.y, q1.z, q1.w};
            f32x4 o4 = (f32x4){0.f, 0.f, 0.f, 0.f};
#pragma unroll
            for (int i = 0; i < 8; ++i) { C.S[i] = C.S[i] * a + cvv * kk[i]; o4 = o4 + C.S[i] * qq[i]; }
            o4.x += __shfl_xor(o4.x, 32); o4.y += __shfl_xor(o4.y, 32); o4.z += __shfl_xor(o4.z, 32); o4.w += __shfl_xor(o4.w, 32);
            if (lane < 32) ((LAS f32x4*)(opart + (t * 8 + wave) * 128))[jv] = o4;
        }
#pragma unroll
        for (int i = 0; i < 8; ++i) *(f32x4*)(Sout + ((size_t)u * 128 + 8 * rg + i) * 128 + 4 * jv) = C.S[i];
        LDS_BAR();
        if (wave < 4) { const int t = wave; const size_t row = (size_t)TP + 4 * b + t;
            float o0 = 0.f, o1 = 0.f;
#pragma unroll
            for (int w = 0; w < 8; ++w) { o0 += opart[(t * 8 + w) * 128 + lane]; o1 += opart[(t * 8 + w) * 128 + lane + 64]; }
            const float r = rsqrtf(wave_sum(o0 * o0 + o1 * o1) * (1.f / 128.f) + NORM_EPS);
            MIX[row * DM + 2048 + h * 128 + lane] = (bf16)f2bf(o0 * r * gn0 * silu_f(C.z0));
            MIX[row * DM + 2048 + h * 128 + lane + 64] = (bf16)f2bf(o1 * r * gn1 * silu_f(C.z1)); }
        LDS_BAR();
        C = N;
    }
}
constexpr int ATT_KIMG = 0, ATT_VIMG = 69632, ATT_IMG_ROWS = 272;
constexpr int ATT_BTAB_OFF = MISC_OFF + 128;
__device__ __forceinline__ void attn_load_q(bf16x8 (&qf)[4], const bf16* qptr, int lane) {
#pragma unroll
    for (int s = 0; s < 4; ++s) qf[s] = *(const bf16x8*)(qptr + 32 * s + 8 * (lane >> 4));
}
__device__ __forceinline__ void attn_tile(LAS unsigned char* L, const LAS float* btab, const bf16x8 (&qf)[4], int kt0, int dist0, int jlo, int jhi, float sink, int g, bf16* optr, int lane) {
    const int quad = lane >> 4, l15 = lane & 15;
    f32x4 sc[9];
    bf16x8 kf[2][4];
#pragma unroll
    for (int s = 0; s < 4; ++s) kf[0][s] = *(const LAS bf16x8*)(L + ATT_KIMG + row_read_addr_16(lane, kt0, s));
#pragma unroll
    for (int i = 0; i < 9; ++i) {
        if (i + 1 < 9) {
#pragma unroll
            for (int s = 0; s < 4; ++s) kf[(i + 1) & 1][s] = *(const LAS bf16x8*)(L + ATT_KIMG + row_read_addr_16(lane, kt0 + i + 1, s)); }
        __builtin_amdgcn_sched_barrier(0);
        f32x4 a0 = __builtin_amdgcn_mfma_f32_16x16x32_bf16(kf[i & 1][0], qf[0], (f32x4){0.f, 0.f, 0.f, 0.f}, 0, 0, 0), a1 = __builtin_amdgcn_mfma_f32_16x16x32_bf16(kf[i & 1][1], qf[1], (f32x4){0.f, 0.f, 0.f, 0.f}, 0, 0, 0);
        a0 = __builtin_amdgcn_mfma_f32_16x16x32_bf16(kf[i & 1][2], qf[2], a0, 0, 0, 0); a1 = __builtin_amdgcn_mfma_f32_16x16x32_bf16(kf[i & 1][3], qf[3], a1, 0, 0, 0);
        sc[i] = a0 + a1;
        __builtin_amdgcn_sched_barrier(0);
    }
    float m = sink;
    const bool interior_free = (jlo <= 16 * (kt0 + 1)) && (jhi >= 16 * (kt0 + 8));
#pragma unroll
    for (int i = 0; i < 9; ++i) {
        if (i >= 1 && i <= 7 && interior_free) {
#pragma unroll
            for (int r = 0; r < 4; ++r) { const float v = sc[i][r] * 0.08838834764831845f + btab[g * 132 + dist0 - 16 * i - r]; sc[i][r] = v; m = fmaxf(m, v); }
        } else {
#pragma unroll
            for (int r = 0; r < 4; ++r) { const int dist = dist0 - 16 * i - r, j = 16 * (kt0 + i) + 4 * quad + r; const bool ok = dist >= 0 && dist <= 128 && j >= jlo && j < jhi;
                const float b = btab[g * 132 + (ok ? dist : 0)]; const float v = ok ? sc[i][r] * 0.08838834764831845f + b : -3.0e38f; sc[i][r] = v; m = fmaxf(m, v); }
        }
    }
    m = fmaxf(m, __shfl_xor(m, 16)); m = fmaxf(m, __shfl_xor(m, 32));
    float sum = 0.f;
#pragma unroll
    for (int i = 0; i < 9; ++i)
#pragma unroll
        for (int r = 0; r < 4; ++r) { const float pv = sc[i][r] > -1.0e38f ? __expf(sc[i][r] - m) : 0.f; sc[i][r] = pv; sum += pv; }
    sum += __shfl_xor(sum, 16); sum += __shfl_xor(sum, 32);
    const float inv = __builtin_amdgcn_rcpf(sum + __expf(sink - m));
    bf16x8 pf[5];
#pragma unroll
    for (int p = 0; p < 5; ++p) {
        const f32x4 a = sc[2 * p] * inv; const f32x4 b = (p < 4) ? sc[2 * p + 1 < 9 ? 2 * p + 1 : 8] * inv : (f32x4){0.f, 0.f, 0.f, 0.f};
        pf[p] = __builtin_bit_cast(bf16x8, (v4u){pg8::cvt_pk_bf16(a[0], a[1]), pg8::cvt_pk_bf16(a[2], a[3]), pg8::cvt_pk_bf16(b[0], b[1]), pg8::cvt_pk_bf16(b[2], b[3])});
    }
    const unsigned vbase = lds_addr(L) + ATT_VIMG; const unsigned q4 = (unsigned)l15 >> 2, p2 = (unsigned)lane & 3;
    const unsigned vrow = 16u * (unsigned)kt0 + 4u * (unsigned)quad + q4;
#pragma unroll
    for (int c = 0; c < 8; ++c) {
        const unsigned va = vbase + off_b(vrow, 2 * c + (p2 >> 1)) + 8 * (p2 & 1);
        s16x4 t0, t1, t2, t3, t4, t5, t6, t7, t8, t9;
        asm volatile("ds_read_b64_tr_b16 %0, %10\n\tds_read_b64_tr_b16 %1, %10 offset:4096\n\tds_read_b64_tr_b16 %2, %10 offset:8192\n\tds_read_b64_tr_b16 %3, %10 offset:12288\n\t"
                     "ds_read_b64_tr_b16 %4, %10 offset:16384\n\tds_read_b64_tr_b16 %5, %10 offset:20480\n\tds_read_b64_tr_b16 %6, %10 offset:24576\n\tds_read_b64_tr_b16 %7, %10 offset:28672\n\t"
                     "ds_read_b64_tr_b16 %8, %10 offset:32768\n\tds_read_b64_tr_b16 %9, %10 offset:36864\n\ts_waitcnt lgkmcnt(0)"
                     : "=&v"(t0), "=&v"(t1), "=&v"(t2), "=&v"(t3), "=&v"(t4), "=&v"(t5), "=&v"(t6), "=&v"(t7), "=&v"(t8), "=&v"(t9) : "v"(va) : "memory");
        f32x4 o = (f32x4){0.f, 0.f, 0.f, 0.f};
        o = __builtin_amdgcn_mfma_f32_16x16x32_bf16((bf16x8){t0[0], t0[1], t0[2], t0[3], t1[0], t1[1], t1[2], t1[3]}, pf[0], o, 0, 0, 0);
        o = __builtin_amdgcn_mfma_f32_16x16x32_bf16((bf16x8){t2[0], t2[1], t2[2], t2[3], t3[0], t3[1], t3[2], t3[3]}, pf[1], o, 0, 0, 0);
        o = __builtin_amdgcn_mfma_f32_16x16x32_bf16((bf16x8){t4[0], t4[1], t4[2], t4[3], t5[0], t5[1], t5[2], t5[3]}, pf[2], o, 0, 0, 0);
        o = __builtin_amdgcn_mfma_f32_16x16x32_bf16((bf16x8){t6[0], t6[1], t6[2], t6[3], t7[0], t7[1], t7[2], t7[3]}, pf[3], o, 0, 0, 0);
        o = __builtin_amdgcn_mfma_f32_16x16x32_bf16((bf16x8){t8[0], t8[1], t8[2], t8[3], t9[0], t9[1], t9[2], t9[3]}, pf[4], o, 0, 0, 0);
        v2u w; w.x = pk2(o[0], o[1]); w.y = pk2(o[2], o[3]);
        *(v2u*)(optr + 16 * c + 4 * quad) = w;
    }
}
__device__ __forceinline__ void attn_btab(const Frame& F, const float* rel_bias, int kvh) {
    LAS float* btab = (LAS float*)(F.lds + ATT_BTAB_OFF);
    for (int t = F.tid; t < 4 * 129; t += NWAVES * 64) { const int g = t / 129, d = t - g * 129; btab[g * 132 + d] = rel_bias[rel_bucket_dev(d) * 16 + kvh * 4 + g]; }
}
__device__ __forceinline__ void attn_prompt_unit(const Frame& F, int qb, int kvh, const bf16* P, const float* rel_bias, const float* sinks, bf16* MIX) {
    LAS unsigned char* L = F.lds + RING_OFF;
    const int tid = F.tid, lane = F.lane, wave = F.wave;
    attn_btab(F, rel_bias, kvh);
    const int krow0 = 128 * (qb - 1);
    {
        v4u kv[8], vv[8];
#pragma unroll
        for (int it = 0; it < 8; ++it) { const int cid = tid + 512 * it, row = cid >> 4, ch = cid & 15, gr = krow0 + row, gc = gr < 0 ? 0 : gr;
            kv[it] = *(const v4u*)(P + (size_t)gc * PW + C_KA + kvh * 128 + ch * 8); vv[it] = *(const v4u*)(P + (size_t)gc * PW + C_VA + kvh * 128 + ch * 8); }
#pragma unroll
        for (int it = 0; it < 8; ++it) { const int cid = tid + 512 * it, row = cid >> 4, ch = cid & 15; const bool ok = krow0 + row >= 0;
            *(LAS v4u*)(L + ATT_KIMG + off_b(row, ch)) = ok ? kv[it] : (v4u){0u, 0u, 0u, 0u}; *(LAS v4u*)(L + ATT_VIMG + off_b(row, ch)) = ok ? vv[it] : (v4u){0u, 0u, 0u, 0u}; }
    }
    if (tid < 256) { const int row = 256 + (tid >> 4), ch = tid & 15; *(LAS v4u*)(L + ATT_VIMG + off_b(row, ch)) = (v4u){0u, 0u, 0u, 0u}; *(LAS v4u*)(L + ATT_KIMG + off_b(row, ch)) = (v4u){0u, 0u, 0u, 0u}; }
    __syncthreads();
    const LAS float* btab = (const LAS float*)(F.lds + ATT_BTAB_OFF);
    const int quad = lane >> 4, l15 = lane & 15, g = wave >> 1, h = kvh * 4 + g; const float sink = sinks[h];
    bf16x8 qf[4], qn[4];
    attn_load_q(qf, P + (size_t)(128 * qb + 16 * ((wave & 1) * 4) + l15) * PW + C_QA + h * 128, lane);
#pragma unroll 1
    for (int k = 0; k < 4; ++k) { const int qt = (wave & 1) * 4 + k, row = 128 * qb + 16 * qt + l15;
        attn_load_q(qn, P + (size_t)(row + (k < 3 ? 16 : 0)) * PW + C_QA + h * 128, lane);
        attn_tile(L, btab, qf, qt, 128 + l15 - 4 * quad, qb == 0 ? 128 : 0, 256, sink, g, MIX + (size_t)row * DM + h * 128, lane);
#pragma unroll
        for (int s = 0; s < 4; ++s) qf[s] = qn[s]; }
    __syncthreads();
}
__device__ __forceinline__ void attn_sample_unit(const Frame& F, int b, int kvh, const bf16* P, const float* ck, const float* cv, const float* rel_bias, const float* sinks, bf16* MIX) {
    LAS unsigned char* L = F.lds + RING_OFF;
    const int tid = F.tid, lane = F.lane, wave = F.wave;
    attn_btab(F, rel_bias, kvh);
    {
        f32x4 c0[4], c1[4];
#pragma unroll
        for (int kv = 0; kv < 2; ++kv) {
            const float* src = kv ? cv : ck; const int img = kv ? ATT_VIMG : ATT_KIMG;
#pragma unroll
            for (int it = 0; it < 4; ++it) { const int cid = tid + 512 * it, row = cid >> 4, ch = cid & 15; const float* kp = src + ((size_t)(b * 128 + row) * 4 + kvh) * 128 + ch * 8;
                c0[it] = *(const f32x4*)kp; c1[it] = *(const f32x4*)(kp + 4); }
#pragma unroll
            for (int it = 0; it < 4; ++it) { const int cid = tid + 512 * it, row = cid >> 4, ch = cid & 15;
                *(LAS v4u*)(L + img + off_b(row, ch)) = (v4u){pk2(c0[it].x, c0[it].y), pk2(c0[it].z, c0[it].w), pk2(c1[it].x, c1[it].y), pk2(c1[it].z, c1[it].w)}; }
        }
        { const int cid = tid + 2048, row = cid >> 4, ch = cid & 15;
          v4u kv = (v4u){0u, 0u, 0u, 0u}, vv = kv;
          if (row < 132) { const size_t gr = (size_t)TP + 4 * b + (row - 128); kv = *(const v4u*)(P + gr * PW + C_KA + kvh * 128 + ch * 8); vv = *(const v4u*)(P + gr * PW + C_VA + kvh * 128 + ch * 8); }
          *(LAS v4u*)(L + ATT_KIMG + off_b(row, ch)) = kv; *(LAS v4u*)(L + ATT_VIMG + off_b(row, ch)) = vv; }
    }
    __syncthreads();
    if (wave == 0) {
        const LAS float* btab = (const LAS float*)(F.lds + ATT_BTAB_OFF);
        const int quad = lane >> 4, l15 = lane & 15, g = l15 >> 2, t = l15 & 3, h = kvh * 4 + g, row = TP + 4 * b + t;
        bf16x8 qf[4]; attn_load_q(qf, P + (size_t)row * PW + C_QA + h * 128, lane);
        attn_tile(L, btab, qf, 0, 128 + t - 4 * quad, 0, 132, sinks[h], g, MIX + (size_t)row * DM + h * 128, lane);
    }
    __syncthreads();
}
constexpr int N_PHASES = 10;
__global__ void __launch_bounds__(NWAVES * 64, 2) mega_fwd(Params p) {
    extern __shared__ __attribute__((aligned(16))) unsigned char lds[];
    Frame F;
    F.lds = (LAS unsigned char*)lds;
    F.MISC = (volatile LAS unsigned*)(F.lds + MISC_OFF);
    F.tid = threadIdx.x; F.lane = F.tid & 63; F.wave = __builtin_amdgcn_readfirstlane(F.tid >> 6);
    F.G = gridDim.x; { const int bx = blockIdx.x; F.vcu = (F.G % 8 == 0) ? (bx % 8) * (F.G / 8) + bx / 8 : bx; }
    unsigned char* ws = p.ws;
    F.ctl = (gu32*)(ws + WS_CTL);
    for (int u = F.tid; u < (LDS_BYTES - LDSCTL_OFF) / 4; u += NWAVES * 64) ((LAS unsigned*)(F.lds + LDSCTL_OFF))[u] = 0u;
    __syncthreads();
    XcdBarrier bar = xcd_barrier_post((unsigned*)(F.ctl + CW_BAR) + p.li * XCD_BAR_WORDS, F.MISC + 8);
    const int lo = p.ph_lo, hi = p.ph_hi;
#define IN(k) (lo <= (k) && (k) < hi)
#define BOTH(k) (IN(k) && IN((k) + 1))
#define GRID_BAR() xcd_barrier(bar)
#ifdef PROBE_A
    unsigned long long* stamps = (unsigned long long*)(p.ws + WS_QN);
#define STAMP(id) do { if (F.tid == 0) stamps[(size_t)blockIdx.x * 64 + (id)] = wall_clock64(); } while (0)
#else
#define STAMP(id) do {} while (0)
#endif
    STAMP(0);
    bf16* Win_t = (bf16*)(ws + WS_WIN); bf16* Wout_t = (bf16*)(ws + WS_WOUT); bf16* Wgu_t = (bf16*)(ws + WS_WGU); bf16* Wdn_t = (bf16*)(ws + WS_WDN);
    bf16* H = (bf16*)(ws + WS_H); bf16* MIX = (bf16*)(ws + WS_MIX); bf16* P = (bf16*)(ws + WS_P); bf16* ACT = (bf16*)(ws + WS_ACT);
    float* AB = (float*)(ws + WS_AB); bf16* MIXO = (bf16*)(ws + WS_MIXO); bf16* FFNO = (bf16*)(ws + WS_FFNO);
    bf16* SLAB = (bf16*)(ws + WS_VBG);
    const ScanBufs sb{(bf16*)(ws + WS_WF), (bf16*)(ws + WS_KDF), (bf16*)(ws + WS_QEF), (bf16*)(ws + WS_QKF), (float*)(ws + WS_UF), (float*)(ws + WS_EGL), ws + WS_VBG, (bf16*)(ws + WS_SNF), (bf16*)(ws + WS_VNF)};
    float* out = p.out;

    if (IN(0)) { p0_prologue(F, p); STAMP(1); if (BOTH(0)) GRID_BAR(); STAMP(2); }
    if (IN(1)) {
        pg8::Gemm g{H, Win_t, MROWS, PROJ_PAD, DM}; pg8::StaticOrder S; S.init(MROWS, PROJ_PAD, DM, F.G, (int)blockIdx.x);
        pg8::EpiProj E{P, AB, PW};
        pg8::gemm_phase<pg8::EpiProj, pg8::StaticOrder, true, true>(F.lds + RING_OFF, g, S, E);
        STAMP(3); if (BOTH(1)) GRID_BAR(); STAMP(4);
    }
    if (IN(2)) {
        if (p.pad & 1) ph_copy_states(F, P, p.in[2], p.in[3], out);
        STAMP(5);
        if (p.pad & 2) gdn_sample_units(F, F.vcu, F.G, P, AB, p.in[4], p.in[9], p.in[10], p.in[11], p.in[12], p.in[5], out + O_SGDN, MIX);
        STAMP(6);
        if (p.pad & 4) gdn_prep_all(F, P, AB, p.in[9], p.in[10], p.in[11], sb);
        STAMP(7); if (BOTH(2)) GRID_BAR(); STAMP(8);
    }
    if (IN(3)) {
        if (F.G == 256) {
            const int xcd = F.vcu >> 5, r = F.vcu & 31;
            if (r < 16) gdn_scan_unit(F, xcd * 2 + (r >> 3), r & 7, sb, out + O_PGDN);
            else { const int aw = xcd * 16 + (r - 16);
                for (int u = aw; u < 256; u += 128) attn_prompt_unit(F, u >> 2, u & 3, P, p.in[6], p.in[8], MIX);
                for (int u = aw; u < 512; u += 128) attn_sample_unit(F, u >> 2, u & 3, P, p.in[2], p.in[3], p.in[6], p.in[8], MIX);
                STAMP(24);
                w_up_convert(F, p, aw, 128); }
        } else {
            for (int su = F.vcu; su < 128; su += F.G) gdn_scan_unit(F, su >> 3, su & 7, sb, out + O_PGDN);
            for (int u = F.vcu; u < 256; u += F.G) attn_prompt_unit(F, u >> 2, u & 3, P, p.in[6], p.in[8], MIX);
            for (int u = F.vcu; u < 512; u += F.G) attn_sample_unit(F, u >> 2, u & 3, P, p.in[2], p.in[3], p.in[6], p.in[8], MIX);
            w_up_convert(F, p, F.vcu, F.G);
        }
        STAMP(9); if (BOTH(3)) GRID_BAR(); STAMP(10);
    }
    if (IN(4)) { gdn_opass_units(F, F.vcu, F.G, sb, P, p.in[12], MIX); STAMP(11); if (BOTH(4)) GRID_BAR(); STAMP(12); }
    if (IN(5)) {
        pg8::Gemm g{MIX, Wout_t, MROWS, DM, DM}; pg8::SplitTailOrder S; S.init(TP, NSB * NST, DM, DM, F.G, (int)blockIdx.x);
        pg8::EpiBfSlab E{MIXO, DM, SLAB, TP / 256, DM / 64, (size_t)NSB * NST * DM};
        pg8::gemm_phase<pg8::EpiBfSlab, pg8::SplitTailOrder, true, true>(F.lds + RING_OFF, g, S, E);
        STAMP(13); if (BOTH(5)) GRID_BAR(); STAMP(14);
    }
    if (IN(6)) { ph_postmix(F, p, MIXO, SLAB, out, H); STAMP(15); if (BOTH(6)) GRID_BAR(); STAMP(16); }
    if (IN(7)) {
        pg8::Gemm g{H, Wgu_t, MROWS, NGU, DM}; pg8::StaticOrder S; S.init(MROWS, NGU, DM, F.G, (int)blockIdx.x);
        pg8::EpiSwiGLU E{ACT, FF};
        pg8::gemm_phase<pg8::EpiSwiGLU, pg8::StaticOrder, true, true>(F.lds + RING_OFF, g, S, E);
        STAMP(17);
        { const int n12 = S.nwg % F.G, c = (int)blockIdx.x;
          if (n12 == 0) { w_down_convert(F, p, c, F.G); copy_cache_rows(F, p.in[2], p.in[3], out, c, F.G); }
          else if (c >= n12) { w_down_convert(F, p, c - n12, F.G - n12); copy_cache_rows(F, p.in[2], p.in[3], out, c - n12, F.G - n12); } }
        STAMP(18); if (BOTH(7)) GRID_BAR(); STAMP(19);
    }
    if (IN(8)) {
        pg8::Gemm g{ACT, Wdn_t, MROWS, DM, FF}; pg8::SplitTailOrder S; S.init(TP, NSB * NST, DM, FF, F.G, (int)blockIdx.x);
        pg8::EpiBfSlab E{FFNO, DM, SLAB, TP / 256, FF / 64, (size_t)NSB * NST * DM};
        pg8::gemm_phase<pg8::EpiBfSlab, pg8::SplitTailOrder, true, true>(F.lds + RING_OFF, g, S, E);
        STAMP(20); if (BOTH(8)) GRID_BAR(); STAMP(21);
    }
    if (IN(9)) ph_final(F, FFNO, SLAB, p.in[17], out);
#ifdef PROBE_A
    STAMP(22); GRID_BAR(); STAMP(23);
    if (blockIdx.x == 0 && F.tid == 0) {
        double acc = (PROBE_MODE == 2) ? 1e30 : 0.0; int cnt = 0;
        for (int b = 0; b < (int)gridDim.x; ++b) {
            const int vb = (gridDim.x % 8 == 0) ? (b % 8) * ((int)gridDim.x / 8) + b / 8 : b; const bool scanb = (vb & 31) < 16;
            if (PROBE_MODE == 0 && b != 0) continue; if (PROBE_MODE == 3 && !scanb) continue; if (PROBE_MODE == 4 && scanb) continue;
            const double d = (double)(long long)(stamps[(size_t)b * 64 + PROBE_B] - stamps[(size_t)b * 64 + PROBE_A]) * 0.01;
            if (PROBE_MODE == 2) acc = d < acc ? d : acc; else if (PROBE_MODE == 5) acc += d; else acc = d > acc ? d : acc; ++cnt; }
        if (PROBE_MODE == 5) acc /= cnt;
        out[O_SWK] = p.in[2][4 * 512] + (float)(acc / PROBE_DIV); }
#endif
#undef IN
#undef BOTH
#undef GRID_BAR
}
#ifndef MK_N_LAUNCHES
#define MK_N_LAUNCHES 1
#endif
extern "C" void kernel_launch(void* const* d_in, const int* in_sizes, int n_in, void* d_out, int out_size, void* d_ws, size_t ws_size, hipStream_t stream) {
    static int grid = 0;
    if (grid == 0) {
        if (n_in != 21 || out_size != (int)O_TOTAL || ws_size < WS_END) { fprintf(stderr, "kernel_launch: unexpected shapes (n_in %d, out %d, ws %zu < %zu)\n", n_in, out_size, ws_size, (size_t)WS_END); grid = -1; return; }
        int dev = 0, cus = 0;
        if (hipGetDevice(&dev) != hipSuccess || hipDeviceGetAttribute(&cus, hipDeviceAttributeMultiprocessorCount, dev) != hipSuccess) { grid = -1; return; }
        if (hipFuncSetAttribute((const void*)mega_fwd, hipFuncAttributeMaxDynamicSharedMemorySize, LDS_BYTES) != hipSuccess) { fprintf(stderr, "kernel_launch: hipFuncSetAttribute failed\n"); grid = -1; return; }
        int per_cu = 0; (void)hipOccupancyMaxActiveBlocksPerMultiprocessor(&per_cu, (const void*)mega_fwd, NWAVES * 64, LDS_BYTES); (void)hipGetLastError();
        grid = cus;
    }
    if (grid < 0) return;
    Params p{};
    for (int i = 0; i < 21; ++i) p.in[i] = (const float*)d_in[i];
    p.out = (float*)d_out; p.ws = (unsigned char*)d_ws;
#ifdef MK_PLAN
    const int plan[][3] = {MK_PLAN};
#else
    const int plan[][3] = {{0, N_PHASES, 7}};
#endif
    constexpr int nplan = (int)(sizeof(plan) / sizeof(plan[0]));
    static_assert((size_t)(CW_BAR + nplan * XCD_BAR_WORDS) * 4 <= CTL_ZERO_BYTES, "barrier words inside the control region");
    (void)hipMemsetAsync((char*)d_ws + WS_CTL, 0, (size_t)(CW_BAR + nplan * XCD_BAR_WORDS) * 4, stream);
    for (int li = 0; li < (int)(sizeof(plan) / sizeof(plan[0])); ++li) { p.ph_lo = plan[li][0]; p.ph_hi = plan[li][1]; p.li = li; p.pad = plan[li][2];
        hipLaunchKernelGGL(mega_fwd, dim3(grid), dim3(NWAVES * 64), LDS_BYTES, stream, p); }
}
```

```cpp
#include <hip/hip_runtime.h>
#include <cstdio>
#include <cstdint>
namespace pg8 {
#define PG8_LAS __attribute__((address_space(3)))
typedef unsigned short bf16_t;
typedef short bf16x8 __attribute__((ext_vector_type(8)));
typedef float f32x4 __attribute__((ext_vector_type(4)));
typedef unsigned u32x4 __attribute__((ext_vector_type(4)));
constexpr int BM = 256, BK = 64, HALF = 128, HTB = HALF * BK * 2  , STAGE_BYTES = 8 * HTB, NXCD = 8, WGM = 8;

__host__ __device__ __forceinline__ int lds_byte(int r, int c) { const int st = (r >> 4) * 2 + (c >> 5), rr = r & 15, cc = c & 31, ob = rr * 64 + cc * 2; return st * 1024 + (ob ^ (((ob >> 9) & 1) << 5)); }
__host__ __device__ __forceinline__ void stage_rc(int b, int& R, int& C) { const int st = b / 1024, sb = b % 1024, swz = sb ^ (((sb >> 9) & 1) << 5); R = (st >> 1) * 16 + swz / 64; C = (st & 1) * 32 + (swz % 64) / 2; }
__host__ __device__ __forceinline__ int perm32(int rho) { const int n = rho >> 4, i = rho & 15; return 8 * (i >> 2) + 4 * n + (i & 3); }

struct Unit { int pm, pn, k0, nk; };
struct Gemm { const bf16_t* A; const bf16_t* Bt; int M, N, K; };

struct StaticOrder {
    int nM, nN, nwg, G, c, ntf;
    __host__ __device__ void init(int M, int N, int K, int G_, int c_) { nM = M / BM; nN = N / BM; nwg = nM * nN; G = G_; c = c_; ntf = K / BK; }
    __host__ __device__ bool next(int i, Unit& u) const {
        const long L = (long)i * G + c; if (L >= nwg) return false;
        int wgid = (int)L; { const int q = nwg / NXCD, r = nwg % NXCD, xcd = wgid % NXCD, off = wgid / NXCD; wgid = (xcd < r ? xcd * (q + 1) : r * (q + 1) + (xcd - r) * q) + off; }
        const int nig = WGM * nN, gid = wgid / nig, fm = gid * WGM, gsz = (nM - fm) < WGM ? (nM - fm) : WGM;
        u.pm = fm + ((wgid % nig) % gsz); u.pn = (wgid % nig) / gsz; u.k0 = 0; u.nk = ntf; return true;
    }
    __device__ __forceinline__ void a_ready(const Unit&) const {}
    __device__ __forceinline__ void done(const Unit&) const {}
};
struct SplitTailOrder {
    StaticOrder base; int mp, ntail_items;
    __host__ __device__ void init(int Mprompt, int Msample, int N, int K, int G_, int c_) { base.init(Mprompt, N, K, G_, c_); mp = Mprompt / BM; ntail_items = (Msample / BM) * (N / BM) * 8; }
    __host__ __device__ bool next(int i, Unit& u) const {
        Unit t; t.pm = 0; t.pn = 0; t.k0 = 0; t.nk = base.ntf; const bool full = base.next(i, t);
        const int nb = (base.nwg - base.c + base.G - 1) / base.G;
        const int item = (i - nb) * base.G + base.c; const bool tail = !full && i >= nb && item < ntail_items;
        const int tt = item >> 3, sp = item & 7, per = (base.ntf / 16) * 2, rem = (base.ntf - 8 * per) / 2;
        u.pm = full ? t.pm : mp + tt / base.nN; u.pn = full ? t.pn : tt % base.nN; u.nk = full ? t.nk : per + (sp < rem ? 2 : 0); u.k0 = full ? 0 : sp * per + 2 * (sp < rem ? sp : rem);
        return full || tail;
    }
    __device__ __forceinline__ void a_ready(const Unit&) const {}
    __device__ __forceinline__ void done(const Unit&) const {}
};
__device__ __forceinline__ unsigned cvt_pk_bf16(float lo, float hi) { unsigned r; asm volatile("v_cvt_pk_bf16_f32 %0, %1, %2" : "=v"(r) : "v"(lo), "v"(hi)); return r; }
typedef float f32x2 __attribute__((ext_vector_type(2)));
__device__ __forceinline__ float silu_f(float x) { return x * __builtin_amdgcn_rcpf(1.0f + __expf(-x)); }
struct EpiProj {
    static constexpr bool PERM = true, AFTER_DRAIN = false;
    bf16_t* P; float* AB; int ldp;
    __device__ __forceinline__ void operator()(const f32x4 (&acc)[2][2][4][2], const Unit& u, int wr, int wc, int fr, int fq) const {
        const int row0 = u.pm * BM + wr * 64 + fr;
        if (u.pn < 44) {
            const int col0 = u.pn * BM + wc * 32 + 8 * fq;
#pragma unroll
            for (int ai = 0; ai < 2; ++ai)
#pragma unroll
                for (int m = 0; m < 4; ++m) { bf16_t* rowp = P + (size_t)(row0 + ai * HALF + m * 16) * ldp + col0;
#pragma unroll
                    for (int bj = 0; bj < 2; ++bj) { const f32x4 v0 = acc[ai][bj][m][0], v1 = acc[ai][bj][m][1];
                        u32x4 w; w.x = cvt_pk_bf16(v0[0], v0[1]); w.y = cvt_pk_bf16(v0[2], v0[3]); w.z = cvt_pk_bf16(v1[0], v1[1]); w.w = cvt_pk_bf16(v1[2], v1[3]);
                        *(u32x4*)(rowp + bj * HALF) = w; } }
        } else if (wc == 0) {
#pragma unroll
            for (int ai = 0; ai < 2; ++ai)
#pragma unroll
                for (int m = 0; m < 4; ++m) { float* rp = AB + (size_t)(row0 + ai * HALF + m * 16) * 32 + 8 * fq;
                    *(f32x4*)(rp) = acc[ai][0][m][0]; *(f32x4*)(rp + 4) = acc[ai][0][m][1]; }
        }
    }
};
struct EpiBfSlab {
    static constexpr bool PERM = true, AFTER_DRAIN = false;
    bf16_t* C; int ldc; bf16_t* slab; int mp, ntf; size_t slab_stride;
    __device__ __forceinline__ void operator()(const f32x4 (&acc)[2][2][4][2], const Unit& u, int wr, int wc, int fr, int fq) const {
        const int col0 = u.pn * BM + wc * 32 + 8 * fq, row0 = u.pm * BM + wr * 64 + fr;
        if (u.nk == ntf) {
#pragma unroll
            for (int ai = 0; ai < 2; ++ai)
#pragma unroll
                for (int m = 0; m < 4; ++m) { bf16_t* rowp = C + (size_t)(row0 + ai * HALF + m * 16) * ldc + col0;
#pragma unroll
                    for (int bj = 0; bj < 2; ++bj) { const f32x4 v0 = acc[ai][bj][m][0], v1 = acc[ai][bj][m][1];
                        u32x4 w; w.x = cvt_pk_bf16(v0[0], v0[1]); w.y = cvt_pk_bf16(v0[2], v0[3]); w.z = cvt_pk_bf16(v1[0], v1[1]); w.w = cvt_pk_bf16(v1[2], v1[3]);
                        *(u32x4*)(rowp + bj * HALF) = w; } }
        } else {
            const int per = (ntf / 16) * 2, rem = (ntf - 8 * per) / 2; const int sp = u.k0 < rem * (per + 2) ? u.k0 / (per + 2) : rem + (u.k0 - rem * (per + 2)) / per;
            bf16_t* Cb = slab + (size_t)sp * slab_stride; const int r0 = row0 - mp * BM;
#pragma unroll
            for (int ai = 0; ai < 2; ++ai)
#pragma unroll
                for (int m = 0; m < 4; ++m) { bf16_t* rowp = Cb + (size_t)(r0 + ai * HALF + m * 16) * ldc + col0;
#pragma unroll
                    for (int bj = 0; bj < 2; ++bj) { const f32x4 v0 = acc[ai][bj][m][0], v1 = acc[ai][bj][m][1];
                        u32x4 w; w.x = cvt_pk_bf16(v0[0], v0[1]); w.y = cvt_pk_bf16(v0[2], v0[3]); w.z = cvt_pk_bf16(v1[0], v1[1]); w.w = cvt_pk_bf16(v1[2], v1[3]);
                        *(u32x4*)(rowp + bj * HALF) = w; } }
        }
    }
};
struct EpiSwiGLU {
    static constexpr bool PERM = true, AFTER_DRAIN = false;
    bf16_t* O; int ldc;
    __device__ __forceinline__ void operator()(const f32x4 (&acc)[2][2][4][2], const Unit& u, int wr, int wc, int fr, int fq) const {
        const int row0 = u.pm * BM + wr * 64 + fr, col0 = u.pn * HALF + wc * 32 + 8 * fq;
#pragma unroll
        for (int ai = 0; ai < 2; ++ai)
#pragma unroll
            for (int m = 0; m < 4; ++m) { bf16_t* rowp = O + (size_t)(row0 + ai * HALF + m * 16) * ldc + col0;
                const f32x4 g0 = acc[ai][0][m][0], g1 = acc[ai][0][m][1], u0 = acc[ai][1][m][0], u1 = acc[ai][1][m][1];
                u32x4 w; w.x = cvt_pk_bf16(silu_f(g0[0]) * u0[0], silu_f(g0[1]) * u0[1]); w.y = cvt_pk_bf16(silu_f(g0[2]) * u0[2], silu_f(g0[3]) * u0[3]);
                w.z = cvt_pk_bf16(silu_f(g1[0]) * u1[0], silu_f(g1[1]) * u1[1]); w.w = cvt_pk_bf16(silu_f(g1[2]) * u1[2], silu_f(g1[3]) * u1[3]);
                *(u32x4*)rowp = w; }
    }
};
template <class Epi, class Sched, bool ALIGN_EPI = false, bool SP2 = false>
__device__ __forceinline__ void gemm_phase(PG8_LAS unsigned char* lds, const Gemm g, const Sched& S, const Epi& E) {
    const int tid = threadIdx.x, wid = __builtin_amdgcn_readfirstlane(tid >> 6), lane = tid & 63, wr = wid >> 2, wc = wid & 3, fr = lane & 15, fq = lane >> 4;
    const int K = g.K;
    unsigned voffA[2], voffB[2];
#pragma unroll
    for (int i = 0; i < 2; ++i) { int R, C; stage_rc(tid * 16 + i * 8192, R, C); const int Rb = Epi::PERM ? ((R & ~31) + perm32(R & 31)) : R;
        voffA[i] = (unsigned)(R * K + C) * 2u; voffB[i] = (unsigned)(Rb * K + C) * 2u; }
    const size_t kstep = (size_t)(BK * 2);
    const size_t hstep = (size_t)HALF * K * 2;
    const size_t tstep = 2 * hstep;
    const unsigned ldsw = (unsigned)wid * 1024u;
    const int aoff = lds_byte(wr * 64 + fr, fq * 8), boff = lds_byte(wc * 32 + fr, fq * 8);
#define PG8_SA(b, h) (((b) * 2 + (h)) * HTB)
#define PG8_SB(b, h) ((4 + (b) * 2 + (h)) * HTB)
#define PG8_STAGE(bufoff, gbase, voff) do { _Pragma("unroll") for (int _i = 0; _i < 2; ++_i) \
        __builtin_amdgcn_global_load_lds((const unsigned*)((const char*)(gbase) + (voff)[_i]), (PG8_LAS unsigned*)(lds + (bufoff) + ldsw + _i * 8192), 16, 0, 0); } while (0)
#define PG8_LDA(dst, b, h) do { _Pragma("unroll") for (int m = 0; m < 4; ++m) _Pragma("unroll") for (int k = 0; k < 2; ++k) dst[m][k] = *(const PG8_LAS bf16x8*)(lds + PG8_SA(b, h) + aoff + m * 2048 + k * 1024); } while (0)
#define PG8_LDB(dst, b, h) do { _Pragma("unroll") for (int n = 0; n < 2; ++n) _Pragma("unroll") for (int k = 0; k < 2; ++k) dst[n][k] = *(const PG8_LAS bf16x8*)(lds + PG8_SB(b, h) + boff + n * 2048 + k * 1024); } while (0)
#define PG8_MMA(ai, bj, At, Bt) do { __builtin_amdgcn_s_setprio(1); _Pragma("unroll") for (int m = 0; m < 4; ++m) _Pragma("unroll") for (int n = 0; n < 2; ++n) _Pragma("unroll") for (int k = 0; k < 2; ++k) \
        acc[ai][bj][m][n] = __builtin_amdgcn_mfma_f32_16x16x32_bf16(Bt[n][k], At[m][k], acc[ai][bj][m][n], 0, 0, 0); __builtin_amdgcn_s_setprio(0); } while (0)
#define PG8_WAIT_V(n) asm volatile("s_waitcnt vmcnt(" #n ")" ::: "memory")
#define PG8_WAIT_L(n) asm volatile("s_waitcnt lgkmcnt(" #n ")" ::: "memory")
#define PG8_BAR __builtin_amdgcn_s_barrier()
#define PG8_SCHED __builtin_amdgcn_sched_barrier(0)
    Unit cur, nxt; int ui = 0;
    if (!S.next(0, cur)) return;
    f32x4 acc[2][2][4][2];
#pragma unroll
    for (int a = 0; a < 2; ++a)
#pragma unroll
        for (int b = 0; b < 2; ++b)
#pragma unroll
            for (int m = 0; m < 4; ++m)
#pragma unroll
                for (int n = 0; n < 2; ++n) acc[a][b][m][n] = (f32x4){0.f, 0.f, 0.f, 0.f};
    bf16x8 At[4][2], B0[2][2], B1[2][2];
    const char* cA = (const char*)g.A + (size_t)cur.pm * tstep + (size_t)cur.k0 * (BK * 2); const char* cB = (const char*)g.Bt + (size_t)cur.pn * tstep + (size_t)cur.k0 * (BK * 2);
    S.a_ready(cur);
    if constexpr (SP2) {
        PG8_STAGE(PG8_SB(0, 0), cB, voffB); PG8_STAGE(PG8_SB(0, 1), cB + hstep, voffB); PG8_STAGE(PG8_SA(0, 0), cA, voffA); PG8_STAGE(PG8_SA(0, 1), cA + hstep, voffA);
        if (wr == 1) PG8_BAR;
        PG8_WAIT_V(2); PG8_BAR;
        PG8_STAGE(PG8_SB(1, 0), cB + kstep, voffB); PG8_STAGE(PG8_SA(1, 0), cA + kstep, voffA); PG8_STAGE(PG8_SB(1, 1), cB + hstep + kstep, voffB);
        PG8_WAIT_V(6); PG8_BAR;
    } else {
        PG8_STAGE(PG8_SB(0, 0), cB, voffB); PG8_STAGE(PG8_SA(0, 0), cA, voffA); PG8_STAGE(PG8_SB(0, 1), cB + hstep, voffB); PG8_STAGE(PG8_SA(0, 1), cA + hstep, voffA);
        if (wr == 1) PG8_BAR;
        PG8_WAIT_V(4); PG8_BAR;
        PG8_STAGE(PG8_SB(1, 0), cB + kstep, voffB); PG8_STAGE(PG8_SA(1, 0), cA + kstep, voffA); PG8_STAGE(PG8_SB(1, 1), cB + hstep + kstep, voffB);
        PG8_WAIT_V(6); PG8_BAR;
    }
    for (;;) {
        const bool has_next = S.next(ui + 1, nxt);
        const char* nA = has_next ? (const char*)g.A + (size_t)nxt.pm * tstep + (size_t)nxt.k0 * (BK * 2) : cA; const char* nB = has_next ? (const char*)g.Bt + (size_t)nxt.pn * tstep + (size_t)nxt.k0 * (BK * 2) : cB;
        const int nt = cur.nk;
        for (int t = 0; t < nt; t += 2) {
            const bool last = (t == nt - 2);
            const char* a1 = cA + (size_t)(t + 1) * kstep;
            const char* a2 = last ? nA : cA + (size_t)(t + 2) * kstep; const char* b2 = last ? nB : cB + (size_t)(t + 2) * kstep;
            const char* a3 = a2 + kstep; const char* b3 = b2 + kstep;
            if (last && has_next) S.a_ready(nxt);
            if constexpr (SP2) {
            PG8_LDB(B0, 0, 0); PG8_LDB(B1, 0, 1); PG8_SCHED; PG8_LDA(At, 0, 0); PG8_STAGE(PG8_SA(1, 1), a1 + hstep, voffA);
            PG8_WAIT_V(8); PG8_WAIT_L(0); PG8_BAR; PG8_MMA(0, 0, At, B0); PG8_MMA(0, 1, At, B1); PG8_BAR; PG8_SCHED;
            PG8_LDA(At, 0, 1); PG8_STAGE(PG8_SB(0, 0), b2, voffB); PG8_STAGE(PG8_SB(0, 1), b2 + hstep, voffB); PG8_STAGE(PG8_SA(0, 0), a2, voffA);
            PG8_WAIT_V(8); PG8_WAIT_L(0); PG8_BAR; PG8_MMA(1, 0, At, B0); PG8_MMA(1, 1, At, B1); PG8_BAR; PG8_SCHED;
            PG8_LDB(B0, 1, 0); PG8_LDB(B1, 1, 1); PG8_SCHED; PG8_LDA(At, 1, 0); PG8_STAGE(PG8_SA(0, 1), a2 + hstep, voffA);
            PG8_WAIT_V(8); PG8_WAIT_L(0); PG8_BAR; PG8_MMA(0, 0, At, B0); PG8_MMA(0, 1, At, B1); PG8_BAR; PG8_SCHED;
            PG8_LDA(At, 1, 1); PG8_STAGE(PG8_SB(1, 0), b3, voffB); PG8_STAGE(PG8_SB(1, 1), b3 + hstep, voffB); PG8_STAGE(PG8_SA(1, 0), a3, voffA);
            PG8_WAIT_V(8); PG8_WAIT_L(0); PG8_BAR; PG8_MMA(1, 0, At, B0); PG8_MMA(1, 1, At, B1); PG8_BAR; PG8_SCHED;
            } else {
            PG8_LDB(B0, 0, 0); PG8_SCHED; PG8_LDA(At, 0, 0); PG8_STAGE(PG8_SA(1, 1), a1 + hstep, voffA);
            PG8_WAIT_L(8); PG8_BAR; PG8_WAIT_L(0); PG8_MMA(0, 0, At, B0); PG8_BAR; PG8_SCHED;
            PG8_LDB(B1, 0, 1); PG8_STAGE(PG8_SB(0, 0), b2, voffB);
            PG8_BAR; PG8_WAIT_L(0); PG8_MMA(0, 1, At, B1); PG8_BAR;
            PG8_LDA(At, 0, 1); PG8_STAGE(PG8_SA(0, 0), a2, voffA);
            PG8_BAR; PG8_WAIT_L(0); PG8_MMA(1, 0, At, B0); PG8_BAR; PG8_SCHED;
            PG8_STAGE(PG8_SB(0, 1), b2 + hstep, voffB);
            PG8_WAIT_V(6); PG8_BAR; PG8_MMA(1, 1, At, B1); PG8_BAR;
            PG8_LDB(B0, 1, 0); PG8_SCHED; PG8_LDA(At, 1, 0); PG8_STAGE(PG8_SA(0, 1), a2 + hstep, voffA);
            PG8_WAIT_L(8); PG8_BAR; PG8_WAIT_L(0); PG8_MMA(0, 0, At, B0); PG8_BAR; PG8_SCHED;
            PG8_LDB(B1, 1, 1); PG8_STAGE(PG8_SB(1, 0), b3, voffB);
            PG8_BAR; PG8_WAIT_L(0); PG8_MMA(0, 1, At, B1); PG8_BAR;
            PG8_LDA(At, 1, 1); PG8_STAGE(PG8_SA(1, 0), a3, voffA);
            PG8_BAR; PG8_WAIT_L(0); PG8_MMA(1, 0, At, B0); PG8_BAR; PG8_SCHED;
            PG8_STAGE(PG8_SB(1, 1), b3 + hstep, voffB);
            PG8_WAIT_V(6); PG8_BAR; PG8_MMA(1, 1, At, B1); PG8_BAR;
            }
        }
        if constexpr (ALIGN_EPI) { if (wr == 0) PG8_BAR; }
        if constexpr (!Epi::AFTER_DRAIN) { E(acc, cur, wr, wc, fr, fq); S.done(cur); }
        if (!has_next) break;
#pragma unroll
        for (int a = 0; a < 2; ++a)
#pragma unroll
            for (int b = 0; b < 2; ++b)
#pragma unroll
                for (int m = 0; m < 4; ++m)
#pragma unroll
                    for (int n = 0; n < 2; ++n) acc[a][b][m][n] = (f32x4){0.f, 0.f, 0.f, 0.f};
        cur = nxt; cA = nA; cB = nB; ++ui;
        if constexpr (ALIGN_EPI) { if (wr == 1) PG8_BAR; }
    }
    PG8_WAIT_V(0);
    if constexpr (!ALIGN_EPI) { if (wr == 0) PG8_BAR; }
    PG8_BAR;
    if constexpr (Epi::AFTER_DRAIN) { E.fused(acc, cur, wr, wc, fr, fq, lds, wid, lane); S.done(cur); }
#undef PG8_SA
#undef PG8_SB
#undef PG8_STAGE
#undef PG8_LDA
#undef PG8_LDB
#undef PG8_MMA
#undef PG8_WAIT_V
#undef PG8_WAIT_L
#undef PG8_BAR
#undef PG8_SCHED
}
}
constexpr int NWAVES = 8;
constexpr int DM = 4096, TP = 8192, NSB = 128, NST = 4, MROWS = TP + NSB * NST;
constexpr int PROJ_W = 11296, PROJ_PAD = 11520, PW = 11264;
constexpr int C_QA = 0, C_KA = 2048, C_VA = 2560, C_QKVG = 3072, C_ZG = 9216;
constexpr int FF = 11008, NGU = 2 * FF;
constexpr float NORM_EPS = 1e-6f;
constexpr size_t O_YP = 0, O_YS = 33554432, O_PWK = 35651584, O_PWV = 35717120, O_PCONV = 35782656, O_PGDN = 35801088,
                 O_SWK = 36063232, O_SWV = 44451840, O_SCONV = 52840448, O_SGDN = 55199744, O_TOTAL = 88754176;
constexpr size_t WS_CTL = 0, CTL_ZERO_BYTES = 1u << 20;
constexpr size_t WS_WIN = CTL_ZERO_BYTES;
constexpr size_t WS_WOUT = WS_WIN + (size_t)PROJ_PAD * DM * 2;
constexpr size_t WS_WGU = WS_WOUT + (size_t)DM * DM * 2;
constexpr size_t WS_WDN = WS_WGU + (size_t)NGU * DM * 2;
constexpr size_t WS_H = WS_WDN + (size_t)DM * FF * 2;
constexpr size_t WS_MIX = WS_H + (size_t)MROWS * DM * 2;
constexpr size_t WS_FFNO = WS_H;
constexpr size_t WS_P = WS_MIX + (size_t)MROWS * DM * 2;
constexpr size_t WS_MIXO = WS_P;
constexpr size_t WS_ACT = WS_P;
constexpr size_t WS_AB = WS_P + (size_t)MROWS * PW * 2;
constexpr size_t WS_QN = WS_AB + (size_t)MROWS * 32 * 4;
constexpr size_t WS_KN = WS_QN + (size_t)NSB * NST * 2048 * 4;
constexpr size_t WS_VN = WS_KN + (size_t)NSB * NST * 2048 * 4;
constexpr size_t WS_GB = WS_VN + (size_t)NSB * NST * 2048 * 4;
constexpr size_t WS_ORAW = WS_GB + (size_t)MROWS * 32 * 4;
constexpr int NUNIT = 16 * 128;
constexpr size_t WS_WF = WS_ORAW + (size_t)MROWS * 2048 * 4;
constexpr size_t WS_KDF = WS_WF + (size_t)NUNIT * 16384;
constexpr size_t WS_QEF = WS_KDF + (size_t)NUNIT * 16384;
constexpr size_t WS_QKF = WS_QEF + (size_t)NUNIT * 16384;
constexpr size_t WS_UF = WS_QKF + (size_t)NUNIT * 8192;
constexpr size_t WS_EGL = WS_UF + (size_t)NUNIT * 32768;
constexpr size_t WS_VBG = WS_EGL + (size_t)NUNIT * 4;
constexpr size_t WS_VNF = WS_VBG + (size_t)NUNIT * 32768;
constexpr size_t WS_END = WS_VNF + (size_t)NUNIT * 16384;
constexpr size_t WS_SNF = WS_ORAW;
static_assert((size_t)MROWS * DM * 4 <= 2 * (size_t)MROWS * DM * 2 && (size_t)MROWS * FF * 2 <= (size_t)MROWS * PW * 2, "overlays");
constexpr int CW_TMO = 0, CW_CODE = 1, CW_BAR = 4096;
constexpr int RING_OFF = 0, RING_BYTES = 139264;
constexpr int LDSCTL_OFF = RING_BYTES, MISC_OFF = LDSCTL_OFF + 320;
constexpr int LDS_BYTES = 147456;
#define GAS __attribute__((address_space(1)))
#define LAS __attribute__((address_space(3)))
typedef unsigned short bf16;
typedef unsigned v4u __attribute__((ext_vector_type(4)));
typedef unsigned v2u __attribute__((ext_vector_type(2)));
typedef float f32x4 __attribute__((ext_vector_type(4)));
typedef short bf16x8 __attribute__((ext_vector_type(8)));
typedef GAS unsigned gu32;
#define RLX_AGENT __ATOMIC_RELAXED, __HIP_MEMORY_SCOPE_AGENT
#define LDS_WAIT() asm volatile("s_waitcnt lgkmcnt(0)" ::: "memory")
#define VM_WAIT() asm volatile("s_waitcnt vmcnt(0)" ::: "memory")
#define LDS_BAR() do { asm volatile("s_waitcnt lgkmcnt(0)" ::: "memory"); __builtin_amdgcn_s_barrier(); asm volatile("" ::: "memory"); } while (0)
__device__ __forceinline__ unsigned f2bf(float f) { unsigned u = __builtin_bit_cast(unsigned, f); return (u + 0x7fffu + ((u >> 16) & 1u)) >> 16; }
__device__ __forceinline__ unsigned pk2(float lo, float hi) { return f2bf(lo) | (f2bf(hi) << 16); }
__device__ __forceinline__ float bf2f(unsigned short b) { return __builtin_bit_cast(float, ((unsigned)b) << 16); }
__device__ __forceinline__ float bflo(unsigned w) { return __builtin_bit_cast(float, w << 16); }
__device__ __forceinline__ float bfhi(unsigned w) { return __builtin_bit_cast(float, w & 0xffff0000u); }
__device__ __forceinline__ float wave_sum(float v) {
#pragma unroll
    for (int o = 1; o < 64; o <<= 1) v += __shfl_xor(v, o);
    return v;
}
__device__ __forceinline__ float wave_max(float v) {
#pragma unroll
    for (int o = 1; o < 64; o <<= 1) v = fmaxf(v, __shfl_xor(v, o));
    return v;
}
__device__ __forceinline__ float sigmoid_f(float x) { return __builtin_amdgcn_rcpf(1.0f + __expf(-x)); }
__device__ __forceinline__ float silu_f(float x) { return x * __builtin_amdgcn_rcpf(1.0f + __expf(-x)); }
__device__ __forceinline__ float softplus_f(float x) { return fmaxf(x, 0.f) + log1pf(__expf(-fabsf(x))); }
template <int CTRL> __device__ __forceinline__ float dpp_mov(float v) { return __builtin_bit_cast(float, __builtin_amdgcn_update_dpp(0, __builtin_bit_cast(int, v), CTRL, 0xf, 0xf, true)); }
__device__ __forceinline__ float sum16(float v) { v += dpp_mov<0xB1>(v); v += dpp_mov<0x4E>(v); v += dpp_mov<0x141>(v); v += dpp_mov<0x140>(v); return v; }
#define XB_TMO      128
#define XB_XCNT(j)  (256  + 64 * (j))
#define XB_XSUB(j)  (1280 + 64 * (j))
#define XB_XGEN(j)  (2304 + 64 * (j))
#define XB_TOP      3328
#define XB_TOPGEN   3392
#define XCD_BAR_WORDS 3456
#define XB_SPIN_CAP (1u << 18)

__device__ __forceinline__ unsigned xb_ld(unsigned* p)              { return __hip_atomic_load(p, __ATOMIC_RELAXED, __HIP_MEMORY_SCOPE_AGENT); }
__device__ __forceinline__ unsigned xb_add(unsigned* p, unsigned v) { return __hip_atomic_fetch_add(p, v, __ATOMIC_RELAXED, __HIP_MEMORY_SCOPE_AGENT); }
__device__ __forceinline__ unsigned xb_xcc_id() { return (unsigned)__builtin_amdgcn_s_getreg((3 << 11) | 20) & 0xFu; }
#define XB_SPIN(cond, bar) do { unsigned _sp = 0; while (cond) { __builtin_amdgcn_s_sleep(1); \
    if ((++_sp & 255u) == 0u) { if (xb_ld(&(bar)[XB_TMO])) break; if (_sp > XB_SPIN_CAP) { atomicAdd(&(bar)[XB_TMO], 1u); break; } } } } while (0)

struct XcdBarrier {
    unsigned* bar; unsigned x;
    volatile LAS unsigned* st;
};

__device__ __forceinline__ XcdBarrier xcd_barrier_post(unsigned* bar, volatile LAS unsigned* st) {
    XcdBarrier b; b.bar = bar; b.x = xb_xcc_id(); b.st = st;
    if (threadIdx.x == 0) (void)xb_add(&bar[XB_XCNT(b.x)], 1u);
    return b;
}
__device__ __forceinline__ void xcd_barrier_complete(unsigned* bar, unsigned x, unsigned& nloc, unsigned& nx) {
    const unsigned G = gridDim.x * gridDim.y * gridDim.z;
    unsigned sum, cnt, mine, sp = 0u;
    for (;;) {
        sum = 0u; cnt = 0u; mine = 0u;
#pragma unroll
        for (unsigned j = 0; j < 16; ++j) { const unsigned c = xb_ld(&bar[XB_XCNT(j)]); sum += c; cnt += (c > 0u) ? 1u : 0u; mine = (j == x) ? c : mine; }
        if (sum == G) break;
        __builtin_amdgcn_s_sleep(1);
        if ((++sp & 255u) == 0u) { if (xb_ld(&bar[XB_TMO])) break; if (sp > XB_SPIN_CAP) { atomicAdd(&bar[XB_TMO], 1u); break; } }
    }
    nloc = mine > 0u ? mine : 1u; nx = cnt > 0u ? cnt : 1u;
}

__device__ __forceinline__ void xcd_barrier(const XcdBarrier& b) {
    asm volatile("s_waitcnt vmcnt(0)" ::: "memory");
    __syncthreads();
    if (threadIdx.x == 0) {
        unsigned* bar = b.bar;
        __builtin_amdgcn_s_waitcnt(0);
        unsigned nloc = b.st[0], nx = b.st[1];
        if (nloc == 0u) { xcd_barrier_complete(bar, b.x, nloc, nx); b.st[0] = nloc; b.st[1] = nx; }
        const unsigned old = xb_add(&bar[XB_XSUB(b.x)], 1u);
        const unsigned gen = old / nloc;
        if (old + 1u == (gen + 1u) * nloc) {
            __builtin_amdgcn_fence(__ATOMIC_RELEASE, "agent");
            asm volatile("s_waitcnt vmcnt(0)" ::: "memory");
            const unsigned og = xb_add(&bar[XB_TOP], 1u);
            const unsigned tg = og / nx;
            if (og + 1u == (tg + 1u) * nx) xb_add(&bar[XB_TOPGEN], 1u);
            else XB_SPIN(xb_ld(&bar[XB_TOPGEN]) == tg, bar);
            __builtin_amdgcn_fence(__ATOMIC_ACQUIRE, "agent");
            xb_add(&bar[XB_XGEN(b.x)], 1u);
            asm volatile("s_waitcnt vmcnt(0)" ::: "memory");
        } else {
            XB_SPIN(xb_ld(&bar[XB_XGEN(b.x)]) == gen, bar);
            __builtin_amdgcn_fence(__ATOMIC_ACQUIRE, "agent");
            asm volatile("s_waitcnt vmcnt(0)" ::: "memory");
        }
    }
    __syncthreads();
}
struct Params {
    const float* in[21]; float* out; unsigned char* ws; int ph_lo, ph_hi, li, pad;
};
struct Frame {
    LAS unsigned char* lds;
    volatile LAS unsigned* MISC;
    gu32* ctl;
    int tid, lane, wave, vcu, G;
};
template <bool DEEP = false>
__device__ __forceinline__ void p0_transpose_item(const float* W, int K, int N, bf16* WT, int k0, int n0, int dst_row0, LAS float* scr, int lane) {
    if constexpr (DEEP) {
        float v[32];
#pragma unroll
        for (int i = 0; i < 32; ++i) v[i] = W[(size_t)(k0 + 2 * i + (lane >> 5)) * N + n0 + (lane & 31)];
#pragma unroll
        for (int i = 0; i < 32; ++i) scr[(2 * i + (lane >> 5)) * 33 + (lane & 31)] = v[i];
    } else {
#pragma unroll 8
        for (int i = 0; i < 32; ++i) { const int kk = 2 * i + (lane >> 5); scr[kk * 33 + (lane & 31)] = W[(size_t)(k0 + kk) * N + n0 + (lane & 31)]; }
    }
    LDS_WAIT(); asm volatile("" ::: "memory");
    const int c = lane & 7;
#pragma unroll
    for (int j = 0; j < 4; ++j) { const int n = (lane >> 3) + 8 * j; const LAS float* s = scr + (8 * c) * 33 + n;
        v4u o; o.x = pk2(s[0 * 33], s[1 * 33]); o.y = pk2(s[2 * 33], s[3 * 33]); o.z = pk2(s[4 * 33], s[5 * 33]); o.w = pk2(s[6 * 33], s[7 * 33]);
        *(GAS v4u*)(WT + (size_t)(dst_row0 + n) * K + k0 + 8 * c) = o; }
    LDS_WAIT(); asm volatile("" ::: "memory");
}
__device__ __forceinline__ const float* x_row(const Params& p, int m) { return m < TP ? p.in[0] + (size_t)m * DM : p.in[1] + (size_t)(m - TP) * DM; }
__device__ __forceinline__ void rms_row_to_bf16(const float* xrow, const float* w, bf16* orow, int lane) {
    const GAS f32x4* xr = (const GAS f32x4*)xrow + lane; const GAS f32x4* wr = (const GAS f32x4*)w + lane;
    f32x4 v[16]; float s = 0.f;
#pragma unroll
    for (int j = 0; j < 16; ++j) { v[j] = xr[64 * j]; s += (v[j].x * v[j].x + v[j].y * v[j].y) + (v[j].z * v[j].z + v[j].w * v[j].w); }
    const float r = rsqrtf(wave_sum(s) * (1.f / DM) + NORM_EPS);
    GAS v2u* o8 = (GAS v2u*)orow + lane;
#pragma unroll
    for (int j = 0; j < 16; ++j) { const f32x4 ww = wr[64 * j]; v2u o; o.x = pk2(v[j].x * r * ww.x, v[j].y * r * ww.y); o.y = pk2(v[j].z * r * ww.z, v[j].w * r * ww.w); o8[64 * j] = o; }
}
__device__ __forceinline__ void p0_prologue(Frame& F, const Params& p) {
    LAS float* scr = (LAS float*)(F.lds + RING_OFF + F.wave * 16384);
    const int gw = F.vcu * NWAVES + F.wave, NGW = F.G * NWAVES;
    unsigned char* ws = p.ws;
    bf16* Win_t = (bf16*)(ws + WS_WIN); bf16* Wout_t = (bf16*)(ws + WS_WOUT); bf16* Wgu_t = (bf16*)(ws + WS_WGU);
    constexpr int I_IN = (DM / 64) * (PROJ_W / 32), I_OUT = (DM / 64) * (DM / 32), I_G = (DM / 64) * (FF / 32);
    constexpr int NITEMS = I_IN + I_OUT + I_G;
    for (int it = gw; it < NITEMS; it += NGW) {
        int r = it;
        if (r < I_IN) { const int nb = r % (PROJ_W / 32), kb = r / (PROJ_W / 32); p0_transpose_item(p.in[7], DM, PROJ_W, Win_t, 64 * kb, 32 * nb, 32 * nb, scr, F.lane); continue; } r -= I_IN;
        if (r < I_OUT) { const int nb = r % (DM / 32), kb = r / (DM / 32); p0_transpose_item(p.in[13], DM, DM, Wout_t, 64 * kb, 32 * nb, 32 * nb, scr, F.lane); continue; } r -= I_OUT;
        { const int nb = r % (FF / 32), kb = r / (FF / 32), n0 = 32 * nb; p0_transpose_item(p.in[18], DM, FF, Wgu_t, 64 * kb, n0, 256 * (n0 >> 7) + (n0 & 127), scr, F.lane); }
    }
    { GAS v4u* z = (GAS v4u*)(Win_t + (size_t)PROJ_W * DM); const size_t n16 = (size_t)(PROJ_PAD - PROJ_W) * DM * 2 / 16;
      for (size_t i = (size_t)gw * 64 + F.lane; i < n16; i += (size_t)NGW * 64) z[i] = (v4u){0u, 0u, 0u, 0u}; }
    bf16* H = (bf16*)(ws + WS_H);
    for (int m = gw; m < MROWS; m += NGW) rms_row_to_bf16(x_row(p, m), p.in[14], H + (size_t)m * DM, F.lane);
}
__device__ __forceinline__ void w_down_convert(const Frame& F, const Params& p, int wi, int nw) {
    LAS float* scr = (LAS float*)(F.lds + RING_OFF + F.wave * 16384);
    bf16* Wdn_t = (bf16*)(p.ws + WS_WDN);
    constexpr int I_D = (FF / 64) * (DM / 32);
    for (int r = wi * NWAVES + F.wave; r < I_D; r += nw * NWAVES) { const int nb = r % (DM / 32), kb = r / (DM / 32); p0_transpose_item<true>(p.in[20], FF, DM, Wdn_t, 64 * kb, 32 * nb, 32 * nb, scr, F.lane); }
}
__device__ __forceinline__ void w_up_convert(const Frame& F, const Params& p, int wi, int nw) {
    LAS float* scr = (LAS float*)(F.lds + RING_OFF + F.wave * 16384);
    bf16* Wgu_t = (bf16*)(p.ws + WS_WGU);
    constexpr int I_G = (DM / 64) * (FF / 32);
    for (int r = wi * NWAVES + F.wave; r < I_G; r += nw * NWAVES) { const int nb = r % (FF / 32), kb = r / (FF / 32), n0 = 32 * nb; p0_transpose_item<true>(p.in[19], DM, FF, Wgu_t, 64 * kb, n0, 256 * (n0 >> 7) + 128 + (n0 & 127), scr, F.lane); }
}
__device__ __forceinline__ int rel_bucket_dev(int n) {
    if (n < 16) return n;
    int large = 16 + (int)(logf((float)n * 0.0625f) / 2.0794415416798357f * 16.0f);
    return large < 31 ? large : 31;
}
__device__ __forceinline__ f32x4 bf4_to_f32(v2u w) { return (f32x4){bflo(w.x), bfhi(w.x), bflo(w.y), bfhi(w.y)}; }
__device__ __forceinline__ void ph_copy_states(const Frame& F, const bf16* P, const float* ck, const float* cv, float* out) {
    const int gid = F.vcu * 512 + F.tid, gs = F.G * 512;
    for (int id = gid; id < NSB * 2 * 4 * 128; id += gs) { const int b = id >> 10, kv = (id >> 9) & 1, j = 124 + ((id >> 7) & 3), c4 = id & 127;
        ((f32x4*)(out + (kv ? O_SWV : O_SWK) + ((size_t)b * 128 + j) * 512))[c4] = bf4_to_f32(((const v2u*)(P + (size_t)(TP + 4 * b + (j - 124)) * PW + (kv ? C_VA : C_KA)))[c4]); }
    for (int id = gid; id < 2 * 128 * 128; id += gs) { const int kv = id >> 14, j = (id >> 7) & 127, c4 = id & 127;
        ((f32x4*)(out + (kv ? O_PWV : O_PWK) + (size_t)j * 512))[c4] = bf4_to_f32(((const v2u*)(P + (size_t)(TP - 128 + j) * PW + (kv ? C_VA : C_KA)))[c4]); }
    for (int id = gid; id < 3 * 1536; id += gs) { const int r = id / 1536, c4 = id - r * 1536;
        ((f32x4*)(out + O_PCONV + (size_t)r * 6144))[c4] = bf4_to_f32(((const v2u*)(P + (size_t)(TP - 3 + r) * PW + C_QKVG))[c4]); }
    for (int id = gid; id < NSB * 3 * 1536; id += gs) { const int br = id / 1536, c4 = id - br * 1536, b = br / 3, r = br - 3 * b;
        ((f32x4*)(out + O_SCONV + (size_t)br * 6144))[c4] = bf4_to_f32(((const v2u*)(P + (size_t)(TP + 4 * b + r + 1) * PW + C_QKVG))[c4]); }
}
__device__ __forceinline__ void copy_cache_rows(const Frame& F, const float* ck, const float* cv, float* out, int wi, int nw) {
    for (int id = wi * 512 + F.tid; id < NSB * 2 * 128 * 128; id += nw * 512) { const int b = id >> 15, kv = (id >> 14) & 1, j = (id >> 7) & 127, c4 = id & 127;
        if (j < 124) ((f32x4*)(out + (kv ? O_SWV : O_SWK) + ((size_t)b * 128 + j) * 512))[c4] = ((const f32x4*)((kv ? cv : ck) + ((size_t)b * 128 + j + 4) * 512))[c4]; }
}
__device__ __forceinline__ void ph_gated_norm(const Frame& F, const float* ORAW, const bf16* P, const float* gw, bf16* MIX, int row_lo, int row_hi) {
    const int lane = F.lane;
    const f32x4 g4 = ((const f32x4*)gw)[lane & 31];
    for (int row = row_lo + F.vcu * NWAVES + F.wave; row < row_hi; row += F.G * NWAVES) {
        f32x4 o[8]; v2u z[8];
#pragma unroll
        for (int i = 0; i < 8; ++i) { o[i] = ((const f32x4*)(ORAW + (size_t)row * 2048))[64 * i + lane]; z[i] = ((const v2u*)(P + (size_t)row * PW + C_ZG))[64 * i + lane]; }
#pragma unroll
        for (int i = 0; i < 8; ++i) {
            float ss = (o[i].x * o[i].x + o[i].y * o[i].y) + (o[i].z * o[i].z + o[i].w * o[i].w);
#pragma unroll
            for (int sh = 1; sh < 32; sh <<= 1) ss += __shfl_xor(ss, sh);
            const float r = rsqrtf(ss * (1.f / 128.f) + NORM_EPS); const f32x4 zz = bf4_to_f32(z[i]);
            v2u w; w.x = pk2(o[i].x * r * g4.x * silu_f(zz.x), o[i].y * r * g4.y * silu_f(zz.y)); w.y = pk2(o[i].z * r * g4.z * silu_f(zz.z), o[i].w * r * g4.w * silu_f(zz.w));
            ((v2u*)(MIX + (size_t)row * DM + 2048))[64 * i + lane] = w;
        }
    }
}
__device__ __forceinline__ void row_gemm_out(const bf16* C, const bf16* slab, int row, int lane, f32x4 (&v)[16]) {
    if (row < TP) { const v2u* cr = (const v2u*)(C + (size_t)row * DM) + lane; v2u w[16];
#pragma unroll
        for (int j = 0; j < 16; ++j) w[j] = cr[64 * j];
#pragma unroll
        for (int j = 0; j < 16; ++j) v[j] = bf4_to_f32(w[j]);
    } else { const v2u* s = (const v2u*)(slab + (size_t)(row - TP) * DM) + lane; constexpr size_t st = (size_t)NSB * NST * DM / 4;
#pragma unroll
        for (int j = 0; j < 16; ++j) { const v2u* q = s + 64 * j; v[j] = ((bf4_to_f32(q[0]) + bf4_to_f32(q[st])) + (bf4_to_f32(q[2 * st]) + bf4_to_f32(q[3 * st]))) + ((bf4_to_f32(q[4 * st]) + bf4_to_f32(q[5 * st])) + (bf4_to_f32(q[6 * st]) + bf4_to_f32(q[7 * st]))); }
    }
}
__device__ __forceinline__ void slab_rows_to_lds(const Frame& F, const bf16* slab) {
    LAS f32x4* srow = (LAS f32x4*)(F.lds + RING_OFF); constexpr size_t st = (size_t)NSB * NST * DM / 4;
    for (int idx = F.tid; idx < NWAVES * 1024; idx += NWAVES * 64) { const int w = idx >> 10, c = idx & 1023, sr = w * F.G + F.vcu;
        if (sr < NSB * NST) { const v2u* q = (const v2u*)(slab + (size_t)sr * DM) + c; v2u t[8];
#pragma unroll
            for (int k = 0; k < 8; ++k) t[k] = q[k * st];
            srow[idx] = ((bf4_to_f32(t[0]) + bf4_to_f32(t[1])) + (bf4_to_f32(t[2]) + bf4_to_f32(t[3]))) + ((bf4_to_f32(t[4]) + bf4_to_f32(t[5])) + (bf4_to_f32(t[6]) + bf4_to_f32(t[7]))); } }
    __syncthreads();
}
__device__ __forceinline__ void ph_postmix(const Frame& F, const Params& p, const bf16* MIXO, const bf16* SLAB, float* out, bf16* H) {
    const int lane = F.lane; const f32x4* w_post = (const f32x4*)p.in[15] + lane; const f32x4* w_pre = (const f32x4*)p.in[16] + lane;
    const int NGW = F.G * NWAVES, np = (TP + NGW - 1) / NGW, ns = (NSB * NST + NGW - 1) / NGW;
    const bool lds_rows = ns == 1; if (lds_rows) slab_rows_to_lds(F, SLAB);
    for (int it = 0; it < np + ns; ++it) {
        const int row = it < np ? F.vcu * NWAVES + F.wave + it * NGW : TP + F.wave * F.G + F.vcu + (it - np) * NGW;
        if (it < np ? row >= TP : row >= MROWS) continue;
        const f32x4* xr = (const f32x4*)x_row(p, row) + lane;
        f32x4 v[16], x[16];
#pragma unroll
        for (int j = 0; j < 16; ++j) x[j] = xr[64 * j];
        if (it >= np && lds_rows) {
#pragma unroll
            for (int j = 0; j < 16; ++j) v[j] = ((const LAS f32x4*)(F.lds + RING_OFF))[F.wave * 1024 + lane + 64 * j];
        } else row_gemm_out(MIXO, SLAB, row, lane, v);
        float s = 0.f;
#pragma unroll
        for (int j = 0; j < 16; ++j) s += (v[j].x * v[j].x + v[j].y * v[j].y) + (v[j].z * v[j].z + v[j].w * v[j].w);
        const float r = rsqrtf(wave_sum(s) * (1.f / DM) + NORM_EPS); float s2 = 0.f;
        f32x4* orow = (f32x4*)(out + (size_t)row * DM) + lane;
#pragma unroll
        for (int j = 0; j < 16; ++j) { const f32x4 w = w_post[64 * j];
            v[j].x = x[j].x + v[j].x * r * w.x; v[j].y = x[j].y + v[j].y * r * w.y; v[j].z = x[j].z + v[j].z * r * w.z; v[j].w = x[j].w + v[j].w * r * w.w;
            orow[64 * j] = v[j]; s2 += (v[j].x * v[j].x + v[j].y * v[j].y) + (v[j].z * v[j].z + v[j].w * v[j].w); }
        const float r2 = rsqrtf(wave_sum(s2) * (1.f / DM) + NORM_EPS);
        v2u* hrow = (v2u*)(H + (size_t)row * DM) + lane;
#pragma unroll
        for (int j = 0; j < 16; ++j) { const f32x4 w = w_pre[64 * j]; v2u o; o.x = pk2(v[j].x * r2 * w.x, v[j].y * r2 * w.y); o.y = pk2(v[j].z * r2 * w.z, v[j].w * r2 * w.w); hrow[64 * j] = o; }
    }
}
__device__ __forceinline__ void ph_final(const Frame& F, const bf16* FFNO, const bf16* SLAB, const float* w_post_, float* out) {
    const int lane = F.lane; const f32x4* w_post = (const f32x4*)w_post_ + lane;
    const int NGW = F.G * NWAVES, np = (TP + NGW - 1) / NGW, ns = (NSB * NST + NGW - 1) / NGW;
    const bool lds_rows = ns == 1; if (lds_rows) slab_rows_to_lds(F, SLAB);
    for (int it = 0; it < np + ns; ++it) {
        const int row = it < np ? F.vcu * NWAVES + F.wave + it * NGW : TP + F.wave * F.G + F.vcu + (it - np) * NGW;
        if (it < np ? row >= TP : row >= MROWS) continue;
        f32x4* orow = (f32x4*)(out + (size_t)row * DM) + lane;
        f32x4 v[16], x[16];
#pragma unroll
        for (int j = 0; j < 16; ++j) x[j] = orow[64 * j];
        if (it >= np && lds_rows) {
#pragma unroll
            for (int j = 0; j < 16; ++j) v[j] = ((const LAS f32x4*)(F.lds + RING_OFF))[F.wave * 1024 + lane + 64 * j];
        } else row_gemm_out(FFNO, SLAB, row, lane, v);
        float s = 0.f;
#pragma unroll
        for (int j = 0; j < 16; ++j) s += (v[j].x * v[j].x + v[j].y * v[j].y) + (v[j].z * v[j].z + v[j].w * v[j].w);
        const float r = rsqrtf(wave_sum(s) * (1.f / DM) + NORM_EPS);
#pragma unroll
        for (int j = 0; j < 16; ++j) { const f32x4 w = w_post[64 * j];
            orow[64 * j] = (f32x4){x[j].x + v[j].x * r * w.x, x[j].y + v[j].y * r * w.y, x[j].z + v[j].z * r * w.z, x[j].w + v[j].w * r * w.w}; }
    }
}
__device__ __forceinline__ unsigned off_b(unsigned row, unsigned ch) { return 256u * row + 16u * (ch ^ (((row & 3) << 2) | ((row >> 2) & 3))); }
__device__ __forceinline__ unsigned row_read_addr_16(unsigned lane, unsigned rb, unsigned s) { return off_b((lane & 15) + 16 * rb, 4 * s + (lane >> 4)); }
__device__ __forceinline__ unsigned tr_read_addr_16(unsigned lane, unsigned c, unsigned ks, unsigned t) {
    const unsigned g = lane >> 4, q = (lane & 15) >> 2, p = lane & 3;
    return off_b(32 * ks + 8 * g + 4 * t + q, 2 * c + (p >> 1)) + 8 * (p & 1);
}
typedef short s16x4 __attribute__((ext_vector_type(4)));
__device__ __forceinline__ unsigned lds_addr(const LAS unsigned char* p) { return (unsigned)(__UINTPTR_TYPE__)p; }
__device__ __forceinline__ s16x4 tr_read_wait(unsigned a) { s16x4 r; asm volatile("ds_read_b64_tr_b16 %0, %1\n\ts_waitcnt lgkmcnt(0)" : "=&v"(r) : "v"(a) : "memory"); return r; }
__device__ __forceinline__ bf16x8 tr_frag(unsigned base, unsigned lane, unsigned c, unsigned ks) {
    const s16x4 lo = tr_read_wait(base + tr_read_addr_16(lane, c, ks, 0)), hi = tr_read_wait(base + tr_read_addr_16(lane, c, ks, 1));
    return (bf16x8){lo[0], lo[1], lo[2], lo[3], hi[0], hi[1], hi[2], hi[3]};
}
__device__ __forceinline__ v4u pack8(const float* y) { v4u o; o.x = pg8::cvt_pk_bf16(y[0], y[1]); o.y = pg8::cvt_pk_bf16(y[2], y[3]); o.z = pg8::cvt_pk_bf16(y[4], y[5]); o.w = pg8::cvt_pk_bf16(y[6], y[7]); return o; }
struct ScanBufs { bf16* wF; bf16* kdF; bf16* qeF; bf16* qkF; float* uF; float* egl; unsigned char* vbg; bf16* snF; bf16* vnF; };
constexpr int PREP_B = 4;
constexpr int PA_SLOT = 17408;
constexpr int PA_IMG = PREP_B * PA_SLOT;
constexpr int PA_MSC = PA_IMG + 65536;
struct PrepIn { v4u xw[11]; f32x4 w0[4], w1[4]; float ga, gb; };
__device__ __forceinline__ void gdn_prep_issue(PrepIn& I, int un, int tid, const bf16* P, const float* AB, const float* conv_w) {
    const int h = un >> 7, n = un & 127, row0 = 64 * n, lane = tid & 63;
    const int part = (tid >> 7) < 3 ? (tid >> 7) : 2, tok0 = ((tid >> 4) & 7) * 8, cl = tid & 15, ch = part * 2048 + h * 128 + cl * 8;
#pragma unroll
    for (int k = 0; k < 11; ++k) { const int r = row0 + tok0 - 3 + k, rc = r < 0 ? 0 : r; I.xw[k] = *(const v4u*)(P + (size_t)rc * PW + C_QKVG + ch); }
#pragma unroll
    for (int i = 0; i < 4; ++i) { const float* wp = conv_w + (size_t)i * 6144 + ch; I.w0[i] = *(const f32x4*)wp; I.w1[i] = *(const f32x4*)(wp + 4); }
    I.ga = AB[(size_t)(row0 + lane) * 32 + h]; I.gb = AB[(size_t)(row0 + lane) * 32 + 16 + h];
}
__device__ __forceinline__ void gdn_prep_a(const Frame& F, int un, int slot, PrepIn& I, int un_next, const bf16* P, const float* AB, const float* conv_w, const float* a_log, const float* dt_bias, const ScanBufs sb) {
    constexpr int KIMG = PA_IMG, QIMG = PA_IMG + 16384, QEIMG = PA_IMG + 32768, KDIMG = PA_IMG + 49152, QKB = QIMG;
    LAS unsigned char* L = F.lds + RING_OFF;
    LAS float* gcs = (LAS float*)(L + PA_MSC); LAS float* bts = gcs + 64; LAS float* Af = (LAS float*)(L + slot * PA_SLOT);
    int zv = 0; asm volatile("" : "+v"(zv));
    const int tid = F.tid + zv, lane = tid & 63, wave = F.wave, quad = lane >> 4, l15 = lane & 15;
    const int h = un >> 7, n = un & 127, row0 = 64 * n;
    const int part = tid >> 7, tok0 = ((tid >> 4) & 7) * 8, cl = tid & 15, ch = part * 2048 + h * 128 + cl * 8;
    v4u xw[11]; f32x4 w0[4], w1[4];
    unsigned char* vbg = sb.vbg + (size_t)un * 32768;
    if (tid < 384) {
#pragma unroll
        for (int k = 0; k < 11; ++k) { const int r = row0 + tok0 - 3 + k; xw[k] = r < 0 ? (v4u){0u, 0u, 0u, 0u} : I.xw[k]; }
#pragma unroll
        for (int i = 0; i < 4; ++i) { w0[i] = I.w0[i]; w1[i] = I.w1[i]; }
    } else if (wave == 6) {
        const float a = I.ga, bb = I.gb;
        float g = -__expf(a_log[h]) * softplus_f(a + dt_bias[h]);
#pragma unroll
        for (int o = 1; o < 64; o <<= 1) { const float t = __shfl_up(g, o); if (lane >= o) g += t; }
        gcs[lane] = g; bts[lane] = sigmoid_f(bb);
    }
    LDS_BAR();
    const float glast = gcs[63];
    if (tid < 384) {
#pragma unroll
        for (int t = 0; t < 8; ++t) {
            const int tok = tok0 + t; float y[8];
#pragma unroll
            for (int e = 0; e < 8; ++e) y[e] = 0.f;
#pragma unroll
            for (int i = 0; i < 4; ++i) { const v4u w = xw[t + i];
                y[0] += bflo(w.x) * w0[i].x; y[1] += bfhi(w.x) * w0[i].y; y[2] += bflo(w.y) * w0[i].z; y[3] += bfhi(w.y) * w0[i].w;
                y[4] += bflo(w.z) * w1[i].x; y[5] += bfhi(w.z) * w1[i].y; y[6] += bflo(w.w) * w1[i].z; y[7] += bfhi(w.w) * w1[i].w; }
            float ss = 0.f;
#pragma unroll
            for (int e = 0; e < 8; ++e) { y[e] = silu_f(y[e]); ss += y[e] * y[e]; }
            const float gc = gcs[tok], be = bts[tok], egc = __expf(gc), ekd = __expf(glast - gc);
            const unsigned o = off_b(tok, cl); float t8[8];
            if (part < 2) {
                ss = sum16(ss);
                const float rn = rsqrtf(ss + NORM_EPS) * (part == 0 ? 0.08838834764831845f : 1.0f);
#pragma unroll
                for (int e = 0; e < 8; ++e) y[e] *= rn;
            }
            if (part == 0) {
                *(LAS v4u*)(L + QIMG + o) = pack8(y);
#pragma unroll
                for (int e = 0; e < 8; ++e) t8[e] = y[e] * egc;
                *(LAS v4u*)(L + QEIMG + o) = pack8(t8);
            } else if (part == 1) {
                *(LAS v4u*)(L + KIMG + o) = pack8(y);
#pragma unroll
                for (int e = 0; e < 8; ++e) t8[e] = y[e] * (be * egc);
                *(v4u*)(vbg + 16384 + o) = pack8(t8);
#pragma unroll
                for (int e = 0; e < 8; ++e) t8[e] = y[e] * ekd;
                *(LAS v4u*)(L + KDIMG + o) = pack8(t8);
            } else {
#pragma unroll
                for (int e = 0; e < 8; ++e) t8[e] = y[e] * be;
                *(v4u*)(vbg + o) = pack8(t8);
            }
        }
    }
    gdn_prep_issue(I, un_next, tid, P, AB, conv_w);
    LDS_BAR();
    f32x4 accj[3];
#pragma unroll
    for (int r = 0; r < 3; ++r) {
        const int job = wave + 8 * r; accj[r] = (f32x4){0.f, 0.f, 0.f, 0.f};
        if (job < 20) {
            const int idx = job < 10 ? job : job - 10, ti = idx >= 6 ? 3 : idx >= 3 ? 2 : idx >= 1 ? 1 : 0, tj = idx - ti * (ti + 1) / 2;
            const int aimg = job < 10 ? KIMG : QIMG;
            bf16x8 fa[4], fb[4];
#pragma unroll
            for (int s = 0; s < 4; ++s) { fa[s] = *(const LAS bf16x8*)(L + aimg + row_read_addr_16(lane, ti, s)); fb[s] = *(const LAS bf16x8*)(L + KIMG + row_read_addr_16(lane, tj, s)); }
            __builtin_amdgcn_sched_barrier(0);
#pragma unroll
            for (int s = 0; s < 4; ++s) accj[r] = __builtin_amdgcn_mfma_f32_16x16x32_bf16(fa[s], fb[s], accj[r], 0, 0, 0);
        }
    }
    LDS_BAR();
#pragma unroll
    for (int r = 0; r < 3; ++r) {
        const int job = wave + 8 * r;
        if (job < 20) {
            const int idx = job < 10 ? job : job - 10, ti = idx >= 6 ? 3 : idx >= 3 ? 2 : idx >= 1 ? 1 : 0, tj = idx - ti * (ti + 1) / 2;
            const int j = 16 * tj + l15; const float gj = gcs[j];
#pragma unroll
            for (int e = 0; e < 4; ++e) { const int i = 16 * ti + 4 * quad + e; const float dec = __expf(fminf(gcs[i] - gj, 0.f));
                if (job < 10) Af[i * 68 + j] = (i > j) ? bts[i] * accj[r][e] * dec : 0.f;
                else ((LAS bf16*)(L + QKB))[i * 72 + j] = (bf16)f2bf(accj[r][e] * dec); }
        }
    }
    LDS_BAR();
    {
        const unsigned base = lds_addr(L);
#pragma unroll 1
        for (int job = wave; job < 40; job += 8) {
            if (job < 16) { const int ti = job >> 2, s = job & 3;
                *(v4u*)(sb.qeF + ((size_t)(un * 16 + job) * 64 + lane) * 8) = *(const LAS v4u*)(L + QEIMG + row_read_addr_16(lane, ti, s)); }
            else if (job < 32) { const int f = job - 16, di = f >> 1, s2 = f & 1;
                const bf16x8 fr = tr_frag(base + KDIMG, lane, di, s2);
                *(bf16x8*)(sb.kdF + ((size_t)(un * 16 + f) * 64 + lane) * 8) = fr; }
            else { const int f = job - 32, ti = f >> 1, s2 = f & 1, i = 16 * ti + l15, j0 = 32 * s2 + 8 * quad;
                v4u w = *(const LAS v4u*)(L + QKB + i * 144 + j0 * 2);
                w.x = (j0 + 0 <= i ? w.x & 0xffffu : 0u) | (j0 + 1 <= i ? w.x & 0xffff0000u : 0u); w.y = (j0 + 2 <= i ? w.y & 0xffffu : 0u) | (j0 + 3 <= i ? w.y & 0xffff0000u : 0u);
                w.z = (j0 + 4 <= i ? w.z & 0xffffu : 0u) | (j0 + 5 <= i ? w.z & 0xffff0000u : 0u); w.w = (j0 + 6 <= i ? w.w & 0xffffu : 0u) | (j0 + 7 <= i ? w.w & 0xffff0000u : 0u);
                *(v4u*)(sb.qkF + ((size_t)(un * 8 + f) * 64 + lane) * 8) = w; }
        }
    }
    if (tid == 0) sb.egl[un] = __expf(glast);
    LDS_BAR();
}
__device__ __forceinline__ void gdn_prep_c(const Frame& F, int un, int slot, const ScanBufs sb) {
    constexpr int VBIMG = PA_IMG, KGIMG = PA_IMG + 16384, WT = PA_IMG + 32768;
    LAS unsigned char* L = F.lds + RING_OFF;
    int zv = 0; asm volatile("" : "+v"(zv));
    const int tid = F.tid + zv, lane = tid & 63, wave = F.wave, quad = lane >> 4, l15 = lane & 15;
    const unsigned char* vbg = sb.vbg + (size_t)un * 32768;
#pragma unroll
    for (int it = 0; it < 4; ++it) { const int o = (tid + 512 * it) * 16; *(LAS v4u*)(L + VBIMG + o) = *(const v4u*)(vbg + o); }
    LDS_BAR();
    {
        const int ti = wave & 3, which = wave >> 2; const unsigned base = lds_addr(L) + (which ? KGIMG : VBIMG);
        bf16x8 ta[2];
#pragma unroll
        for (int s2 = 0; s2 < 2; ++s2) ta[s2] = *(const LAS bf16x8*)(L + slot * PA_SLOT + (16 * ti + l15) * 144 + (32 * s2 + 8 * quad) * 2);
#pragma unroll 2
        for (int ct = 0; ct < 8; ++ct) {
            f32x4 acc = (f32x4){0.f, 0.f, 0.f, 0.f};
            { const unsigned a0 = base + tr_read_addr_16(lane, ct, 0, 0), a1 = base + tr_read_addr_16(lane, ct, 0, 1), a2 = base + tr_read_addr_16(lane, ct, 1, 0), a3 = base + tr_read_addr_16(lane, ct, 1, 1);
              s16x4 t0, t1, t2, t3;
              asm volatile("ds_read_b64_tr_b16 %0, %4\n\tds_read_b64_tr_b16 %1, %5\n\tds_read_b64_tr_b16 %2, %6\n\tds_read_b64_tr_b16 %3, %7\n\ts_waitcnt lgkmcnt(0)"
                           : "=&v"(t0), "=&v"(t1), "=&v"(t2), "=&v"(t3) : "v"(a0), "v"(a1), "v"(a2), "v"(a3) : "memory");
              acc = __builtin_amdgcn_mfma_f32_16x16x32_bf16(ta[0], (bf16x8){t0[0], t0[1], t0[2], t0[3], t1[0], t1[1], t1[2], t1[3]}, acc, 0, 0, 0);
              acc = __builtin_amdgcn_mfma_f32_16x16x32_bf16(ta[1], (bf16x8){t2[0], t2[1], t2[2], t2[3], t3[0], t3[1], t3[2], t3[3]}, acc, 0, 0, 0); }
            if (which == 0) *(f32x4*)(sb.uF + ((size_t)((un * 4 + ti) * 8 + ct) * 64 + lane) * 4) = acc;
            else {
#pragma unroll
                for (int e = 0; e < 4; ++e) ((LAS bf16*)(L + WT))[(16 * ti + 4 * quad + e) * 136 + 16 * ct + l15] = (bf16)f2bf(acc[e]); }
        }
    }
    LDS_BAR();
#pragma unroll
    for (int it = 0; it < 2; ++it) { const int idx = tid + 512 * it, fr = idx >> 6, ln = idx & 63, ti = fr >> 2, s = fr & 3;
        *(v4u*)(sb.wF + ((size_t)(un * 16 + fr) * 64 + ln) * 8) = *(const LAS v4u*)(L + WT + (16 * ti + (ln & 15)) * 272 + (32 * s + 8 * (ln >> 4)) * 2); }
    LDS_BAR();
}
__device__ __forceinline__ void gdn_prep_invert_blocked(const Frame& F, int nslots) {
    LAS unsigned char* L = F.lds + RING_OFF;
    int zv = 0; asm volatile("" : "+v"(zv));
    const int tid = F.tid + zv, lane = tid & 63, wave = F.wave, q = lane >> 4, l15 = lane & 15;
    if (wave < nslots) {
        const LAS float* Af = (const LAS float*)(L + wave * PA_SLOT); LAS float* Tf = (LAS float*)(L + PA_IMG + wave * 16384);
        float t[16];
#pragma unroll
        for (int i = 0; i < 16; ++i) {
            const LAS float* rp = Af + (16 * q + i) * 68 + 16 * q; f32x4 ar[4];
#pragma unroll
            for (int jb = 0; jb < 4; ++jb) if (4 * jb < i) ar[jb] = *(const LAS f32x4*)(rp + 4 * jb);
            float acc = (l15 == i) ? 1.f : 0.f;
#pragma unroll
            for (int j = 0; j < i; ++j) acc -= ar[j >> 2][j & 3] * t[j];
            t[i] = acc;
        }
#pragma unroll
        for (int i = 0; i < 16; ++i) Tf[(16 * q + i) * 64 + 16 * q + l15] = t[i];
    }
    LDS_BAR();
#pragma unroll
    for (int d = 1; d < 4; ++d) {
        const int per = 4 - d, total = nslots * per;
#pragma unroll 1
        for (int job = wave; job < total; job += NWAVES) {
            const int slot = job / per, b = job - slot * per, a = b + d;
            const LAS float* Af = (const LAS float*)(L + slot * PA_SLOT); LAS float* Tf = (LAS float*)(L + PA_IMG + slot * 16384);
            f32x4 acc = (f32x4){0.f, 0.f, 0.f, 0.f};
            float ta[4];
#pragma unroll
            for (int s4 = 0; s4 < 4; ++s4) ta[s4] = Tf[(16 * a + l15) * 64 + 16 * a + 4 * q + s4];
#pragma unroll
            for (int cc = 0; cc < 3; ++cc) if (cc < d) {
                const int c = b + cc; float la[4], tb[4];
#pragma unroll
                for (int s4 = 0; s4 < 4; ++s4) { la[s4] = Af[(16 * a + l15) * 68 + 16 * c + 4 * s4 + q]; tb[s4] = Tf[(16 * c + 4 * s4 + q) * 64 + 16 * b + l15]; }
                __builtin_amdgcn_sched_barrier(0);
#pragma unroll
                for (int s4 = 0; s4 < 4; ++s4) acc = __builtin_amdgcn_mfma_f32_16x16x4f32(la[s4], tb[s4], acc, 0, 0, 0); }
            f32x4 res = (f32x4){0.f, 0.f, 0.f, 0.f};
#pragma unroll
            for (int s4 = 0; s4 < 4; ++s4) res = __builtin_amdgcn_mfma_f32_16x16x4f32(-ta[s4], acc[s4], res, 0, 0, 0);
#pragma unroll
            for (int r = 0; r < 4; ++r) Tf[(16 * a + 4 * q + r) * 64 + 16 * b + l15] = res[r];
        }
        LDS_BAR();
    }
    for (int idx = tid; idx < nslots * 4096; idx += NWAVES * 64) { const int slot = idx >> 12, e = idx & 4095, i = e >> 6, c = e & 63;
        const float v = ((c >> 4) <= (i >> 4)) ? ((const LAS float*)(L + PA_IMG + slot * 16384))[e] : 0.f;
        ((LAS bf16*)(L + slot * PA_SLOT))[i * 72 + c] = (bf16)f2bf(v); }
    VM_WAIT();
    LDS_BAR();
}
__device__ __forceinline__ void gdn_prep_all(const Frame& F, const bf16* P, const float* AB, const float* conv_w, const float* a_log, const float* dt_bias, const ScanBufs sb) {
    PrepIn I{};
    if (F.vcu < NUNIT) gdn_prep_issue(I, F.vcu, F.tid, P, AB, conv_w);
#pragma unroll 1
    for (int u0 = F.vcu; u0 < NUNIT; u0 += F.G * PREP_B) {
#pragma unroll 1
        for (int s = 0; s < PREP_B; ++s) { const int un = u0 + s * F.G; const int nx = un + F.G < NUNIT ? un + F.G : un;
            if (un < NUNIT) gdn_prep_a(F, un, s, I, nx, P, AB, conv_w, a_log, dt_bias, sb); }
        { int ns = 0;
#pragma unroll
          for (int k = 0; k < PREP_B; ++k) ns += (u0 + k * F.G < NUNIT) ? 1 : 0;
          gdn_prep_invert_blocked(F, ns); }
#pragma unroll 1
        for (int s = 0; s < PREP_B; ++s) { const int un = u0 + s * F.G; if (un < NUNIT) gdn_prep_c(F, un, s, sb); }
    }
}
constexpr int SCAN_D = 4;
__device__ __forceinline__ void gdn_scan_unit(const Frame& F, int h, int sl, const ScanBufs sb, float* Sout) {
    constexpr int SB_PITCH = 272, VN_PITCH = 144, SB_OFF = 0, VN_OFF = 16 * SB_PITCH;
    LAS unsigned char* L = F.lds + RING_OFF;
    const int lane = F.lane, wave = F.wave, quad = lane >> 4, l15 = lane & 15;
    for (int i = F.tid; i < (16 * SB_PITCH) / 4; i += NWAVES * 64) ((LAS unsigned*)(L + SB_OFF))[i] = 0u;
    __syncthreads();
    const LAS unsigned char* sfp = L + SB_OFF + l15 * SB_PITCH + quad * 16;
    const LAS unsigned char* vfp = L + VN_OFF + l15 * VN_PITCH + quad * 16;
    if (wave < 4) {
        const int ti = wave;
        f32x4 S0 = (f32x4){0.f, 0.f, 0.f, 0.f}, S1 = S0;
        bf16x8 wf[SCAN_D][4], kdf[SCAN_D][2][2]; f32x4 uf[SCAN_D]; float gl[SCAN_D];
#define LOAD_C(un_, W, KD, U, G) do { \
        _Pragma("unroll") for (int s = 0; s < 4; ++s) W[s] = *(const bf16x8*)(sb.wF + ((size_t)((un_) * 16 + ti * 4 + s) * 64 + lane) * 8); \
        _Pragma("unroll") for (int d = 0; d < 2; ++d) _Pragma("unroll") for (int s2 = 0; s2 < 2; ++s2) KD[d][s2] = *(const bf16x8*)(sb.kdF + ((size_t)((un_) * 16 + (2 * ti + d) * 2 + s2) * 64 + lane) * 8); \
        U = *(const f32x4*)(sb.uF + ((size_t)(((un_) * 4 + ti) * 8 + sl) * 64 + lane) * 4); G = sb.egl[un_]; } while (0)
#pragma unroll
        for (int k = 0; k < SCAN_D; ++k) LOAD_C(h * 128 + k, wf[k], kdf[k], uf[k], gl[k]);
#pragma unroll 1
        for (int n0 = 0; n0 < 128; n0 += SCAN_D) {
#pragma unroll
            for (int k = 0; k < SCAN_D; ++k) {
                bf16x8 sf[4];
#pragma unroll
                for (int s = 0; s < 4; ++s) sf[s] = *(const LAS bf16x8*)(sfp + s * 64);
                __builtin_amdgcn_sched_barrier(0);
                f32x4 acc = __builtin_amdgcn_mfma_f32_16x16x32_bf16(wf[k][0], sf[0], (f32x4){0.f, 0.f, 0.f, 0.f}, 0, 0, 0), acc2 = __builtin_amdgcn_mfma_f32_16x16x32_bf16(wf[k][1], sf[1], (f32x4){0.f, 0.f, 0.f, 0.f}, 0, 0, 0);
                acc = __builtin_amdgcn_mfma_f32_16x16x32_bf16(wf[k][2], sf[2], acc, 0, 0, 0); acc2 = __builtin_amdgcn_mfma_f32_16x16x32_bf16(wf[k][3], sf[3], acc2, 0, 0, 0);
                const f32x4 vn = uf[k] - (acc + acc2);
                { v2u w; w.x = pk2(vn[0], vn[1]); w.y = pk2(vn[2], vn[3]); *(LAS v2u*)(L + VN_OFF + l15 * VN_PITCH + (16 * ti + 4 * quad) * 2) = w; }
                LDS_BAR();
                S0 = S0 * gl[k]; S1 = S1 * gl[k];
                { const bf16x8 vf0 = *(const LAS bf16x8*)(vfp), vf1 = *(const LAS bf16x8*)(vfp + 64);
                  __builtin_amdgcn_sched_barrier(0);
                  S0 = __builtin_amdgcn_mfma_f32_16x16x32_bf16(kdf[k][0][0], vf0, S0, 0, 0, 0); S1 = __builtin_amdgcn_mfma_f32_16x16x32_bf16(kdf[k][1][0], vf0, S1, 0, 0, 0);
                  S0 = __builtin_amdgcn_mfma_f32_16x16x32_bf16(kdf[k][0][1], vf1, S0, 0, 0, 0); S1 = __builtin_amdgcn_mfma_f32_16x16x32_bf16(kdf[k][1][1], vf1, S1, 0, 0, 0); }
                { v2u w; w.x = pk2(S0[0], S0[1]); w.y = pk2(S0[2], S0[3]); *(LAS v2u*)(L + SB_OFF + l15 * SB_PITCH + (16 * (2 * ti) + 4 * quad) * 2) = w;
                  w.x = pk2(S1[0], S1[1]); w.y = pk2(S1[2], S1[3]); *(LAS v2u*)(L + SB_OFF + l15 * SB_PITCH + (16 * (2 * ti + 1) + 4 * quad) * 2) = w; }
                { const int nn = n0 + k + SCAN_D < 128 ? n0 + k + SCAN_D : 127; LOAD_C(h * 128 + nn, wf[k], kdf[k], uf[k], gl[k]); }
                LDS_BAR();
            }
        }
#undef LOAD_C
#pragma unroll
        for (int e = 0; e < 4; ++e) { Sout[((size_t)h * 128 + 16 * (2 * ti) + 4 * quad + e) * 128 + 16 * sl + l15] = S0[e]; Sout[((size_t)h * 128 + 16 * (2 * ti + 1) + 4 * quad + e) * 128 + 16 * sl + l15] = S1[e]; }
    } else {
        bf16* snp = sb.snF + ((size_t)(h * 128) * 8 + sl) * 2048 + lane * 8;
        bf16* vnp = sb.vnF + ((size_t)(h * 128) * 8 + sl) * 1024 + lane * 8;
#pragma unroll 1
        for (int n = 0; n < 128; ++n) {
            if (wave == 4) {
                bf16x8 sf[4];
#pragma unroll
                for (int s = 0; s < 4; ++s) sf[s] = *(const LAS bf16x8*)(sfp + s * 64);
#pragma unroll
                for (int s = 0; s < 4; ++s) *(bf16x8*)(snp + (size_t)n * 8 * 2048 + s * 512) = sf[s];
            }
            LDS_BAR();
            if (wave == 5) {
                const bf16x8 vf0 = *(const LAS bf16x8*)(vfp), vf1 = *(const LAS bf16x8*)(vfp + 64);
                *(bf16x8*)(vnp + (size_t)n * 8 * 1024) = vf0; *(bf16x8*)(vnp + (size_t)n * 8 * 1024 + 512) = vf1;
            }
            LDS_BAR();
        }
    }
    __syncthreads();
}
struct OIn { bf16x8 snf[4], vnf[2]; v4u qe[2], qk, z[2]; };
__device__ __forceinline__ void opass_load(OIn& I, int un, int tid, int lane, int sl, const ScanBufs sb, const bf16* P) {
    const int h = un >> 7, n = un & 127;
#pragma unroll
    for (int s = 0; s < 4; ++s) I.snf[s] = *(const bf16x8*)(sb.snF + ((size_t)(un * 8 + sl) * 4 + s) * 512 + lane * 8);
#pragma unroll
    for (int s2 = 0; s2 < 2; ++s2) I.vnf[s2] = *(const bf16x8*)(sb.vnF + ((size_t)(un * 8 + sl) * 2 + s2) * 512 + lane * 8);
#pragma unroll
    for (int it = 0; it < 2; ++it) { const int idx = tid + 512 * it, tok = idx >> 4, c = idx & 15;
        I.qe[it] = *(const v4u*)(sb.qeF + (size_t)un * 8192 + idx * 8);
        I.z[it] = *(const v4u*)(P + (size_t)(64 * n + tok) * PW + C_ZG + h * 128 + c * 8); }
    I.qk = *(const v4u*)(sb.qkF + (size_t)un * 4096 + tid * 8);
}
__device__ __forceinline__ void gdn_opass_units(const Frame& F, int u0, int ustride, const ScanBufs sb, const bf16* P, const float* gnw, bf16* MIX) {
    constexpr int QE_OFF = 0, QK_OFF = 16384, Z_OFF = 24576, SS_OFF = 40960, Y_OFF = 43264, Y_PITCH = 272;
    LAS unsigned char* L = F.lds + RING_OFF;
    const int tid = F.tid, lane = F.lane, sl = F.wave, quad = lane >> 4, l15 = lane & 15;
    const float gw = gnw[16 * sl + l15];
    LAS float* ssq = (LAS float*)(L + SS_OFF);
    OIn C{}, N{}, N2{};
    if (u0 < NUNIT) { opass_load(C, u0, tid, lane, sl, sb, P); opass_load(N, u0 + ustride < NUNIT ? u0 + ustride : u0, tid, lane, sl, sb, P); }
#pragma unroll 1
    for (int un = u0; un < NUNIT; un += ustride) {
        const int h = un >> 7, n = un & 127, nx = un + 2 * ustride < NUNIT ? un + 2 * ustride : un;
#pragma unroll
        for (int it = 0; it < 2; ++it) { const int idx = tid + 512 * it, tok = idx >> 4, c = idx & 15;
            *(LAS v4u*)(L + QE_OFF + idx * 16) = C.qe[it]; *(LAS v4u*)(L + Z_OFF + tok * 256 + c * 16) = C.z[it]; }
        *(LAS v4u*)(L + QK_OFF + tid * 16) = C.qk;
        LDS_BAR();
        opass_load(N2, nx, tid, lane, sl, sb, P);
        f32x4 acc[4];
#pragma unroll
        for (int ti = 0; ti < 4; ++ti) {
            bf16x8 a[6];
#pragma unroll
            for (int s = 0; s < 4; ++s) a[s] = *(const LAS bf16x8*)(L + QE_OFF + ((ti * 4 + s) * 64 + lane) * 16);
#pragma unroll
            for (int s2 = 0; s2 < 2; ++s2) a[4 + s2] = *(const LAS bf16x8*)(L + QK_OFF + ((ti * 2 + s2) * 64 + lane) * 16);
            __builtin_amdgcn_sched_barrier(0);
            f32x4 x = __builtin_amdgcn_mfma_f32_16x16x32_bf16(a[0], C.snf[0], (f32x4){0.f, 0.f, 0.f, 0.f}, 0, 0, 0), y = __builtin_amdgcn_mfma_f32_16x16x32_bf16(a[1], C.snf[1], (f32x4){0.f, 0.f, 0.f, 0.f}, 0, 0, 0);
            x = __builtin_amdgcn_mfma_f32_16x16x32_bf16(a[2], C.snf[2], x, 0, 0, 0); y = __builtin_amdgcn_mfma_f32_16x16x32_bf16(a[3], C.snf[3], y, 0, 0, 0);
            x = __builtin_amdgcn_mfma_f32_16x16x32_bf16(a[4], C.vnf[0], x, 0, 0, 0); y = __builtin_amdgcn_mfma_f32_16x16x32_bf16(a[5], C.vnf[1], y, 0, 0, 0);
            acc[ti] = x + y;
        }
#pragma unroll
        for (int ti = 0; ti < 4; ++ti)
#pragma unroll
            for (int r = 0; r < 4; ++r) { const float v = sum16(acc[ti][r] * acc[ti][r]); if (l15 == 0) ssq[(16 * ti + 4 * quad + r) * 8 + sl] = v; }
        LDS_BAR();
        if (tid < 64) {
            const f32x4 p0 = *(const LAS f32x4*)(ssq + tid * 8), p1 = *(const LAS f32x4*)(ssq + tid * 8 + 4);
            ssq[512 + tid] = rsqrtf((((p0.x + p0.y) + (p0.z + p0.w)) + ((p1.x + p1.y) + (p1.z + p1.w))) * (1.f / 128.f) + NORM_EPS); }
        LDS_BAR();
#pragma unroll
        for (int ti = 0; ti < 4; ++ti)
#pragma unroll
            for (int r = 0; r < 4; ++r) { const int tok = 16 * ti + 4 * quad + r;
                const float rs = ssq[512 + tok];
                const float z = bf2f(*(const LAS bf16*)(L + Z_OFF + tok * 256 + (16 * sl + l15) * 2));
                const float yv = acc[ti][r] * rs * gw * silu_f(z);
                *(LAS bf16*)(L + Y_OFF + tok * Y_PITCH + (16 * sl + l15) * 2) = (bf16)pg8::cvt_pk_bf16(yv, yv); }
        LDS_BAR();
#pragma unroll
        for (int it = 0; it < 2; ++it) { const int idx = tid + 512 * it, tok = idx >> 4, c = idx & 15;
            *(v4u*)(MIX + (size_t)(64 * n + tok) * DM + 2048 + h * 128 + c * 8) = *(const LAS v4u*)(L + Y_OFF + tok * Y_PITCH + c * 16); }
        LDS_BAR();
        C = N; N = N2;
    }
}
struct SampIn { f32x4 S[8]; float in[11]; float z0, z1; };
__device__ __forceinline__ void samp_load(SampIn& I, int u, int tid, int lane, int wave, const bf16* P, const float* AB, const float* state_conv, const float* conv_w, const float* a_log, const float* dt_bias, const float* S0p) {
    const int b = u >> 4, h = u & 15, rg = tid >> 5, jv = tid & 31;
#pragma unroll
    for (int i = 0; i < 8; ++i) I.S[i] = *(const f32x4*)(S0p + ((size_t)u * 128 + 8 * rg + i) * 128 + 4 * jv);
    const bool cv = tid < 384, gt = !cv && tid < 388;
    const int part = cv ? tid >> 7 : 0, ch = tid & 127, c = part * 2048 + h * 128 + ch;
    const size_t grow = (size_t)TP + 4 * b + (gt ? tid - 384 : 0);
    const float* f[7];
#pragma unroll
    for (int r = 0; r < 3; ++r) f[r] = state_conv + ((size_t)b * 3 + r) * 6144 + c;
#pragma unroll
    for (int i = 0; i < 4; ++i) f[3 + i] = conv_w + (size_t)i * 6144 + c;
    if (gt) { f[0] = AB + grow * 32 + h; f[1] = AB + grow * 32 + 16 + h; f[2] = a_log + h; f[3] = dt_bias + h; }
    I.in[0] = *f[0]; I.in[1] = *f[1]; I.in[2] = *f[2];
#pragma unroll
    for (int t = 0; t < 4; ++t) I.in[3 + t] = bf2f(P[(size_t)(TP + 4 * b + t) * PW + C_QKVG + c]);
    I.in[7] = *f[3]; I.in[8] = *f[4]; I.in[9] = *f[5]; I.in[10] = *f[6];
    const size_t zrow = (size_t)TP + 4 * b + (wave & 3); I.z0 = bf2f(P[zrow * PW + C_ZG + h * 128 + lane]); I.z1 = bf2f(P[zrow * PW + C_ZG + h * 128 + lane + 64]);
}
__device__ __forceinline__ void gdn_sample_units(const Frame& F, int u0, int ustride, const bf16* P, const float* AB, const float* state_conv, const float* conv_w, const float* a_log, const float* dt_bias,
                                                 const float* gnw, const float* S0p, float* Sout, bf16* MIX) {
    LAS float* xs = (LAS float*)(F.lds + RING_OFF);
    LAS float* gs = xs + 1536; LAS float* bs = gs + 4;
    LAS float* red = xs + 2048;
    LAS float* opart = red + 2048;
    const int tid = F.tid, lane = F.lane, wave = F.wave, rg = tid >> 5, jv = tid & 31;
    const float gn0 = gnw[lane], gn1 = gnw[lane + 64];
    SampIn C{}, N{};
    if (u0 < NSB * 16) samp_load(C, u0, tid, lane, wave, P, AB, state_conv, conv_w, a_log, dt_bias, S0p);
#pragma unroll 1
    for (int u = u0; u < NSB * 16; u += ustride) {
        const int b = u >> 4, h = u & 15, un = u + ustride < NSB * 16 ? u + ustride : u;
        if (tid < 384) {
            const int part = tid >> 7, ch = tid & 127;
#pragma unroll
            for (int t = 0; t < 4; ++t) xs[(part * 4 + t) * 128 + ch] = silu_f(C.in[t] * C.in[7] + C.in[t + 1] * C.in[8] + C.in[t + 2] * C.in[9] + C.in[t + 3] * C.in[10]);
        } else if (tid < 388) {
            const int t = tid - 384;
            gs[t] = __expf(-__expf(C.in[2]) * softplus_f(C.in[0] + C.in[7])); bs[t] = sigmoid_f(C.in[1]);
        }
        LDS_BAR();
        samp_load(N, un, tid, lane, wave, P, AB, state_conv, conv_w, a_log, dt_bias, S0p);
        { const int part = wave >> 2, t = wave & 3; LAS float* xv = xs + (part * 4 + t) * 128;
          const float v0 = xv[lane], v1 = xv[lane + 64];
          const float r = rsqrtf(wave_sum(v0 * v0 + v1 * v1) + NORM_EPS) * (part == 0 ? 0.08838834764831845f : 1.0f);
          xv[lane] = v0 * r; xv[lane + 64] = v1 * r; }
        LDS_BAR();
#pragma unroll
        for (int t = 0; t < 4; ++t) {
            const float a = gs[t], be = bs[t];
            const f32x4 k0 = *(const LAS f32x4*)(xs + (4 + t) * 128 + 8 * rg), k1 = *(const LAS f32x4*)(xs + (4 + t) * 128 + 8 * rg + 4);
            const f32x4 q0 = *(const LAS f32x4*)(xs + t * 128 + 8 * rg), q1 = *(const LAS f32x4*)(xs + t * 128 + 8 * rg + 4);
            const f32x4 v4 = *(const LAS f32x4*)(xs + (8 + t) * 128 + 4 * jv);
            f32x4 r4 = ((C.S[0] * k0.x + C.S[1] * k0.y) + (C.S[2] * k0.z + C.S[3] * k0.w)) + ((C.S[4] * k1.x + C.S[5] * k1.y) + (C.S[6] * k1.z + C.S[7] * k1.w));
            r4.x += __shfl_xor(r4.x, 32); r4.y += __shfl_xor(r4.y, 32); r4.z += __shfl_xor(r4.z, 32); r4.w += __shfl_xor(r4.w, 32);
            LAS f32x4* rb = (LAS f32x4*)(red + (t & 1) * 1024);
            if (lane < 32) rb[wave * 32 + jv] = r4;
            LDS_BAR();
            f32x4 rs = (rb[jv] + rb[32 + jv]) + (rb[64 + jv] + rb[96 + jv]); rs = rs + ((rb[128 + jv] + rb[160 + jv]) + (rb[192 + jv] + rb[224 + jv]));
            const f32x4 cvv = (v4 - rs * a) * be;
            const float kk[8] = {k0.x, k0.y, k0.z, k0.w, k1.x, k1.y, k1.z, k1.w}, qq[8] = {q0.x, q0.y, q0.z, q0.w, q1.x, q1.y, q1.z, q1.w};
            f32x4 o4 = (f32x4){0.f, 0.f, 0.f, 0.f};
#pragma unroll
            for (int i = 0; i < 8; ++i) { C.S[i] = C.S[i] * a + cvv * kk[i]; o4 = o4 + C.S[i] * qq[i]; }
            o4.x += __shfl_xor(o4.x, 32); o4.y += __shfl_xor(o4.y, 32); o4.z += __shfl_xor(o4.z, 32); o4.w += __shfl_xor(o4.w, 32);
            if (lane < 32) ((LAS f32x4*)(opart + (t * 8 + wave) * 128))[jv] = o4;
        }
#pragma unroll
        for (int i = 0; i < 8; ++i) *(f32x4*)(Sout + ((size_t)u * 128 + 8 * rg + i) * 128 + 4 * jv) = C.S[i];
        LDS_BAR();
        if (wave < 4) { const int t = wave; const size_t row = (size_t)TP + 4 * b + t;
            float o0 = 0.f, o1 = 0.f;
#pragma unroll
            for (int w = 0; w < 8; ++w) { o0 += opart[(t * 8 + w) * 128 + lane]; o1 += opart[(t * 8 + w) * 128 + lane + 64]; }
            const float r = rsqrtf(wave_sum(o0 * o0 + o1 * o1) * (1.f / 128.f) + NORM_EPS);
            MIX[row * DM + 2048 + h * 128 + lane] = (bf16)f2bf(o0 * r * gn0 * silu_f(C.z0));
            MIX[row * DM + 2048 + h * 128 + lane + 64] = (bf16)f2bf(o1 * r * gn1 * silu_f(C.z1)); }
        LDS_BAR();
        C = N;
    }
}
constexpr int ATT_KIMG = 0, ATT_VIMG = 69632, ATT_IMG_ROWS = 272;
constexpr int ATT_BTAB_OFF = MISC_OFF + 128;
__device__ __forceinline__ void attn_load_q(bf16x8 (&qf)[4], const bf16* qptr, int lane) {
#pragma unroll
    for (int s = 0; s < 4; ++s) qf[s] = *(const bf16x8*)(qptr + 32 * s + 8 * (lane >> 4));
}
__device__ __forceinline__ void attn_tile(LAS unsigned char* L, const LAS float* btab, const bf16x8 (&qf)[4], int kt0, int dist0, int jlo, int jhi, float sink, int g, bf16* optr, int lane) {
    const int quad = lane >> 4, l15 = lane & 15;
    f32x4 sc[9];
    bf16x8 kf[2][4];
#pragma unroll
    for (int s = 0; s < 4; ++s) kf[0][s] = *(const LAS bf16x8*)(L + ATT_KIMG + row_read_addr_16(lane, kt0, s));
#pragma unroll
    for (int i = 0; i < 9; ++i) {
        if (i + 1 < 9) {
#pragma unroll
            for (int s = 0; s < 4; ++s) kf[(i + 1) & 1][s] = *(const LAS bf16x8*)(L + ATT_KIMG + row_read_addr_16(lane, kt0 + i + 1, s)); }
        __builtin_amdgcn_sched_barrier(0);
        f32x4 a0 = __builtin_amdgcn_mfma_f32_16x16x32_bf16(kf[i & 1][0], qf[0], (f32x4){0.f, 0.f, 0.f, 0.f}, 0, 0, 0), a1 = __builtin_amdgcn_mfma_f32_16x16x32_bf16(kf[i & 1][1], qf[1], (f32x4){0.f, 0.f, 0.f, 0.f}, 0, 0, 0);
        a0 = __builtin_amdgcn_mfma_f32_16x16x32_bf16(kf[i & 1][2], qf[2], a0, 0, 0, 0); a1 = __builtin_amdgcn_mfma_f32_16x16x32_bf16(kf[i & 1][3], qf[3], a1, 0, 0, 0);
        sc[i] = a0 + a1;
        __builtin_amdgcn_sched_barrier(0);
    }
    float m = sink;
    const bool interior_free = (jlo <= 16 * (kt0 + 1)) && (jhi >= 16 * (kt0 + 8));
#pragma unroll
    for (int i = 0; i < 9; ++i) {
        if (i >= 1 && i <= 7 && interior_free) {
#pragma unroll
            for (int r = 0; r < 4; ++r) { const float v = sc[i][r] * 0.08838834764831845f + btab[g * 132 + dist0 - 16 * i - r]; sc[i][r] = v; m = fmaxf(m, v); }
        } else {
#pragma unroll
            for (int r = 0; r < 4; ++r) { const int dist = dist0 - 16 * i - r, j = 16 * (kt0 + i) + 4 * quad + r; const bool ok = dist >= 0 && dist <= 128 && j >= jlo && j < jhi;
                const float b = btab[g * 132 + (ok ? dist : 0)]; const float v = ok ? sc[i][r] * 0.08838834764831845f + b : -3.0e38f; sc[i][r] = v; m = fmaxf(m, v); }
        }
    }
    m = fmaxf(m, __shfl_xor(m, 16)); m = fmaxf(m, __shfl_xor(m, 32));
    float sum = 0.f;
#pragma unroll
    for (int i = 0; i < 9; ++i)
#pragma unroll
        for (int r = 0; r < 4; ++r) { const float pv = sc[i][r] > -1.0e38f ? __expf(sc[i][r] - m) : 0.f; sc[i][r] = pv; sum += pv; }
    sum += __shfl_xor(sum, 16); sum += __shfl_xor(sum, 32);
    const float inv = __builtin_amdgcn_rcpf(sum + __expf(sink - m));
    bf16x8 pf[5];
#pragma unroll
    for (int p = 0; p < 5; ++p) {
        const f32x4 a = sc[2 * p] * inv; const f32x4 b = (p < 4) ? sc[2 * p + 1 < 9 ? 2 * p + 1 : 8] * inv : (f32x4){0.f, 0.f, 0.f, 0.f};
        pf[p] = __builtin_bit_cast(bf16x8, (v4u){pg8::cvt_pk_bf16(a[0], a[1]), pg8::cvt_pk_bf16(a[2], a[3]), pg8::cvt_pk_bf16(b[0], b[1]), pg8::cvt_pk_bf16(b[2], b[3])});
    }
    const unsigned vbase = lds_addr(L) + ATT_VIMG; const unsigned q4 = (unsigned)l15 >> 2, p2 = (unsigned)lane & 3;
    const unsigned vrow = 16u * (unsigned)kt0 + 4u * (unsigned)quad + q4;
#pragma unroll
    for (int c = 0; c < 8; ++c) {
        const unsigned va = vbase + off_b(vrow, 2 * c + (p2 >> 1)) + 8 * (p2 & 1);
        s16x4 t0, t1, t2, t3, t4, t5, t6, t7, t8, t9;
        asm volatile("ds_read_b64_tr_b16 %0, %10\n\tds_read_b64_tr_b16 %1, %10 offset:4096\n\tds_read_b64_tr_b16 %2, %10 offset:8192\n\tds_read_b64_tr_b16 %3, %10 offset:12288\n\t"
                     "ds_read_b64_tr_b16 %4, %10 offset:16384\n\tds_read_b64_tr_b16 %5, %10 offset:20480\n\tds_read_b64_tr_b16 %6, %10 offset:24576\n\tds_read_b64_tr_b16 %7, %10 offset:28672\n\t"
                     "ds_read_b64_tr_b16 %8, %10 offset:32768\n\tds_read_b64_tr_b16 %9, %10 offset:36864\n\ts_waitcnt lgkmcnt(0)"
                     : "=&v"(t0), "=&v"(t1), "=&v"(t2), "=&v"(t3), "=&v"(t4), "=&v"(t5), "=&v"(t6), "=&v"(t7), "=&v"(t8), "=&v"(t9) : "v"(va) : "memory");
        f32x4 o = (f32x4){0.f, 0.f, 0.f, 0.f};
        o = __builtin_amdgcn_mfma_f32_16x16x32_bf16((bf16x8){t0[0], t0[1], t0[2], t0[3], t1[0], t1[1], t1[2], t1[3]}, pf[0], o, 0, 0, 0);
        o = __builtin_amdgcn_mfma_f32_16x16x32_bf16((bf16x8){t2[0], t2[1], t2[2], t2[3], t3[0], t3[1], t3[2], t3[3]}, pf[1], o, 0, 0, 0);
        o = __builtin_amdgcn_mfma_f32_16x16x32_bf16((bf16x8){t4[0], t4[1], t4[2], t4[3], t5[0], t5[1], t5[2], t5[3]}, pf[2], o, 0, 0, 0);
        o = __builtin_amdgcn_mfma_f32_16x16x32_bf16((bf16x8){t6[0], t6[1], t6[2], t6[3], t7[0], t7[1], t7[2], t7[3]}, pf[3], o, 0, 0, 0);
        o = __builtin_amdgcn_mfma_f32_16x16x32_bf16((bf16x8){t8[0], t8[1], t8[2], t8[3], t9[0], t9[1], t9[2], t9[3]}, pf[4], o, 0, 0, 0);
        v2u w; w.x = pk2(o[0], o[1]); w.y = pk2(o[2], o[3]);
        *(v2u*)(optr + 16 * c + 4 * quad) = w;
    }
}
__device__ __forceinline__ void attn_btab(const Frame& F, const float* rel_bias, int kvh) {
    LAS float* btab = (LAS float*)(F.lds + ATT_BTAB_OFF);
    for (int t = F.tid; t < 4 * 129; t += NWAVES * 64) { const int g = t / 129, d = t - g * 129; btab[g * 132 + d] = rel_bias[rel_bucket_dev(d) * 16 + kvh * 4 + g]; }
}
__device__ __forceinline__ void attn_prompt_unit(const Frame& F, int qb, int kvh, const bf16* P, const float* rel_bias, const float* sinks, bf16* MIX) {
    LAS unsigned char* L = F.lds + RING_OFF;
    const int tid = F.tid, lane = F.lane, wave = F.wave;
    attn_btab(F, rel_bias, kvh);
    const int krow0 = 128 * (qb - 1);
    {
        v4u kv[8], vv[8];
#pragma unroll
        for (int it = 0; it < 8; ++it) { const int cid = tid + 512 * it, row = cid >> 4, ch = cid & 15, gr = krow0 + row, gc = gr < 0 ? 0 : gr;
            kv[it] = *(const v4u*)(P + (size_t)gc * PW + C_KA + kvh * 128 + ch * 8); vv[it] = *(const v4u*)(P + (size_t)gc * PW + C_VA + kvh * 128 + ch * 8); }
#pragma unroll
        for (int it = 0; it < 8; ++it) { const int cid = tid + 512 * it, row = cid >> 4, ch = cid & 15; const bool ok = krow0 + row >= 0;
            *(LAS v4u*)(L + ATT_KIMG + off_b(row, ch)) = ok ? kv[it] : (v4u){0u, 0u, 0u, 0u}; *(LAS v4u*)(L + ATT_VIMG + off_b(row, ch)) = ok ? vv[it] : (v4u){0u, 0u, 0u, 0u}; }
    }
    if (tid < 256) { const int row = 256 + (tid >> 4), ch = tid & 15; *(LAS v4u*)(L + ATT_VIMG + off_b(row, ch)) = (v4u){0u, 0u, 0u, 0u}; *(LAS v4u*)(L + ATT_KIMG + off_b(row, ch)) = (v4u){0u, 0u, 0u, 0u}; }
    __syncthreads();
    const LAS float* btab = (const LAS float*)(F.lds + ATT_BTAB_OFF);
    const int quad = lane >> 4, l15 = lane & 15, g = wave >> 1, h = kvh * 4 + g; const float sink = sinks[h];
    bf16x8 qf[4], qn[4];
    attn_load_q(qf, P + (size_t)(128 * qb + 16 * ((wave & 1) * 4) + l15) * PW + C_QA + h * 128, lane);
#pragma unroll 1
    for (int k = 0; k < 4; ++k) { const int qt = (wave & 1) * 4 + k, row = 128 * qb + 16 * qt + l15;
        attn_load_q(qn, P + (size_t)(row + (k < 3 ? 16 : 0)) * PW + C_QA + h * 128, lane);
        attn_tile(L, btab, qf, qt, 128 + l15 - 4 * quad, qb == 0 ? 128 : 0, 256, sink, g, MIX + (size_t)row * DM + h * 128, lane);
#pragma unroll
        for (int s = 0; s < 4; ++s) qf[s] = qn[s]; }
    __syncthreads();
}
__device__ __forceinline__ void attn_sample_unit(const Frame& F, int b, int kvh, const bf16* P, const float* ck, const float* cv, const float* rel_bias, const float* sinks, bf16* MIX) {
    LAS unsigned char* L = F.lds + RING_OFF;
    const int tid = F.tid, lane = F.lane, wave = F.wave;
    attn_btab(F, rel_bias, kvh);
    {
        f32x4 c0[4], c1[4];
#pragma unroll
        for (int kv = 0; kv < 2; ++kv) {
            const float* src = kv ? cv : ck; const int img = kv ? ATT_VIMG : ATT_KIMG;
#pragma unroll
            for (int it = 0; it < 4; ++it) { const int cid = tid + 512 * it, row = cid >> 4, ch = cid & 15; const float* kp = src + ((size_t)(b * 128 + row) * 4 + kvh) * 128 + ch * 8;
                c0[it] = *(const f32x4*)kp; c1[it] = *(const f32x4*)(kp + 4); }
#pragma unroll
            for (int it = 0; it < 4; ++it) { const int cid = tid + 512 * it, row = cid >> 4, ch = cid & 15;
                *(LAS v4u*)(L + img + off_b(row, ch)) = (v4u){pk2(c0[it].x, c0[it].y), pk2(c0[it].z, c0[it].w), pk2(c1[it].x, c1[it].y), pk2(c1[it].z, c1[it].w)}; }
        }
        { const int cid = tid + 2048, row = cid >> 4, ch = cid & 15;
          v4u kv = (v4u){0u, 0u, 0u, 0u}, vv = kv;
          if (row < 132) { const size_t gr = (size_t)TP + 4 * b + (row - 128); kv = *(const v4u*)(P + gr * PW + C_KA + kvh * 128 + ch * 8); vv = *(const v4u*)(P + gr * PW + C_VA + kvh * 128 + ch * 8); }
          *(LAS v4u*)(L + ATT_KIMG + off_b(row, ch)) = kv; *(LAS v4u*)(L + ATT_VIMG + off_b(row, ch)) = vv; }
    }
    __syncthreads();
    if (wave == 0) {
        const LAS float* btab = (const LAS float*)(F.lds + ATT_BTAB_OFF);
        const int quad = lane >> 4, l15 = lane & 15, g = l15 >> 2, t = l15 & 3, h = kvh * 4 + g, row = TP + 4 * b + t;
        bf16x8 qf[4]; attn_load_q(qf, P + (size_t)row * PW + C_QA + h * 128, lane);
        attn_tile(L, btab, qf, 0, 128 + t - 4 * quad, 0, 132, sinks[h], g, MIX + (size_t)row * DM + h * 128, lane);
    }
    __syncthreads();
}
constexpr int N_PHASES = 10;
__global__ void __launch_bounds__(NWAVES * 64, 2) mega_fwd(Params p) {
    extern __shared__ __attribute__((aligned(16))) unsigned char lds[];
    Frame F;
    F.lds = (LAS unsigned char*)lds;
    F.MISC = (volatile LAS unsigned*)(F.lds + MISC_OFF);
    F.tid = threadIdx.x; F.lane = F.tid & 63; F.wave = __builtin_amdgcn_readfirstlane(F.tid >> 6);
    F.G = gridDim.x; { const int bx = blockIdx.x; F.vcu = (F.G % 8 == 0) ? (bx % 8) * (F.G / 8) + bx / 8 : bx; }
    unsigned char* ws = p.ws;
    F.ctl = (gu32*)(ws + WS_CTL);
    for (int u = F.tid; u < (LDS_BYTES - LDSCTL_OFF) / 4; u += NWAVES * 64) ((LAS unsigned*)(F.lds + LDSCTL_OFF))[u] = 0u;
    __syncthreads();
    XcdBarrier bar = xcd_barrier_post((unsigned*)(F.ctl + CW_BAR) + p.li * XCD_BAR_WORDS, F.MISC + 8);
    const int lo = p.ph_lo, hi = p.ph_hi;
#define IN(k) (lo <= (k) && (k) < hi)
#define BOTH(k) (IN(k) && IN((k) + 1))
#define GRID_BAR() xcd_barrier(bar)
#ifdef PROBE_A
    unsigned long long* stamps = (unsigned long long*)(p.ws + WS_QN);
#define STAMP(id) do { if (F.tid == 0) stamps[(size_t)blockIdx.x * 64 + (id)] = wall_clock64(); } while (0)
#else
#define STAMP(id) do {} while (0)
#endif
    STAMP(0);
    bf16* Win_t = (bf16*)(ws + WS_WIN); bf16* Wout_t = (bf16*)(ws + WS_WOUT); bf16* Wgu_t = (bf16*)(ws + WS_WGU); bf16* Wdn_t = (bf16*)(ws + WS_WDN);
    bf16* H = (bf16*)(ws + WS_H); bf16* MIX = (bf16*)(ws + WS_MIX); bf16* P = (bf16*)(ws + WS_P); bf16* ACT = (bf16*)(ws + WS_ACT);
    float* AB = (float*)(ws + WS_AB); bf16* MIXO = (bf16*)(ws + WS_MIXO); bf16* FFNO = (bf16*)(ws + WS_FFNO);
    bf16* SLAB = (bf16*)(ws + WS_VBG);
    const ScanBufs sb{(bf16*)(ws + WS_WF), (bf16*)(ws + WS_KDF), (bf16*)(ws + WS_QEF), (bf16*)(ws + WS_QKF), (float*)(ws + WS_UF), (float*)(ws + WS_EGL), ws + WS_VBG, (bf16*)(ws + WS_SNF), (bf16*)(ws + WS_VNF)};
    float* out = p.out;

    if (IN(0)) { p0_prologue(F, p); STAMP(1); if (BOTH(0)) GRID_BAR(); STAMP(2); }
    if (IN(1)) {
        pg8::Gemm g{H, Win_t, MROWS, PROJ_PAD, DM}; pg8::StaticOrder S; S.init(MROWS, PROJ_PAD, DM, F.G, (int)blockIdx.x);
        pg8::EpiProj E{P, AB, PW};
        pg8::gemm_phase<pg8::EpiProj, pg8::StaticOrder, true, true>(F.lds + RING_OFF, g, S, E);
        STAMP(3); if (BOTH(1)) GRID_BAR(); STAMP(4);
    }
    if (IN(2)) {
        if (p.pad & 1) ph_copy_states(F, P, p.in[2], p.in[3], out);
        STAMP(5);
        if (p.pad & 2) gdn_sample_units(F, F.vcu, F.G, P, AB, p.in[4], p.in[9], p.in[10], p.in[11], p.in[12], p.in[5], out + O_SGDN, MIX);
        STAMP(6);
        if (p.pad & 4) gdn_prep_all(F, P, AB, p.in[9], p.in[10], p.in[11], sb);
        STAMP(7); if (BOTH(2)) GRID_BAR(); STAMP(8);
    }
    if (IN(3)) {
        if (F.G == 256) {
            const int xcd = F.vcu >> 5, r = F.vcu & 31;
            if (r < 16) gdn_scan_unit(F, xcd * 2 + (r >> 3), r & 7, sb, out + O_PGDN);
            else { const int aw = xcd * 16 + (r - 16);
                for (int u = aw; u < 256; u += 128) attn_prompt_unit(F, u >> 2, u & 3, P, p.in[6], p.in[8], MIX);
                for (int u = aw; u < 512; u += 128) attn_sample_unit(F, u >> 2, u & 3, P, p.in[2], p.in[3], p.in[6], p.in[8], MIX);
                STAMP(24);
                w_up_convert(F, p, aw, 128); }
        } else {
            for (int su = F.vcu; su < 128; su += F.G) gdn_scan_unit(F, su >> 3, su & 7, sb, out + O_PGDN);
            for (int u = F.vcu; u < 256; u += F.G) attn_prompt_unit(F, u >> 2, u & 3, P, p.in[6], p.in[8], MIX);
            for (int u = F.vcu; u < 512; u += F.G) attn_sample_unit(F, u >> 2, u & 3, P, p.in[2], p.in[3], p.in[6], p.in[8], MIX);
            w_up_convert(F, p, F.vcu, F.G);
        }
        STAMP(9); if (BOTH(3)) GRID_BAR(); STAMP(10);
    }
    if (IN(4)) { gdn_opass_units(F, F.vcu, F.G, sb, P, p.in[12], MIX); STAMP(11); if (BOTH(4)) GRID_BAR(); STAMP(12); }
    if (IN(5)) {
        pg8::Gemm g{MIX, Wout_t, MROWS, DM, DM}; pg8::SplitTailOrder S; S.init(TP, NSB * NST, DM, DM, F.G, (int)blockIdx.x);
        pg8::EpiBfSlab E{MIXO, DM, SLAB, TP / 256, DM / 64, (size_t)NSB * NST * DM};
        pg8::gemm_phase<pg8::EpiBfSlab, pg8::SplitTailOrder, true, true>(F.lds + RING_OFF, g, S, E);
        STAMP(13); if (BOTH(5)) GRID_BAR(); STAMP(14);
    }
    if (IN(6)) { ph_postmix(F, p, MIXO, SLAB, out, H); STAMP(15); if (BOTH(6)) GRID_BAR(); STAMP(16); }
    if (IN(7)) {
        pg8::Gemm g{H, Wgu_t, MROWS, NGU, DM}; pg8::StaticOrder S; S.init(MROWS, NGU, DM, F.G, (int)blockIdx.x);
        pg8::EpiSwiGLU E{ACT, FF};
        pg8::gemm_phase<pg8::EpiSwiGLU, pg8::StaticOrder, true, true>(F.lds + RING_OFF, g, S, E);
        STAMP(17);
        { const int n12 = S.nwg % F.G, c = (int)blockIdx.x;
          if (n12 == 0) { w_down_convert(F, p, c, F.G); copy_cache_rows(F, p.in[2], p.in[3], out, c, F.G); }
          else if (c >= n12) { w_down_convert(F, p, c - n12, F.G - n12); copy_cache_rows(F, p.in[2], p.in[3], out, c - n12, F.G - n12); } }
        STAMP(18); if (BOTH(7)) GRID_BAR(); STAMP(19);
    }
    if (IN(8)) {
        pg8::Gemm g{ACT, Wdn_t, MROWS, DM, FF}; pg8::SplitTailOrder S; S.init(TP, NSB * NST, DM, FF, F.G, (int)blockIdx.x);
        pg8::EpiBfSlab E{FFNO, DM, SLAB, TP / 256, FF / 64, (size_t)NSB * NST * DM};
        pg8::gemm_phase<pg8::EpiBfSlab, pg8::SplitTailOrder, true, true>(F.lds + RING_OFF, g, S, E);
        STAMP(20); if (BOTH(8)) GRID_BAR(); STAMP(21);
    }
    if (IN(9)) ph_final(F, FFNO, SLAB, p.in[17], out);
#ifdef PROBE_A
    STAMP(22); GRID_BAR(); STAMP(23);
    if (blockIdx.x == 0 && F.tid == 0) {
        double acc = (PROBE_MODE == 2) ? 1e30 : 0.0; int cnt = 0;
        for (int b = 0; b < (int)gridDim.x; ++b) {
            const int vb = (gridDim.x % 8 == 0) ? (b % 8) * ((int)gridDim.x / 8) + b / 8 : b; const bool scanb = (vb & 31) < 16;
            if (PROBE_MODE == 0 && b != 0) continue; if (PROBE_MODE == 3 && !scanb) continue; if (PROBE_MODE == 4 && scanb) continue;
            const double d = (double)(long long)(stamps[(size_t)b * 64 + PROBE_B] - stamps[(size_t)b * 64 + PROBE_A]) * 0.01;
            if (PROBE_MODE == 2) acc = d < acc ? d : acc; else if (PROBE_MODE == 5) acc += d; else acc = d > acc ? d : acc; ++cnt; }
        if (PROBE_MODE == 5) acc /= cnt;
        out[O_SWK] = p.in[2][4 * 512] + (float)(acc / PROBE_DIV); }
#endif
#undef IN
#undef BOTH
#undef GRID_BAR
}
#ifndef MK_N_LAUNCHES
#define MK_N_LAUNCHES 1
#endif
extern "C" void kernel_launch(void* const* d_in, const int* in_sizes, int n_in, void* d_out, int out_size, void* d_ws, size_t ws_size, hipStream_t stream) {
    static int grid = 0;
    if (grid == 0) {
        if (n_in != 21 || out_size != (int)O_TOTAL || ws_size < WS_END) { fprintf(stderr, "kernel_launch: unexpected shapes (n_in %d, out %d, ws %zu < %zu)\n", n_in, out_size, ws_size, (size_t)WS_END); grid = -1; return; }
        int dev = 0, cus = 0;
        if (hipGetDevice(&dev) != hipSuccess || hipDeviceGetAttribute(&cus, hipDeviceAttributeMultiprocessorCount, dev) != hipSuccess) { grid = -1; return; }
        if (hipFuncSetAttribute((const void*)mega_fwd, hipFuncAttributeMaxDynamicSharedMemorySize, LDS_BYTES) != hipSuccess) { fprintf(stderr, "kernel_launch: hipFuncSetAttribute failed\n"); grid = -1; return; }
        int per_cu = 0; (void)hipOccupancyMaxActiveBlocksPerMultiprocessor(&per_cu, (const void*)mega_fwd, NWAVES * 64, LDS_BYTES); (void)hipGetLastError();
        grid = cus;
    }
    if (grid < 0) return;
    Params p{};
    for (int i = 0; i < 21; ++i) p.in[i] = (const float*)d_in[i];
    p.out = (float*)d_out; p.ws = (unsigned char*)d_ws;
#ifdef MK_PLAN
    const int plan[][3] = {MK_PLAN};
#else
    const int plan[][3] = {{0, N_PHASES, 7}};
#endif
    constexpr int nplan = (int)(sizeof(plan) / sizeof(plan[0]));
    static_assert((size_t)(CW_BAR + nplan * XCD_BAR_WORDS) * 4 <= CTL_ZERO_BYTES, "barrier words inside the control region");
    (void)hipMemsetAsync((char*)d_ws + WS_CTL, 0, (size_t)(CW_BAR + nplan * XCD_BAR_WORDS) * 4, stream);
    for (int li = 0; li < (int)(sizeof(plan) / sizeof(plan[0])); ++li) { p.ph_lo = plan[li][0]; p.ph_hi = plan[li][1]; p.li = li; p.pad = plan[li][2];
        hipLaunchKernelGGL(mega_fwd, dim3(grid), dim3(NWAVES * 64), LDS_BYTES, stream, p); }
}
```
